# Optimizing an MI355X kernel written in HIP

```python
import math
import jax, jax.numpy as jnp
from jax import lax
import numpy as np

D_MODEL = 1024
BATCH = 2
SEQ = 8192
DEPTH = 2

HEAD_DIM = 64
Q_BLOCK = 128
NORM_EPS = 1e-6

RWKV_HEADS = 8
RWKV_WIDTH = RWKV_HEADS * HEAD_DIM
RWKV_DECAY_RANK = 64
RWKV_ICLR_RANK = 64
RWKV_GATE_RANK = 128
RWKV_GN_EPS = 64e-5

NSA_Q_HEADS = 8
NSA_KV_GROUPS = 2
NSA_CMP_LEN = 32
NSA_CMP_STRIDE = 16
NSA_CMP_HIDDEN = 256
NSA_SEL_BLOCK = 64
NSA_SEL_TOPN = 16
NSA_WINDOW = 512
NSA_FORCE_SCORE = 1e9

SWA_Q_HEADS = 8
SWA_KV_HEADS = 2
SWA_WINDOW = 128

REL_BUCKETS = 32
REL_MAX_DIST = 128

PEER_HEADS = 8
PEER_NKEYS = 128
PEER_EXPERTS = PEER_NKEYS * PEER_NKEYS
PEER_QDIM = 256
PEER_TOPK = 16
PEER_TOK_BLOCK = 128

RWKV_SPLITS = (RWKV_WIDTH, RWKV_WIDTH, RWKV_WIDTH, RWKV_DECAY_RANK, RWKV_ICLR_RANK, RWKV_GATE_RANK)
NSA_SPLITS = (NSA_Q_HEADS * HEAD_DIM,) + (NSA_KV_GROUPS * HEAD_DIM,) * 6 + (NSA_Q_HEADS * 3,)
SWA_SPLITS = (SWA_Q_HEADS * HEAD_DIM, SWA_KV_HEADS * HEAD_DIM, SWA_KV_HEADS * HEAD_DIM)
GATE_SPLITS = (D_MODEL, D_MODEL, D_MODEL)
RWKV_COLS = sum(RWKV_SPLITS)
IN_SPLITS = RWKV_SPLITS + NSA_SPLITS + SWA_SPLITS + GATE_SPLITS
IN_COLS = sum(IN_SPLITS)

kernel_name = 'hybrid_rwkv7_nsa_swasink_peer'


def split_cols(z, sizes):
    cuts = [int(c) for c in np.cumsum(sizes)[:-1]]
    return jnp.split(z, cuts, axis=-1)


def rmsnorm(x, w):
    xf = x.astype(jnp.float32)
    y = xf * lax.rsqrt(jnp.mean(xf * xf, axis=-1, keepdims=True) + NORM_EPS)
    return (y * w.astype(jnp.float32)).astype(x.dtype)


def token_shift(z, mu):
    z_prev = jnp.pad(z, ((0, 0), (1, 0), (0, 0)))[:, :-1]
    return z + mu * (z_prev - z)


def t5_bucket(dist):
    n = jnp.maximum(dist, 0)
    max_exact = REL_BUCKETS // 2
    nf = jnp.maximum(n, max_exact).astype(jnp.float32)
    large = max_exact + (jnp.log(nf / max_exact) / math.log(REL_MAX_DIST / max_exact)
                         * (REL_BUCKETS - max_exact)).astype(jnp.int32)
    large = jnp.minimum(large, REL_BUCKETS - 1)
    return jnp.where(n < max_exact, n, large)


def masked_softmax(s, mask):
    s = jnp.where(mask, s.astype(jnp.float32), -jnp.inf)
    m = jnp.max(s, axis=-1, keepdims=True)
    m = jnp.where(jnp.isfinite(m), m, 0.0)
    e = jnp.exp(s - m)
    return e / jnp.maximum(jnp.sum(e, axis=-1, keepdims=True), 1e-30)


def sink_softmax(s, mask, sink):
    s = jnp.where(mask, s.astype(jnp.float32), -jnp.inf)
    sink = sink.astype(jnp.float32)[None, :, :, None, None]
    m = jnp.maximum(jnp.max(s, axis=-1, keepdims=True), sink)
    e = jnp.exp(s - m)
    return e / (jnp.sum(e, axis=-1, keepdims=True) + jnp.exp(sink - m))


def rwkv7_mixer(zr, zk, zv, zw, za, zg, w0, w2, a0, a2, g2, k_k, k_a, r_k, ln_w, ln_b):
    B, S, C = zr.shape
    H, N = RWKV_HEADS, HEAD_DIM
    f32 = jnp.float32
    log_w = -jax.nn.softplus(-(w0 + jnp.tanh(zw) @ w2)) - 0.5
    decay = jnp.exp(-jnp.exp(log_w.astype(f32)))
    a = jax.nn.sigmoid(a0 + za @ a2)
    g = jax.nn.sigmoid(zg) @ g2
    kk = (zk * k_k).reshape(B, S, H, N).astype(f32)
    kk = kk * lax.rsqrt(jnp.maximum(jnp.sum(kk * kk, axis=-1, keepdims=True), 1e-12))
    k = zk * (1.0 + (a - 1.0) * k_a)
    hd = lambda z: z.reshape(B, S, H, N).astype(f32)
    r_h, k_h, v_h, a_h, w_h = hd(zr), hd(k), hd(zv), hd(a), hd(decay)
    tm = lambda z: jnp.swapaxes(z, 0, 1)

    def step(state, inp):
        r_t, w_t, k_t, v_t, kk_t, a_t = inp
        sa = jnp.einsum('bhij,bhj->bhi', state, -kk_t)
        state = (state * w_t[:, :, None, :] + sa[..., None] * (kk_t * a_t)[:, :, None, :]
                 + v_t[..., None] * k_t[:, :, None, :])
        return state, jnp.einsum('bhij,bhj->bhi', state, r_t)

    s0 = jnp.zeros((B, H, N, N), f32)
    _, y = lax.scan(step, s0, (tm(r_h), tm(w_h), tm(k_h), tm(v_h), tm(kk), tm(a_h)))
    y = tm(y)
    mu = jnp.mean(y, axis=-1, keepdims=True)
    var = jnp.mean(jnp.square(y - mu), axis=-1, keepdims=True)
    y = ((y - mu) * lax.rsqrt(var + RWKV_GN_EPS)).reshape(B, S, C) * ln_w + ln_b
    bonus = jnp.sum(r_h * k_h * r_k, axis=-1, keepdims=True) * v_h
    out = (y + bonus.reshape(B, S, C)) * g
    return out.astype(zr.dtype)


def nsa_compress(z, pe, w1, w2):
    B, S, G, dh = z.shape
    n_sub = NSA_CMP_LEN // NSA_CMP_STRIDE
    chunks = z.reshape(B, S // NSA_CMP_STRIDE, NSA_CMP_STRIDE, G, dh)
    n_cmp = S // NSA_CMP_STRIDE - n_sub + 1
    blocks = jnp.concatenate([chunks[:, j:j + n_cmp] for j in range(n_sub)], axis=2)
    blocks = blocks + pe[None, None, :, None, :]
    flat = blocks.transpose(0, 3, 1, 2, 4).reshape(B, G, n_cmp, NSA_CMP_LEN * dh)
    return jax.nn.gelu(flat @ w1, approximate=False) @ w2


def nsa_mixer(q, kc, vc, ks, vs, kw, vw, gates, pe_k, pe_v, ck_w1, ck_w2, cv_w1, cv_w2, bias_tbl):
    B, S, _ = q.shape
    G, Hg, dh = NSA_KV_GROUPS, NSA_Q_HEADS // NSA_KV_GROUPS, HEAD_DIM
    scale = dh ** -0.5
    heads = lambda z: z.reshape(B, S, G, dh)
    kv_t = lambda z: heads(z).transpose(0, 2, 1, 3)
    qh = q.reshape(B, S, G, Hg, dh).transpose(0, 2, 3, 1, 4)
    gh = jax.nn.sigmoid(gates.reshape(B, S, G, Hg, 3)).transpose(0, 2, 3, 1, 4)

    k_cmp = nsa_compress(heads(kc), pe_k, ck_w1, ck_w2)
    v_cmp = nsa_compress(heads(vc), pe_v, cv_w1, cv_w2)
    n_cmp = k_cmp.shape[2]
    cmp_start = jnp.arange(n_cmp) * NSA_CMP_STRIDE
    cmp_end = cmp_start + NSA_CMP_LEN - 1
    n_sel = S // NSA_SEL_BLOCK
    sel_start = jnp.arange(n_sel) * NSA_SEL_BLOCK
    overlap = ((cmp_end[:, None] >= sel_start[None, :])
               & (cmp_start[:, None] <= sel_start[None, :] + NSA_SEL_BLOCK - 1)).astype(jnp.float32)
    ks_blk = kv_t(ks).reshape(B, G, n_sel, NSA_SEL_BLOCK, dh)
    vs_blk = kv_t(vs).reshape(B, G, n_sel, NSA_SEL_BLOCK, dh)
    pad = ((0, 0), (0, 0), (NSA_WINDOW, 0), (0, 0))
    kw_pad = jnp.pad(kv_t(kw), pad)
    vw_pad = jnp.pad(kv_t(vw), pad)

    tbl = bias_tbl.T.reshape(G, Hg, REL_BUCKETS)
    win_len = NSA_WINDOW + Q_BLOCK
    rel = jnp.arange(Q_BLOCK)[:, None] + NSA_WINDOW - jnp.arange(win_len)[None, :]
    win_bias = tbl[:, :, t5_bucket(rel)]
    win_rel_mask = (rel >= 0) & (rel < NSA_WINDOW)
    top_n = min(NSA_SEL_TOPN, n_sel)
    b_ix = jnp.arange(B)[:, None, None, None]
    g_ix = jnp.arange(G)[None, :, None, None]
    g_ix5 = jnp.arange(G)[None, :, None, None, None]
    h_ix5 = jnp.arange(Hg)[None, None, :, None, None]
    blk = jnp.arange(n_sel)

    def block(i):
        s0 = i * Q_BLOCK
        t = s0 + jnp.arange(Q_BLOCK)
        qb = lax.dynamic_slice_in_dim(qh, s0, Q_BLOCK, axis=3)
        gb = lax.dynamic_slice_in_dim(gh, s0, Q_BLOCK, axis=3)
        sc = jnp.einsum('bghqd,bgcd->bghqc', qb, k_cmp) * scale
        pc = masked_softmax(sc, cmp_end[None, :] <= t[:, None])
        o_cmp = jnp.einsum('bghqc,bgcd->bghqd', pc.astype(v_cmp.dtype), v_cmp)
        imp = jnp.einsum('bghqc,cn->bgqn', pc, overlap)
        cur = t // NSA_SEL_BLOCK
        forced = (blk[None, :] == 0) | (blk[None, :] == cur[:, None]) | (blk[None, :] == cur[:, None] - 1)
        valid = blk[None, :] <= cur[:, None]
        imp = jnp.where(forced, NSA_FORCE_SCORE, jnp.where(valid, imp, -1.0))
        _, sel = lax.top_k(imp, top_n)
        k_sel = ks_blk[b_ix, g_ix, sel].reshape(B, G, Q_BLOCK, top_n * NSA_SEL_BLOCK, dh)
        v_sel = vs_blk[b_ix, g_ix, sel].reshape(B, G, Q_BLOCK, top_n * NSA_SEL_BLOCK, dh)
        pos = (sel[..., None] * NSA_SEL_BLOCK + jnp.arange(NSA_SEL_BLOCK)).reshape(B, G, Q_BLOCK, top_n * NSA_SEL_BLOCK)
        dist = t[:, None] - pos
        bias = tbl[g_ix5, h_ix5, t5_bucket(dist)[:, :, None]]
        ss = jnp.einsum('bghqd,bgqkd->bghqk', qb, k_sel) * scale + bias
        ps = masked_softmax(ss, (dist >= 0)[:, :, None])
        o_sel = jnp.einsum('bghqk,bgqkd->bghqd', ps.astype(v_sel.dtype), v_sel)
        k_win = lax.dynamic_slice_in_dim(kw_pad, s0, win_len, axis=2)
        v_win = lax.dynamic_slice_in_dim(vw_pad, s0, win_len, axis=2)
        kpos = s0 - NSA_WINDOW + jnp.arange(win_len)
        sw = jnp.einsum('bghqd,bgkd->bghqk', qb, k_win) * scale + win_bias
        pw = masked_softmax(sw, win_rel_mask & (kpos >= 0)[None, :])
        o_win = jnp.einsum('bghqk,bgkd->bghqd', pw.astype(v_win.dtype), v_win)
        return gb[..., 0:1] * o_cmp + gb[..., 1:2] * o_sel + gb[..., 2:3] * o_win

    out = lax.map(block, jnp.arange(S // Q_BLOCK))
    return out.transpose(1, 0, 4, 2, 3, 5).reshape(B, S, G * Hg * dh)


def swa_sink_mixer(q, k, v, sinks, bias_tbl):
    B, S, _ = q.shape
    G, Hg, dh = SWA_KV_HEADS, SWA_Q_HEADS // SWA_KV_HEADS, HEAD_DIM
    scale = dh ** -0.5
    qh = q.reshape(B, S, G, Hg, dh).transpose(0, 2, 3, 1, 4)
    pad = ((0, 0), (0, 0), (SWA_WINDOW, 0), (0, 0))
    k_pad = jnp.pad(k.reshape(B, S, G, dh).transpose(0, 2, 1, 3), pad)
    v_pad = jnp.pad(v.reshape(B, S, G, dh).transpose(0, 2, 1, 3), pad)
    win_len = SWA_WINDOW + Q_BLOCK
    rel = jnp.arange(Q_BLOCK)[:, None] + SWA_WINDOW - jnp.arange(win_len)[None, :]
    bias = bias_tbl.T.reshape(G, Hg, REL_BUCKETS)[:, :, t5_bucket(rel)]
    rel_mask = (rel >= 0) & (rel < SWA_WINDOW)
    sink = sinks.reshape(G, Hg)

    def block(i):
        s0 = i * Q_BLOCK
        qb = lax.dynamic_slice_in_dim(qh, s0, Q_BLOCK, axis=3)
        kb = lax.dynamic_slice_in_dim(k_pad, s0, win_len, axis=2)
        vb = lax.dynamic_slice_in_dim(v_pad, s0, win_len, axis=2)
        kpos = s0 - SWA_WINDOW + jnp.arange(win_len)
        s = jnp.einsum('bghqd,bgkd->bghqk', qb, kb) * scale + bias
        p = sink_softmax(s, rel_mask & (kpos >= 0)[None, :], sink)
        return jnp.einsum('bghqk,bgkd->bghqd', p.astype(vb.dtype), vb)

    out = lax.map(block, jnp.arange(S // Q_BLOCK))
    return out.transpose(1, 0, 4, 2, 3, 5).reshape(B, S, G * Hg * dh)


def peer_ffn(z, wq, subkeys, u_tab, v_tab):
    B, S, D = z.shape
    Hp, K, half = PEER_HEADS, PEER_TOPK, PEER_QDIM // 2
    zt = z.reshape(B * S // PEER_TOK_BLOCK, PEER_TOK_BLOCK, D)

    def block(zb):
        q = (zb @ wq).reshape(PEER_TOK_BLOCK, Hp, 2, half)
        s = jnp.einsum('thpd,hpnd->thpn', q, subkeys).astype(jnp.float32)
        s_top, i_top = lax.top_k(s, K)
        cand = (s_top[:, :, 0, :, None] + s_top[:, :, 1, None, :]).reshape(PEER_TOK_BLOCK, Hp, K * K)
        score, flat = lax.top_k(cand, K)
        i1 = jnp.take_along_axis(i_top[:, :, 0], flat // K, axis=-1)
        i2 = jnp.take_along_axis(i_top[:, :, 1], flat % K, axis=-1)
        expert = i1 * PEER_NKEYS + i2
        gate = jax.nn.softmax(score, axis=-1)
        h = jnp.einsum('thkd,td->thk', u_tab[expert], zb).astype(jnp.float32)
        act = (gate * jax.nn.gelu(h, approximate=False)).astype(zb.dtype)
        return jnp.einsum('thk,thkd->td', act, v_tab[expert])

    return lax.map(block, zt).reshape(B, S, D)


def setup_inputs(seed: int = 0) -> dict:
    key = jax.random.key(seed)
    keys = iter(jax.random.split(key, 40))
    L, D = DEPTH, D_MODEL

    def nrm(shape, scale):
        return jax.random.normal(next(keys), shape, jnp.float32) * scale

    def unif(shape, lo, hi):
        return jax.random.uniform(next(keys), shape, jnp.float32, lo, hi)

    cmp_in = NSA_CMP_LEN * HEAD_DIM
    return {
        'x': nrm((BATCH, SEQ, D), 1.0),
        'ln1_w': 1.0 + nrm((L, D), 0.02),
        'ln2_w': 1.0 + nrm((L, D), 0.02),
        'lnf_w': 1.0 + nrm((D,), 0.02),
        'rel_bias': nrm((REL_BUCKETS, NSA_Q_HEADS + SWA_Q_HEADS), 0.3),
        'w_in': nrm((L, D, IN_COLS), D ** -0.5),
        'rwkv_mu': unif((L, RWKV_COLS), 0.0, 1.0),
        'rwkv_w0': -0.5 + nrm((L, RWKV_WIDTH), 0.5),
        'rwkv_w2': nrm((L, RWKV_DECAY_RANK, RWKV_WIDTH), 0.1),
        'rwkv_a0': nrm((L, RWKV_WIDTH), 0.3),
        'rwkv_a2': nrm((L, RWKV_ICLR_RANK, RWKV_WIDTH), 0.1),
        'rwkv_g2': nrm((L, RWKV_GATE_RANK, RWKV_WIDTH), RWKV_GATE_RANK ** -0.5),
        'rwkv_k_k': 0.85 + nrm((L, RWKV_WIDTH), 0.05),
        'rwkv_k_a': 1.0 + nrm((L, RWKV_WIDTH), 0.05),
        'rwkv_r_k': nrm((L, RWKV_HEADS, HEAD_DIM), 0.1),
        'rwkv_ln_w': 1.0 + nrm((L, RWKV_WIDTH), 0.02),
        'rwkv_ln_b': nrm((L, RWKV_WIDTH), 0.02),
        'nsa_pe_k': nrm((L, NSA_CMP_LEN, HEAD_DIM), 0.1),
        'nsa_pe_v': nrm((L, NSA_CMP_LEN, HEAD_DIM), 0.1),
        'nsa_ck_w1': nrm((L, cmp_in, NSA_CMP_HIDDEN), cmp_in ** -0.5),
        'nsa_ck_w2': nrm((L, NSA_CMP_HIDDEN, HEAD_DIM), NSA_CMP_HIDDEN ** -0.5),
        'nsa_cv_w1': nrm((L, cmp_in, NSA_CMP_HIDDEN), cmp_in ** -0.5),
        'nsa_cv_w2': nrm((L, NSA_CMP_HIDDEN, HEAD_DIM), NSA_CMP_HIDDEN ** -0.5),
        'swa_sinks': nrm((L, SWA_Q_HEADS), 0.5),
        'w_br_a': nrm((L, RWKV_WIDTH, D), RWKV_WIDTH ** -0.5),
        'w_br_b': nrm((L, NSA_Q_HEADS * HEAD_DIM, D), (NSA_Q_HEADS * HEAD_DIM) ** -0.5),
        'w_br_c': nrm((L, SWA_Q_HEADS * HEAD_DIM, D), (SWA_Q_HEADS * HEAD_DIM) ** -0.5),
        'w_out': nrm((L, D, D), D ** -0.5),
        'peer_wq': nrm((L, D, PEER_HEADS * PEER_QDIM), D ** -0.5),
        'peer_subkeys': nrm((L, PEER_HEADS, 2, PEER_NKEYS, PEER_QDIM // 2), (PEER_QDIM // 2) ** -0.5),
        'peer_u': nrm((L, PEER_EXPERTS, D), D ** -0.5),
        'peer_v': nrm((L, PEER_EXPERTS, D), 0.5 * PEER_HEADS ** -0.5),
    }


def reference(x, ln1_w, ln2_w, lnf_w, rel_bias, w_in, rwkv_mu, rwkv_w0, rwkv_w2, rwkv_a0, rwkv_a2,
              rwkv_g2, rwkv_k_k, rwkv_k_a, rwkv_r_k, rwkv_ln_w, rwkv_ln_b, nsa_pe_k, nsa_pe_v,
              nsa_ck_w1, nsa_ck_w2, nsa_cv_w1, nsa_cv_w2, swa_sinks, w_br_a, w_br_b, w_br_c, w_out,
              peer_wq, peer_subkeys, peer_u, peer_v):
    nsa_tbl = rel_bias[:, :NSA_Q_HEADS]
    swa_tbl = rel_bias[:, NSA_Q_HEADS:]
    for l in range(DEPTH):
        u = rmsnorm(x, ln1_w[l])
        proj = u @ w_in[l]
        rw = token_shift(proj[..., :RWKV_COLS], rwkv_mu[l])
        zr, zk, zv, zw, za, zg = split_cols(rw, RWKV_SPLITS)
        cols = split_cols(proj[..., RWKV_COLS:], NSA_SPLITS + SWA_SPLITS + GATE_SPLITS)
        nq, nkc, nvc, nks, nvs, nkw, nvw, ngate = cols[:8]
        sq, sk, sv = cols[8:11]
        g_a, g_b, g_c = [jax.nn.sigmoid(c) for c in cols[11:14]]
        o_a = rwkv7_mixer(zr, zk, zv, zw, za, zg, rwkv_w0[l], rwkv_w2[l], rwkv_a0[l], rwkv_a2[l],
                          rwkv_g2[l], rwkv_k_k[l], rwkv_k_a[l], rwkv_r_k[l], rwkv_ln_w[l], rwkv_ln_b[l])
        o_b = nsa_mixer(nq, nkc, nvc, nks, nvs, nkw, nvw, ngate, nsa_pe_k[l], nsa_pe_v[l],
                        nsa_ck_w1[l], nsa_ck_w2[l], nsa_cv_w1[l], nsa_cv_w2[l], nsa_tbl)
        o_c = swa_sink_mixer(sq, sk, sv, swa_sinks[l], swa_tbl)
        merged = g_a * (o_a @ w_br_a[l]) + g_b * (o_b @ w_br_b[l]) + g_c * (o_c @ w_br_c[l])
        x = x + merged @ w_out[l]
        x = x + peer_ffn(rmsnorm(x, ln2_w[l]), peer_wq[l], peer_subkeys[l], peer_u[l], peer_v[l])
    return rmsnorm(x, lnf_w)
```

```cpp
#include <hip/hip_runtime.h>
#include <cstdio>
#include <cstdint>
#define DI __device__ __forceinline__
#define GAS __attribute__((address_space(1)))
#define LAS __attribute__((address_space(3)))
typedef unsigned short bf16;
typedef unsigned v4u __attribute__((ext_vector_type(4)));
typedef unsigned v2u __attribute__((ext_vector_type(2)));
typedef float f32x2 __attribute__((ext_vector_type(2)));
typedef float f32x4 __attribute__((ext_vector_type(4)));
typedef float f32x16 __attribute__((ext_vector_type(16)));
typedef short bf16x8 __attribute__((ext_vector_type(8)));
typedef short s16x4 __attribute__((ext_vector_type(4)));
typedef __bf16 bfx2 __attribute__((ext_vector_type(2)));
struct U3 { unsigned a, b, c; };

namespace pg8 {
#define PG8_LAS __attribute__((address_space(3)))
typedef unsigned short bf16_t;
typedef short bf16x8 __attribute__((ext_vector_type(8)));
typedef float f32x4 __attribute__((ext_vector_type(4)));
typedef unsigned u32x4 __attribute__((ext_vector_type(4)));
constexpr int BM = 256, BK = 64, HALF = 128, HTB = HALF * BK * 2  , STAGE_BYTES = 8 * HTB, NXCD = 8, WGM = 8;

__host__ __device__ __forceinline__ int lds_byte(int r, int c) { const int st = (r >> 4) * 2 + (c >> 5), rr = r & 15, cc = c & 31, ob = rr * 64 + cc * 2; return st * 1024 + (ob ^ (((ob >> 9) & 1) << 5)); }
__host__ __device__ __forceinline__ void stage_rc(int b, int& R, int& C) { const int st = b / 1024, sb = b % 1024, swz = sb ^ (((sb >> 9) & 1) << 5); R = (st >> 1) * 16 + swz / 64; C = (st & 1) * 32 + (swz % 64) / 2; }
__host__ __device__ __forceinline__ int perm32(int rho) { const int n = rho >> 4, i = rho & 15; return 8 * (i >> 2) + 4 * n + (i & 3); }

struct Unit { int pm, pn; };
struct Gemm { const bf16_t* A; const bf16_t* Bt; int M, N, K; };

struct StaticOrder {
    int nM, nN, nwg, G, c;
    __host__ __device__ void init(int M, int N, int G_, int c_) { nM = M / BM; nN = N / BM; nwg = nM * nN; G = G_; c = c_; }
    __host__ __device__ bool next(int i, Unit& u) const {
        const long L = (long)i * G + c; if (L >= nwg) return false;
        int wgid = (int)L; { const int q = nwg / NXCD, r = nwg % NXCD, xcd = wgid % NXCD, off = wgid / NXCD; wgid = (xcd < r ? xcd * (q + 1) : r * (q + 1) + (xcd - r) * q) + off; }
        const int nig = WGM * nN, gid = wgid / nig, fm = gid * WGM, gsz = (nM - fm) < WGM ? (nM - fm) : WGM;
        u.pm = fm + ((wgid % nig) % gsz); u.pn = (wgid % nig) / gsz; return true;
    }
    __device__ __forceinline__ void a_ready(const Unit&) const {}
    __device__ __forceinline__ void done(const Unit&) const {}
};

__device__ __forceinline__ unsigned cvt_pk_bf16(float lo, float hi) { unsigned r; asm volatile("v_cvt_pk_bf16_f32 %0, %1, %2" : "=v"(r) : "v"(lo), "v"(hi)); return r; }
typedef float f32x2 __attribute__((ext_vector_type(2)));
__device__ __forceinline__ f32x2 gelu_pk(f32x2 v) {
    const f32x2 av = __builtin_elementwise_abs(v), d = av * 0.2316418882f + 1.0f;
    f32x2 t; t.x = __builtin_amdgcn_rcpf(d.x); t.y = __builtin_amdgcn_rcpf(d.y);
    f32x2 q = t * 0.5307027145f + (-0.7265760135f); q = q * t + 0.7107068705f; q = q * t + (-0.142248368f); q = q * t + 0.127414796f; q = q * t;
    const f32x2 s = (v * v) * (-0.72134752044f);
    f32x2 e; e.x = __builtin_amdgcn_exp2f(s.x); e.y = __builtin_amdgcn_exp2f(s.y);
    const f32x2 m = v * (q * e), r = v - m;
    f32x2 o; o.x = v.x < 0.f ? m.x : r.x; o.y = v.y < 0.f ? m.y : r.y; return o;
}

__device__ __forceinline__ float sigm(float x) { return __builtin_amdgcn_rcpf(1.0f + __expf(-x)); }
struct EpiBf16P {
    static constexpr bool PERM = true, AFTER_DRAIN = false;
    bf16_t* O; int ldc; unsigned kvmask; bf16_t* KV0; bf16_t* KV1;
    __device__ __forceinline__ void operator()(const f32x4 (&acc)[2][2][4][2], const Unit& u, int wr, int wc, int fr, int fq) const {
        const int row0 = u.pm * BM + wr * 64 + fr; int col0 = u.pn * BM + wc * 32 + 8 * fq, ld = ldc; bf16_t* base = O;
        if ((kvmask >> u.pn) & 1u) { const int slot = __builtin_popcount(kvmask & ((1u << u.pn) - 1u)); base = (slot < 2 ? KV0 : KV1) + (size_t)(slot & 1) * 16384 * 256; ld = 256; col0 = wc * 32 + 8 * fq; }
#pragma unroll
        for (int ai = 0; ai < 2; ++ai)
#pragma unroll
            for (int m = 0; m < 4; ++m) { bf16_t* rowp = base + (size_t)(row0 + ai * HALF + m * 16) * ld + col0;
#pragma unroll
                for (int bj = 0; bj < 2; ++bj) { const f32x4 v0 = acc[ai][bj][m][0], v1 = acc[ai][bj][m][1];
                    u32x4 w; w.x = cvt_pk_bf16(v0[0], v0[1]); w.y = cvt_pk_bf16(v0[2], v0[3]); w.z = cvt_pk_bf16(v1[0], v1[1]); w.w = cvt_pk_bf16(v1[2], v1[3]);
                    *(u32x4*)(rowp + bj * HALF) = w; } }
    }
};
struct EpiMerge {
    static constexpr bool PERM = true, AFTER_DRAIN = false;
    const bf16_t* G; int ldg; bf16_t* O; int accum; float bscale;
    __device__ __forceinline__ void operator()(const f32x4 (&acc)[2][2][4][2], const Unit& u, int wr, int wc, int fr, int fq) const {
        const int row0 = u.pm * BM + wr * 64 + fr, col0 = u.pn * BM + wc * 32 + 8 * fq;
#pragma unroll
        for (int ai = 0; ai < 2; ++ai)
#pragma unroll
            for (int m = 0; m < 4; ++m) { int rowi = row0 + ai * HALF + m * 16; asm volatile("" : "+v"(rowi)); const size_t row = (size_t)rowi;
#pragma unroll
                for (int bj = 0; bj < 2; ++bj) {
                    const u32x4 g = *(const u32x4*)(G + row * ldg + col0 + bj * HALF);
                    u32x4 p = (u32x4){0u, 0u, 0u, 0u}; if (accum) p = *(const u32x4*)(O + row * 1024 + col0 + bj * HALF);
                    float o[8];
#pragma unroll
                    for (int e = 0; e < 4; ++e) {
                        const float g0 = __uint_as_float(g[e] << 16), g1 = __uint_as_float(g[e] & 0xffff0000u);
                        const float p0 = __uint_as_float(p[e] << 16), p1 = __uint_as_float(p[e] & 0xffff0000u);
                        const float a0 = acc[ai][bj][m][e >> 1][(e & 1) * 2], a1 = acc[ai][bj][m][e >> 1][(e & 1) * 2 + 1];
                        o[2 * e] = p0 + sigm(g0) * a0 * bscale; o[2 * e + 1] = p1 + sigm(g1) * a1 * bscale; }
                    u32x4 w; w.x = cvt_pk_bf16(o[0], o[1]); w.y = cvt_pk_bf16(o[2], o[3]); w.z = cvt_pk_bf16(o[4], o[5]); w.w = cvt_pk_bf16(o[6], o[7]);
                    *(u32x4*)(O + row * 1024 + col0 + bj * HALF) = w; }
                asm volatile("" ::: "memory"); }
    }
};
struct EpiResid {
    static constexpr bool PERM = false, AFTER_DRAIN = false;
    const float* X; float* O;
    __device__ __forceinline__ void operator()(const f32x4 (&acc)[2][2][4][2], const Unit& u, int wr, int wc, int fr, int fq) const {
        const int row0 = u.pm * BM + wr * 64 + fr, col0 = u.pn * BM + wc * 32 + 4 * fq;
#pragma unroll
        for (int ai = 0; ai < 2; ++ai) { f32x4 xv[4][2][2];
#pragma unroll
            for (int m = 0; m < 4; ++m) { const size_t off = (size_t)(row0 + ai * HALF + m * 16) * 1024 + col0;
#pragma unroll
                for (int bj = 0; bj < 2; ++bj)
#pragma unroll
                    for (int n = 0; n < 2; ++n) xv[m][bj][n] = *(const f32x4*)(X + off + bj * HALF + n * 16); }
            __builtin_amdgcn_sched_barrier(0);
#pragma unroll
            for (int m = 0; m < 4; ++m) { const size_t off = (size_t)(row0 + ai * HALF + m * 16) * 1024 + col0;
#pragma unroll
                for (int bj = 0; bj < 2; ++bj)
#pragma unroll
                    for (int n = 0; n < 2; ++n) *(f32x4*)(O + off + bj * HALF + n * 16) = xv[m][bj][n] + acc[ai][bj][m][n]; }
            __builtin_amdgcn_sched_barrier(0); }
    }
};
template <class Epi, class Sched, bool ALIGN_EPI = false, bool SP2 = false>
__device__ __forceinline__ void gemm_phase(PG8_LAS unsigned char* lds, const Gemm g, const Sched& S, const Epi& E) {
    int tid_ = threadIdx.x; asm volatile("" : "+v"(tid_));
    const int tid = tid_, wid = __builtin_amdgcn_readfirstlane(tid >> 6), lane = tid & 63, wr = wid >> 2, wc = wid & 3, fr = lane & 15, fq = lane >> 4;
    const int K = g.K, nt = K / BK;
    unsigned voffA[2], voffB[2];
#pragma unroll
    for (int i = 0; i < 2; ++i) { int R, C; stage_rc(tid * 16 + i * 8192, R, C); const int Rb = Epi::PERM ? ((R & ~31) + perm32(R & 31)) : R;
        voffA[i] = (unsigned)(R * K + C) * 2u; voffB[i] = (unsigned)(Rb * K + C) * 2u; }
    const size_t kstep = (size_t)(BK * 2);
    const size_t hstep = (size_t)HALF * K * 2;
    const size_t tstep = 2 * hstep;
    const unsigned ldsw = (unsigned)wid * 1024u;
    const int aoff = lds_byte(wr * 64 + fr, fq * 8), boff = lds_byte(wc * 32 + fr, fq * 8);
#define PG8_SA(b, h) (((b) * 2 + (h)) * HTB)
#define PG8_SB(b, h) ((4 + (b) * 2 + (h)) * HTB)
#define PG8_STAGE(bufoff, gbase, voff) do { _Pragma("unroll") for (int _i = 0; _i < 2; ++_i) \
        __builtin_amdgcn_global_load_lds((const unsigned*)((const char*)(gbase) + (voff)[_i]), (PG8_LAS unsigned*)(lds + (bufoff) + ldsw + _i * 8192), 16, 0, 0); } while (0)
#define PG8_LDA(dst, b, h) do { _Pragma("unroll") for (int m = 0; m < 4; ++m) _Pragma("unroll") for (int k = 0; k < 2; ++k) dst[m][k] = *(const PG8_LAS bf16x8*)(lds + PG8_SA(b, h) + aoff + m * 2048 + k * 1024); } while (0)
#define PG8_LDB(dst, b, h) do { _Pragma("unroll") for (int n = 0; n < 2; ++n) _Pragma("unroll") for (int k = 0; k < 2; ++k) dst[n][k] = *(const PG8_LAS bf16x8*)(lds + PG8_SB(b, h) + boff + n * 2048 + k * 1024); } while (0)
#define PG8_MMA(ai, bj, At, Bt) do { __builtin_amdgcn_s_setprio(1); _Pragma("unroll") for (int m = 0; m < 4; ++m) _Pragma("unroll") for (int n = 0; n < 2; ++n) _Pragma("unroll") for (int k = 0; k < 2; ++k) \
        acc[ai][bj][m][n] = __builtin_amdgcn_mfma_f32_16x16x32_bf16(Bt[n][k], At[m][k], acc[ai][bj][m][n], 0, 0, 0); __builtin_amdgcn_s_setprio(0); } while (0)
#define PG8_WAIT_V(n) asm volatile("s_waitcnt vmcnt(" #n ")" ::: "memory")
#define PG8_WAIT_L(n) asm volatile("s_waitcnt lgkmcnt(" #n ")" ::: "memory")
#define PG8_BAR __builtin_amdgcn_s_barrier()
#define PG8_SCHED __builtin_amdgcn_sched_barrier(0)
    Unit cur, nxt; int ui = 0;
    if (!S.next(0, cur)) return;
    f32x4 acc[2][2][4][2];
#pragma unroll
    for (int a = 0; a < 2; ++a)
#pragma unroll
        for (int b = 0; b < 2; ++b)
#pragma unroll
            for (int m = 0; m < 4; ++m)
#pragma unroll
                for (int n = 0; n < 2; ++n) acc[a][b][m][n] = (f32x4){0.f, 0.f, 0.f, 0.f};
    bf16x8 At[4][2], B0[2][2], B1[2][2];
    const char* cA = (const char*)g.A + (size_t)cur.pm * tstep; const char* cB = (const char*)g.Bt + (size_t)cur.pn * tstep;
    S.a_ready(cur);
    if constexpr (SP2) {
        PG8_STAGE(PG8_SB(0, 0), cB, voffB); PG8_STAGE(PG8_SB(0, 1), cB + hstep, voffB); PG8_STAGE(PG8_SA(0, 0), cA, voffA); PG8_STAGE(PG8_SA(0, 1), cA + hstep, voffA);
        if (wr == 1) PG8_BAR;
        PG8_WAIT_V(2); PG8_BAR;
        PG8_STAGE(PG8_SB(1, 0), cB + kstep, voffB); PG8_STAGE(PG8_SA(1, 0), cA + kstep, voffA); PG8_STAGE(PG8_SB(1, 1), cB + hstep + kstep, voffB);
        PG8_WAIT_V(6); PG8_BAR;
    } else {
        PG8_STAGE(PG8_SB(0, 0), cB, voffB); PG8_STAGE(PG8_SA(0, 0), cA, voffA); PG8_STAGE(PG8_SB(0, 1), cB + hstep, voffB); PG8_STAGE(PG8_SA(0, 1), cA + hstep, voffA);
        if (wr == 1) PG8_BAR;
        PG8_WAIT_V(4); PG8_BAR;
        PG8_STAGE(PG8_SB(1, 0), cB + kstep, voffB); PG8_STAGE(PG8_SA(1, 0), cA + kstep, voffA); PG8_STAGE(PG8_SB(1, 1), cB + hstep + kstep, voffB);
        PG8_WAIT_V(6); PG8_BAR;
    }
    for (;;) {
        const bool has_next = S.next(ui + 1, nxt);
        const char* nA = has_next ? (const char*)g.A + (size_t)nxt.pm * tstep : cA; const char* nB = has_next ? (const char*)g.Bt + (size_t)nxt.pn * tstep : cB;
        for (int t = 0; t < nt; t += 2) {
            const bool last = (t == nt - 2);
            const char* a1 = cA + (size_t)(t + 1) * kstep;
            const char* a2 = last ? nA : cA + (size_t)(t + 2) * kstep; const char* b2 = last ? nB : cB + (size_t)(t + 2) * kstep;
            const char* a3 = a2 + kstep; const char* b3 = b2 + kstep;
            if (last && has_next) S.a_ready(nxt);
            if constexpr (SP2) {
            PG8_LDB(B0, 0, 0); PG8_LDB(B1, 0, 1); PG8_SCHED; PG8_LDA(At, 0, 0); PG8_STAGE(PG8_SA(1, 1), a1 + hstep, voffA);
            PG8_WAIT_V(8); PG8_WAIT_L(0); PG8_BAR; PG8_MMA(0, 0, At, B0); PG8_MMA(0, 1, At, B1); PG8_BAR; PG8_SCHED;
            PG8_LDA(At, 0, 1); PG8_STAGE(PG8_SB(0, 0), b2, voffB); PG8_STAGE(PG8_SB(0, 1), b2 + hstep, voffB); PG8_STAGE(PG8_SA(0, 0), a2, voffA);
            PG8_WAIT_V(8); PG8_WAIT_L(0); PG8_BAR; PG8_MMA(1, 0, At, B0); PG8_MMA(1, 1, At, B1); PG8_BAR; PG8_SCHED;
            PG8_LDB(B0, 1, 0); PG8_LDB(B1, 1, 1); PG8_SCHED; PG8_LDA(At, 1, 0); PG8_STAGE(PG8_SA(0, 1), a2 + hstep, voffA);
            PG8_WAIT_V(8); PG8_WAIT_L(0); PG8_BAR; PG8_MMA(0, 0, At, B0); PG8_MMA(0, 1, At, B1); PG8_BAR; PG8_SCHED;
            PG8_LDA(At, 1, 1); PG8_STAGE(PG8_SB(1, 0), b3, voffB); PG8_STAGE(PG8_SB(1, 1), b3 + hstep, voffB); PG8_STAGE(PG8_SA(1, 0), a3, voffA);
            PG8_WAIT_V(8); PG8_WAIT_L(0); PG8_BAR; PG8_MMA(1, 0, At, B0); PG8_MMA(1, 1, At, B1); PG8_BAR; PG8_SCHED;
            } else {
            PG8_LDB(B0, 0, 0); PG8_SCHED; PG8_LDA(At, 0, 0); PG8_STAGE(PG8_SA(1, 1), a1 + hstep, voffA);
            PG8_WAIT_L(8); PG8_BAR; PG8_WAIT_L(0); PG8_MMA(0, 0, At, B0); PG8_BAR; PG8_SCHED;
            PG8_LDB(B1, 0, 1); PG8_STAGE(PG8_SB(0, 0), b2, voffB);
            PG8_BAR; PG8_WAIT_L(0); PG8_MMA(0, 1, At, B1); PG8_BAR;
            PG8_LDA(At, 0, 1); PG8_STAGE(PG8_SA(0, 0), a2, voffA);
            PG8_BAR; PG8_WAIT_L(0); PG8_MMA(1, 0, At, B0); PG8_BAR; PG8_SCHED;
            PG8_STAGE(PG8_SB(0, 1), b2 + hstep, voffB);
            PG8_WAIT_V(6); PG8_BAR; PG8_MMA(1, 1, At, B1); PG8_BAR;
            PG8_LDB(B0, 1, 0); PG8_SCHED; PG8_LDA(At, 1, 0); PG8_STAGE(PG8_SA(0, 1), a2 + hstep, voffA);
            PG8_WAIT_L(8); PG8_BAR; PG8_WAIT_L(0); PG8_MMA(0, 0, At, B0); PG8_BAR; PG8_SCHED;
            PG8_LDB(B1, 1, 1); PG8_STAGE(PG8_SB(1, 0), b3, voffB);
            PG8_BAR; PG8_WAIT_L(0); PG8_MMA(0, 1, At, B1); PG8_BAR;
            PG8_LDA(At, 1, 1); PG8_STAGE(PG8_SA(1, 0), a3, voffA);
            PG8_BAR; PG8_WAIT_L(0); PG8_MMA(1, 0, At, B0); PG8_BAR; PG8_SCHED;
            PG8_STAGE(PG8_SB(1, 1), b3 + hstep, voffB);
            PG8_WAIT_V(6); PG8_BAR; PG8_MMA(1, 1, At, B1); PG8_BAR;
            }
        }
        if constexpr (ALIGN_EPI) { if (wr == 0) PG8_BAR; }
        if constexpr (!Epi::AFTER_DRAIN) { E(acc, cur, wr, wc, fr, fq); S.done(cur); }
        if (!has_next) break;
#pragma unroll
        for (int a = 0; a < 2; ++a)
#pragma unroll
            for (int b = 0; b < 2; ++b)
#pragma unroll
                for (int m = 0; m < 4; ++m)
#pragma unroll
                    for (int n = 0; n < 2; ++n) acc[a][b][m][n] = (f32x4){0.f, 0.f, 0.f, 0.f};
        cur = nxt; cA = nA; cB = nB; ++ui;
        if constexpr (ALIGN_EPI) { if (wr == 1) PG8_BAR; }
    }
    PG8_WAIT_V(0);
    if constexpr (!ALIGN_EPI) { if (wr == 0) PG8_BAR; }
    PG8_BAR;
    if constexpr (Epi::AFTER_DRAIN) { E.fused(acc, cur, wr, wc, fr, fq, lds, wid, lane); S.done(cur); }
#undef PG8_SA
#undef PG8_SB
#undef PG8_STAGE
#undef PG8_LDA
#undef PG8_LDB
#undef PG8_MMA
#undef PG8_WAIT_V
#undef PG8_WAIT_L
#undef PG8_BAR
#undef PG8_SCHED
}
}

#ifndef REP_PREP
#define REP_PREP 1
#endif
#ifndef REP_SCAN
#define REP_SCAN 1
#endif
#ifndef REP_NSA
#define REP_NSA 1
#endif
#ifndef REP_SWA
#define REP_SWA 1
#endif
#ifndef REP_PRO
#define REP_PRO 1
#endif
#ifndef REP_NORM2
#define REP_NORM2 1
#endif
#ifndef REP_WIN
#define REP_WIN 1
#endif
#ifndef REP_MERGE
#define REP_MERGE 1
#endif
#ifndef REP_PQ
#define REP_PQ 1
#endif
#ifndef REP_PEER
#define REP_PEER 1
#endif
#define DBG_ZERO 0
constexpr int NWAVES = 8, NT = 512;
constexpr int BATCH = 2, SEQ = 8192, D = 1024, M = BATCH * SEQ, LAYERS = 2;
constexpr int NP = 7168;
constexpr int C_R = 0, C_K = 512, C_V = 1024, C_W = 1536, C_A = 1600, C_G = 1664;
constexpr int C_NQ = 1792, C_NKC = 2304, C_NVC = 2432, C_NKS = 2560, C_NVS = 2688, C_NKW = 2816, C_NVW = 2944, C_NG = 3072;
constexpr int PAD_A = 3096, PAD_B = 3328;
constexpr int C_SQ = 3328, C_SK = 3840, C_SV = 3968, C_GA = 4096;
constexpr float PU_SCALE = 64.f, PV_SCALE = 11.f;
constexpr float LOG2E = 1.4426950408889634f;
constexpr float NEG_INF = -__builtin_huge_valf();

constexpr size_t MiB = 1u << 20, KiB = 1u << 10;
constexpr size_t WS_CTL = 0, CTL_ZERO_BYTES = 1 * MiB;
constexpr size_t WS_WIN = 1 * MiB;
constexpr size_t WS_WBR = 29 * MiB;
constexpr size_t WS_WOUT = 35 * MiB;
constexpr size_t WS_WQ = 39 * MiB;
constexpr size_t WS_SK = 47 * MiB;
constexpr size_t WS_CW1 = 48 * MiB;
constexpr size_t WS_CW2 = 52 * MiB;
constexpr size_t WS_RW = 52 * MiB + 256 * KiB;
constexpr size_t WS_PROJ = 54 * MiB;
constexpr size_t WS_XN = 278 * MiB;
constexpr size_t WS_OA = 310 * MiB, WS_OB = 326 * MiB, WS_OC = 342 * MiB;
constexpr size_t WS_REC = 358 * MiB;
constexpr size_t WS_G = 472 * MiB;
constexpr size_t WS_BON = 470 * MiB;
constexpr size_t WS_KCMP = 471 * MiB, WS_VCMP = 471 * MiB + 256 * KiB;
constexpr size_t WS_PU = 358 * MiB, WS_PV = 374 * MiB;
constexpr size_t WS_PQ = WS_PROJ;
constexpr size_t WS_SLIST = WS_PROJ + 64 * MiB;
constexpr size_t WS_KV0 = 454 * MiB, WS_KV1 = 490 * MiB;
constexpr unsigned KV_TILE_MASK = (1u << 9) | (1u << 10) | (1u << 11) | (1u << 15);
constexpr size_t WS_END = 506 * MiB;
constexpr int CW_BAR = 4096;

constexpr int LDS_BYTES = 155648;
constexpr int MISC_OFF = LDS_BYTES - 256;

DI float bflo(unsigned u) { return __uint_as_float(u << 16); }
DI float bfhi(unsigned u) { return __uint_as_float(u & 0xffff0000u); }
DI unsigned pk(float a, float b) { f32x2 v = {a, b}; return __builtin_bit_cast(unsigned, __builtin_convertvector(v, bfx2)); }
DI float sigm(float x) { return __builtin_amdgcn_rcpf(1.0f + __expf(-x)); }
DI float gelu_erf(float x) { return 0.5f * x * (1.0f + erff(x * 0.70710678118654752f)); }
DI float dpp_f(float v, const int ctrl_unused) { return v; }
#define DPPQ(v, ctrl) __builtin_bit_cast(float, __builtin_amdgcn_update_dpp(0, __builtin_bit_cast(int, (v)), (ctrl), 0xF, 0xF, true))
#define DPP_ADD(v, ctrl) ((v) + __builtin_bit_cast(float, __builtin_amdgcn_update_dpp(0, __builtin_bit_cast(int, (v)), (ctrl), 0xF, 0xF, true)))
DI float row16_sum(float v) {
    v = DPP_ADD(v, 0xB1); v = DPP_ADD(v, 0x4E); v = DPP_ADD(v, 0x141); v = DPP_ADD(v, 0x140); return v; }
DI float oct_sum(float v) {
    v = DPP_ADD(v, 0xB1); v = DPP_ADD(v, 0x4E); v = DPP_ADD(v, 0x141); return v; }
DI float wave_sum(float v) {
    v = row16_sum(v);
    const float a = __builtin_bit_cast(float, __builtin_amdgcn_readlane(__builtin_bit_cast(int, v), 0));
    const float b = __builtin_bit_cast(float, __builtin_amdgcn_readlane(__builtin_bit_cast(int, v), 16));
    const float c = __builtin_bit_cast(float, __builtin_amdgcn_readlane(__builtin_bit_cast(int, v), 32));
    const float d = __builtin_bit_cast(float, __builtin_amdgcn_readlane(__builtin_bit_cast(int, v), 48));
    return (a + b) + (c + d); }
DI bf16x8 pack8(const float (&z)[8]) { v4u p; p.x = pk(z[0], z[1]); p.y = pk(z[2], z[3]); p.z = pk(z[4], z[5]); p.w = pk(z[6], z[7]); return __builtin_bit_cast(bf16x8, p); }
DI void unpack8(v4u u, float (&z)[8]) {
#pragma unroll
    for (int e = 0; e < 4; ++e) { z[2 * e] = bflo(u[e]); z[2 * e + 1] = bfhi(u[e]); } }
#define MFMA16(a, b, c) __builtin_amdgcn_mfma_f32_16x16x32_bf16((a), (b), (c), 0, 0, 0)
#define MFMA32(a, b, c) __builtin_amdgcn_mfma_f32_32x32x16_bf16((a), (b), (c), 0, 0, 0)
DI int crow(int reg, int hh) { return (reg & 3) + 8 * (reg >> 2) + 4 * hh; }

struct Args { const float* in[32]; float* out; unsigned char* ws; int ph_lo, ph_hi; };
enum { I_X = 0, I_LN1, I_LN2, I_LNF, I_REL, I_WIN, I_MU, I_W0, I_W2, I_A0, I_A2, I_G2, I_KK, I_KA, I_RK, I_LNW, I_LNB, I_PEK, I_PEV, I_CKW1, I_CKW2, I_CVW1, I_CVW2,
       I_SINK, I_WBA, I_WBB, I_WBC, I_WOUT, I_PWQ, I_PSK, I_PU, I_PV };
__device__ const unsigned char T5_BK[128] = {0, 1, 2, 3, 4, 5, 6, 7, 8, 9, 10, 11, 12, 13, 14, 15, 16, 16, 16, 17, 17, 18, 18, 18, 19, 19, 19, 20, 20, 20, 20, 21, 21, 21, 21, 22, 22, 22, 22, 22, 23, 23, 23, 23, 23, 23, 24, 24, 24, 24, 24, 24, 25, 25, 25, 25, 25, 25, 25, 26, 26, 26, 26, 26, 26, 26, 26, 27, 27, 27, 27, 27, 27, 27, 27, 27, 27, 28, 28, 28, 28, 28, 28, 28, 28, 28, 28, 29, 29, 29, 29, 29, 29, 29, 29, 29, 29, 29, 29, 30, 30, 30, 30, 30, 30, 30, 30, 30, 30, 30, 30, 30, 30, 31, 31, 31, 31, 31, 31, 31, 31, 31, 31, 31, 31, 31, 31, 31};

#define XB_TMO      128
#define XB_XCNT(j)  (256  + 64 * (j))
#define XB_XSUB(j)  (1280 + 64 * (j))
#define XB_XGEN(j)  (2304 + 64 * (j))
#define XB_TOP      3328
#define XB_TOPGEN   3392
#define XCD_BAR_WORDS 3456
#define XB_SPIN_CAP (1u << 18)

__device__ __forceinline__ unsigned xb_ld(unsigned* p)              { return __hip_atomic_load(p, __ATOMIC_RELAXED, __HIP_MEMORY_SCOPE_AGENT); }
__device__ __forceinline__ unsigned xb_add(unsigned* p, unsigned v) { return __hip_atomic_fetch_add(p, v, __ATOMIC_RELAXED, __HIP_MEMORY_SCOPE_AGENT); }
__device__ __forceinline__ unsigned xb_xcc_id() { return (unsigned)__builtin_amdgcn_s_getreg((3 << 11) | 20) & 0xFu; }
#define XB_SPIN(cond, bar) do { unsigned _sp = 0; while (cond) { __builtin_amdgcn_s_sleep(1); \
    if ((++_sp & 255u) == 0u) { if (xb_ld(&(bar)[XB_TMO])) break; if (_sp > XB_SPIN_CAP) { atomicAdd(&(bar)[XB_TMO], 1u); break; } } } } while (0)

struct XcdBarrier {
    unsigned* bar; unsigned x;
    volatile LAS unsigned* st;
};

__device__ __forceinline__ XcdBarrier xcd_barrier_post(unsigned* bar, volatile LAS unsigned* st) {
    XcdBarrier b; b.bar = bar; b.x = xb_xcc_id(); b.st = st;
    if (threadIdx.x == 0) (void)xb_add(&bar[XB_XCNT(b.x)], 1u);
    return b;
}
__device__ __forceinline__ void xcd_barrier_complete(unsigned* bar, unsigned x, unsigned& nloc, unsigned& nx) {
    const unsigned G = gridDim.x * gridDim.y * gridDim.z;
    unsigned sum, cnt, mine, sp = 0u;
    for (;;) {
        sum = 0u; cnt = 0u; mine = 0u;
#pragma unroll
        for (unsigned j = 0; j < 16; ++j) { const unsigned c = xb_ld(&bar[XB_XCNT(j)]); sum += c; cnt += (c > 0u) ? 1u : 0u; mine = (j == x) ? c : mine; }
        if (sum == G) break;
        __builtin_amdgcn_s_sleep(1);
        if ((++sp & 255u) == 0u) { if (xb_ld(&bar[XB_TMO])) break; if (sp > XB_SPIN_CAP) { atomicAdd(&bar[XB_TMO], 1u); break; } }
    }
    nloc = mine > 0u ? mine : 1u; nx = cnt > 0u ? cnt : 1u;
}

__device__ __forceinline__ void xcd_barrier(const XcdBarrier& b) {
    asm volatile("s_waitcnt vmcnt(0)" ::: "memory");
    __syncthreads();
    if (threadIdx.x == 0) {
        unsigned* bar = b.bar;
        __builtin_amdgcn_s_waitcnt(0);
        unsigned nloc = b.st[0], nx = b.st[1];
        if (nloc == 0u) { xcd_barrier_complete(bar, b.x, nloc, nx); b.st[0] = nloc; b.st[1] = nx; }
        const unsigned old = xb_add(&bar[XB_XSUB(b.x)], 1u);
        const unsigned gen = old / nloc;
        if (old + 1u == (gen + 1u) * nloc) {
            __builtin_amdgcn_fence(__ATOMIC_RELEASE, "agent");
            asm volatile("s_waitcnt vmcnt(0)" ::: "memory");
            const unsigned og = xb_add(&bar[XB_TOP], 1u);
            const unsigned tg = og / nx;
            if (og + 1u == (tg + 1u) * nx) xb_add(&bar[XB_TOPGEN], 1u);
            else XB_SPIN(xb_ld(&bar[XB_TOPGEN]) == tg, bar);
            __builtin_amdgcn_fence(__ATOMIC_ACQUIRE, "agent");
            xb_add(&bar[XB_XGEN(b.x)], 1u);
            asm volatile("s_waitcnt vmcnt(0)" ::: "memory");
        } else {
            XB_SPIN(xb_ld(&bar[XB_XGEN(b.x)]) == gen, bar);
            __builtin_amdgcn_fence(__ATOMIC_ACQUIRE, "agent");
            asm volatile("s_waitcnt vmcnt(0)" ::: "memory");
        }
    }
    __syncthreads();
}

DI void tr_item(const float* W, int K, int Nsrc, bf16* WT, int pa, int pb, LAS float* scr, int item, int nblk, int lane) {
    const int kb = item / nblk, nb = item % nblk, k0 = 64 * kb, n0 = 64 * nb;
    const int nq = lane & 15, r = n0 + 4 * nq;
    const int sc = r < pa ? r : (r < pb ? -1 : r - (pb - pa));
    const float* wp = W + (size_t)(k0 + (lane >> 4)) * Nsrc + (sc >= 0 ? sc : 0);
    f32x4 v[16];
#pragma unroll
    for (int i = 0; i < 16; ++i) v[i] = *(const f32x4*)(wp + (size_t)(4 * i) * Nsrc);
    __builtin_amdgcn_sched_barrier(0);
#pragma unroll
    for (int i = 0; i < 16; ++i) { if (sc < 0) v[i] = (f32x4){0.f, 0.f, 0.f, 0.f}; *(LAS f32x4*)(scr + (4 * i + (lane >> 4)) * 68 + 4 * nq) = v[i]; }
    asm volatile("s_waitcnt lgkmcnt(0)" ::: "memory");
    const int c = lane & 7;
#pragma unroll
    for (int j = 0; j < 8; ++j) { const int n = (lane >> 3) + 8 * j; const LAS float* s = scr + (8 * c) * 68 + n;
        v4u o; o.x = pk(s[0 * 68], s[1 * 68]); o.y = pk(s[2 * 68], s[3 * 68]); o.z = pk(s[4 * 68], s[5 * 68]); o.w = pk(s[6 * 68], s[7 * 68]);
        *(v4u*)(WT + (size_t)(n0 + n) * K + k0 + 8 * c) = o; }
    asm volatile("s_waitcnt lgkmcnt(0)" ::: "memory");
}
#define TR_MAT(W, K, Nsrc, Ndst, WT, pa, pb) do { const int nblk_ = (Ndst) / 64, nit_ = ((K) / 64) * nblk_; int st_ = gw - base_; if (st_ < 0) st_ += NGW; \
    for (int it_ = st_; it_ < nit_; it_ += NGW) tr_item((W), (K), (Nsrc), (WT), (pa), (pb), scr, it_, nblk_, lane); base_ = (base_ + nit_) % NGW; } while (0)
DI void cvt_copy(const float* src, bf16* dst, size_t n, size_t gtid, size_t gthreads) {
    for (size_t i = gtid * 8; i < n; i += gthreads * 8) {
        const f32x4 a = *(const f32x4*)(src + i), b = *(const f32x4*)(src + i + 4);
        v4u o; o.x = pk(a[0], a[1]); o.y = pk(a[2], a[3]); o.z = pk(b[0], b[1]); o.w = pk(b[2], b[3]);
        *(v4u*)(dst + i) = o; }
}
DI void p_prologue(const Args& a, LAS unsigned char* lds, int tid) {
    const int lane = tid & 63, wave = tid >> 6, gw = blockIdx.x * NWAVES + wave, NGW = gridDim.x * NWAVES;
    LAS float* scr = (LAS float*)(lds + wave * 17408);
    unsigned char* ws = a.ws;
    int base_ = 0;
    for (int l = 0; l < LAYERS; ++l) {
        TR_MAT(a.in[I_WIN] + (size_t)l * 1024 * 6936, 1024, 6936, NP, (bf16*)(ws + WS_WIN) + (size_t)l * NP * 1024, PAD_A, PAD_B);
        TR_MAT(a.in[I_WBA] + (size_t)l * 512 * 1024, 512, 1024, 1024, (bf16*)(ws + WS_WBR) + (size_t)(l * 3 + 0) * 1024 * 512, 1 << 30, 1 << 30);
        TR_MAT(a.in[I_WBB] + (size_t)l * 512 * 1024, 512, 1024, 1024, (bf16*)(ws + WS_WBR) + (size_t)(l * 3 + 1) * 1024 * 512, 1 << 30, 1 << 30);
        TR_MAT(a.in[I_WBC] + (size_t)l * 512 * 1024, 512, 1024, 1024, (bf16*)(ws + WS_WBR) + (size_t)(l * 3 + 2) * 1024 * 512, 1 << 30, 1 << 30);
        TR_MAT(a.in[I_WOUT] + (size_t)l * 1024 * 1024, 1024, 1024, 1024, (bf16*)(ws + WS_WOUT) + (size_t)l * 1024 * 1024, 1 << 30, 1 << 30);
        TR_MAT(a.in[I_PWQ] + (size_t)l * 1024 * 2048, 1024, 2048, 2048, (bf16*)(ws + WS_WQ) + (size_t)l * 2048 * 1024, 1 << 30, 1 << 30);
        TR_MAT(a.in[I_CKW1] + (size_t)l * 2048 * 256, 2048, 256, 256, (bf16*)(ws + WS_CW1) + (size_t)(l * 2 + 0) * 256 * 2048, 1 << 30, 1 << 30);
        TR_MAT(a.in[I_CVW1] + (size_t)l * 2048 * 256, 2048, 256, 256, (bf16*)(ws + WS_CW1) + (size_t)(l * 2 + 1) * 256 * 2048, 1 << 30, 1 << 30);
        TR_MAT(a.in[I_CKW2] + (size_t)l * 256 * 64, 256, 64, 64, (bf16*)(ws + WS_CW2) + (size_t)(l * 2 + 0) * 64 * 256, 1 << 30, 1 << 30);
        TR_MAT(a.in[I_CVW2] + (size_t)l * 256 * 64, 256, 64, 64, (bf16*)(ws + WS_CW2) + (size_t)(l * 2 + 1) * 64 * 256, 1 << 30, 1 << 30);
        bf16* rw = (bf16*)(ws + WS_RW) + (size_t)l * 131072;
        TR_MAT(a.in[I_W2] + (size_t)l * 64 * 512, 64, 512, 512, rw, 1 << 30, 1 << 30);
        TR_MAT(a.in[I_A2] + (size_t)l * 64 * 512, 64, 512, 512, rw + 512 * 64, 1 << 30, 1 << 30);
        TR_MAT(a.in[I_G2] + (size_t)l * 128 * 512, 128, 512, 512, rw + 2 * 512 * 64, 1 << 30, 1 << 30);
    }
    cvt_copy(a.in[I_PSK], (bf16*)(ws + WS_SK), (size_t)LAYERS * 16 * 128 * 128, (size_t)blockIdx.x * NT + tid, (size_t)gridDim.x * NT);
}

DI void rms_row_bf16(const float* xrow, const float* w, bf16* orow, int lane) {
    const f32x4* xr = (const f32x4*)xrow + lane;
    f32x4 v[4]; float s = 0.f;
#pragma unroll
    for (int j = 0; j < 4; ++j) v[j] = xr[64 * j];
    __builtin_amdgcn_sched_barrier(0);
#pragma unroll
    for (int j = 0; j < 4; ++j) s += (v[j].x * v[j].x + v[j].y * v[j].y) + (v[j].z * v[j].z + v[j].w * v[j].w);
    const float rs = rsqrtf(wave_sum(s) * (1.f / D) + 1e-6f);
    f32x4 wv[4];
#pragma unroll
    for (int j = 0; j < 4; ++j) wv[j] = ((const f32x4*)w)[lane + 64 * j];
    __builtin_amdgcn_sched_barrier(0);
#pragma unroll
    for (int j = 0; j < 4; ++j) { const f32x4 o = v[j] * rs * wv[j];
        v2u p; p.x = pk(o.x, o.y); p.y = pk(o.z, o.w); ((v2u*)orow)[lane + 64 * j] = p; }
}
DI void p_rms(const float* x, const float* w, bf16* out, int tid) {
    const int lane = tid & 63, gw = blockIdx.x * NWAVES + (tid >> 6), NGW = gridDim.x * NWAVES;
    for (int m = gw; m < M; m += NGW) rms_row_bf16(x + (size_t)m * D, w, out + (size_t)m * D, lane);
}

DI void load_shift8(const bf16* cur, const bf16* prv, bool hp, const float* mu, float (&z)[8]) {
    const v4u c = *(const v4u*)cur; v4u p = *(const v4u*)(hp ? prv : cur);
    const f32x4 m0 = *(const f32x4*)mu, m1 = *(const f32x4*)(mu + 4);
    if (!hp) p = (v4u){0u, 0u, 0u, 0u};
    float cf[8], pf[8]; unpack8(c, cf); unpack8(p, pf);
#pragma unroll
    for (int e = 0; e < 8; ++e) { const float mm = e < 4 ? m0[e & 3] : m1[e & 3]; z[e] = cf[e] + mm * (pf[e] - cf[e]); }
}
struct Sh4 { v2u c, p; f32x4 m; };
DI void ls4_ld(const bf16* cur, const bf16* prv, bool hp, const float* mu, Sh4& s) { s.c = *(const v2u*)cur; s.p = *(const v2u*)(hp ? prv : cur); s.m = *(const f32x4*)mu; }
DI void ls4_mix(const Sh4& s, bool hp, float (&z)[4]) {
    v2u p = s.p; if (!hp) p = (v2u){0u, 0u};
    const float c0 = bflo(s.c.x), c1 = bfhi(s.c.x), c2 = bflo(s.c.y), c3 = bfhi(s.c.y), p0 = bflo(p.x), p1 = bfhi(p.x), p2 = bflo(p.y), p3 = bfhi(p.y);
    z[0] = c0 + s.m[0] * (p0 - c0); z[1] = c1 + s.m[1] * (p1 - c1); z[2] = c2 + s.m[2] * (p2 - c2); z[3] = c3 + s.m[3] * (p3 - c3);
}
DI void load_shift4(const bf16* cur, const bf16* prv, bool hp, const float* mu, float (&z)[4]) { Sh4 s; ls4_ld(cur, prv, hp, mu, s); ls4_mix(s, hp, z); }
DI void rwkv_prep_item(const Args& a, int l, int item, int lane_in, LAS unsigned char* bfr, LAS float* ms) {
    int lane = lane_in; asm volatile("" : "+v"(lane));
    const int r16_ = lane & 15, q4_ = lane >> 4, m = (item >> 2) * 16 + r16_, tm = r16_ & 3, h_lo = (item & 3) * 2;
    const bool hp = (m & (SEQ - 1)) != 0;
    const bf16* prow = (const bf16*)(a.ws + WS_PROJ) + (size_t)m * NP; const bf16* pprev = prow - NP;
    const float* mu = a.in[I_MU] + l * 1792;
    { int q4 = q4_; asm volatile("" : "+v"(q4));
#pragma unroll
    for (int ks = 0; ks < 2; ++ks) { float z[8]; const int c = ks * 32 + q4 * 8;
        load_shift8(prow + C_W + c, pprev + C_W + c, hp, mu + C_W + c, z);
#pragma unroll
        for (int e = 0; e < 8; ++e) z[e] = tanhf(z[e]);
        *(LAS bf16x8*)(bfr + ks * 8192) = pack8(z); asm volatile("" : "+v"(q4) :: "memory");
        load_shift8(prow + C_A + c, pprev + C_A + c, hp, mu + C_A + c, z); *(LAS bf16x8*)(bfr + (2 + ks) * 8192) = pack8(z); asm volatile("" : "+v"(q4) :: "memory"); }
#pragma unroll
    for (int ks = 0; ks < 4; ++ks) { float z[8]; const int c = ks * 32 + q4 * 8;
        load_shift8(prow + C_G + c, pprev + C_G + c, hp, mu + C_G + c, z);
#pragma unroll
        for (int e = 0; e < 8; ++e) z[e] = sigm(z[e]);
        *(LAS bf16x8*)(bfr + (4 + ks) * 8192) = pack8(z); asm volatile("" : "+v"(q4) :: "memory"); }
    }
    const bf16* W2T = (const bf16*)(a.ws + WS_RW) + (size_t)l * 131072; const bf16* A2T = W2T + 512 * 64; const bf16* G2T = A2T + 512 * 64;
    float* BON = (float*)(a.ws + WS_BON);
#pragma unroll 1
    for (int h_ = h_lo; h_ < h_lo + 2; ++h_) {
        int h = h_, q4 = q4_, r16 = r16_, mv = m; asm volatile("" : "+v"(h), "+v"(q4), "+v"(r16), "+v"(mv));
        const bf16* prow = (const bf16*)(a.ws + WS_PROJ) + (size_t)mv * NP; const bf16* pprev = prow - NP;
        bf16* GB = (bf16*)(a.ws + WS_G);
        float ss = 0.f, bon = 0.f;
        { Sh4 sk[4]; f32x4 kkq[4];
#pragma unroll
          for (int mt = 0; mt < 4; ++mt) { const int ch = h * 64 + mt * 16 + q4 * 4; ls4_ld(prow + C_K + ch, pprev + C_K + ch, hp, mu + C_K + ch, sk[mt]); kkq[mt] = *(const f32x4*)(a.in[I_KK] + l * 512 + ch); }
          __builtin_amdgcn_sched_barrier(0);
#pragma unroll
          for (int mt = 0; mt < 4; ++mt) { float zk1[4]; ls4_mix(sk[mt], hp, zk1);
#pragma unroll
            for (int j = 0; j < 4; ++j) { const float kr = zk1[j] * kkq[mt][j]; ss += kr * kr; } } }
        asm volatile("" : "+v"(h), "+v"(q4), "+v"(r16) :: "memory");
        ss += __shfl_xor(ss, 16); ss += __shfl_xor(ss, 32);
        const float inv = rsqrtf(fmaxf(ss, 1e-12f));
        v4u FQ[2], FR[2], FA[2], FK[2]; float qall[4][4], rall[4][4];
        unsigned char* recb = a.ws + WS_REC + ((size_t)((mv >> 13) * 8 + h) * 2048 + ((mv & (SEQ - 1)) >> 2)) * 3072;
#pragma unroll
        for (int mt = 0; mt < 4; ++mt) {
            f32x4 ag = (f32x4){0.f, 0.f, 0.f, 0.f}; const int row = h * 64 + mt * 16 + r16, ch = h * 64 + mt * 16 + q4 * 4;
            bf16x8 gf[4];
#pragma unroll
            for (int ks = 0; ks < 4; ++ks) gf[ks] = *(const bf16x8*)(G2T + row * 128 + ks * 32 + q4 * 8);
            __builtin_amdgcn_sched_barrier(0);
#pragma unroll
            for (int ks = 0; ks < 4; ++ks) ag = MFMA16(gf[ks], *(const LAS bf16x8*)(bfr + (4 + ks) * 8192), ag);
            v2u gv; gv.x = pk(ag[0], ag[1]); gv.y = pk(ag[2], ag[3]); *(v2u*)(GB + (size_t)mv * 512 + ch) = gv;
            asm volatile("" : "+v"(h), "+v"(q4), "+v"(r16) :: "memory");
        }
#pragma unroll
        for (int mt = 0; mt < 4; ++mt) {
            f32x4 aw = (f32x4){0.f, 0.f, 0.f, 0.f}, aa = aw;
            const int row = h * 64 + mt * 16 + r16;
            const int ch = h * 64 + mt * 16 + q4 * 4; float zr[4], zv[4], zkm[4];
            bf16x8 wf[2], af2[2]; Sh4 sK, sR, sV;
#pragma unroll
            for (int ks = 0; ks < 2; ++ks) { wf[ks] = *(const bf16x8*)(W2T + row * 64 + ks * 32 + q4 * 8); af2[ks] = *(const bf16x8*)(A2T + row * 64 + ks * 32 + q4 * 8); }
            ls4_ld(prow + C_K + ch, pprev + C_K + ch, hp, mu + C_K + ch, sK); ls4_ld(prow + C_R + ch, pprev + C_R + ch, hp, mu + C_R + ch, sR); ls4_ld(prow + C_V + ch, pprev + C_V + ch, hp, mu + C_V + ch, sV);
            const f32x4 w0 = *(const f32x4*)(a.in[I_W0] + l * 512 + ch), a0 = *(const f32x4*)(a.in[I_A0] + l * 512 + ch), k_k = *(const f32x4*)(a.in[I_KK] + l * 512 + ch),
                        k_a = *(const f32x4*)(a.in[I_KA] + l * 512 + ch), r_k = *(const f32x4*)(a.in[I_RK] + l * 512 + ch);
            __builtin_amdgcn_sched_barrier(0);
#pragma unroll
            for (int ks = 0; ks < 2; ++ks) { aw = MFMA16(wf[ks], *(const LAS bf16x8*)(bfr + ks * 8192), aw); aa = MFMA16(af2[ks], *(const LAS bf16x8*)(bfr + (2 + ks) * 8192), aa); }
            ls4_mix(sK, hp, zkm); ls4_mix(sR, hp, zr); ls4_mix(sV, hp, zv);
            float qv[4], rv[4], kav[4], kkv[4], ahv[4], khv[4], w4a[4];
#pragma unroll
            for (int j = 0; j < 4; ++j) {
                const float y = -(w0[j] + aw[j]);
                const float sp = fmaxf(y, 0.f) + __logf(1.0f + __expf(-fabsf(y)));
                const float dec = __expf(-__expf(-sp - 0.5f));
                const float av_ = sigm(a0[j] + aa[j]);
                const float kk = zkm[j] * k_k[j] * inv;
                const float kpr = zkm[j] * (1.0f + (av_ - 1.0f) * k_a[j]);
                bon += zr[j] * kpr * r_k[j];
                float winc = dec;
                { const float t1 = DPPQ(winc, 0x90); winc *= (tm >= 1) ? t1 : 1.0f; const float t2 = DPPQ(winc, 0x44); winc *= (tm >= 2) ? t2 : 1.0f; }
                const float wsh = DPPQ(winc, 0x90), wexc = (tm == 0) ? 1.0f : wsh, w4 = DPPQ(winc, 0xFF), rw = __builtin_amdgcn_rcpf(winc);
                const float ah = kk * av_ * rw, kh = kpr * rw;
                qv[j] = wexc * kk; rv[j] = winc * zr[j]; kav[j] = ah * w4; kkv[j] = kh * w4; w4a[j] = w4;
                *(bf16*)(recb + 2560 + (size_t)(mt * 16 + q4 * 4 + j) * 8 + tm * 2) = (bf16)(pk(zv[j], 0.f) & 0xffffu);
                ahv[j] = ah; khv[j] = kh; qall[mt][j] = qv[j]; rall[mt][j] = rv[j];
            }
            { float ka4[4] = {0.f, 0.f, 0.f, 0.f}, kk4[4] = {0.f, 0.f, 0.f, 0.f};
#pragma unroll
              for (int jj = 0; jj < 4; ++jj) { const float a0_ = DPPQ(kav[jj], 0x00), a1_ = DPPQ(kav[jj], 0x55), a2_ = DPPQ(kav[jj], 0xAA), a3_ = DPPQ(kav[jj], 0xFF);
                  const float k0_ = DPPQ(kkv[jj], 0x00), k1_ = DPPQ(kkv[jj], 0x55), k2_ = DPPQ(kkv[jj], 0xAA), k3_ = DPPQ(kkv[jj], 0xFF); const bool mine = tm == jj;
                  ka4[0] = mine ? a0_ : ka4[0]; ka4[1] = mine ? a1_ : ka4[1]; ka4[2] = mine ? a2_ : ka4[2]; ka4[3] = mine ? a3_ : ka4[3];
                  kk4[0] = mine ? k0_ : kk4[0]; kk4[1] = mine ? k1_ : kk4[1]; kk4[2] = mine ? k2_ : kk4[2]; kk4[3] = mine ? k3_ : kk4[3]; }
              *(v4u*)(recb + 1024 + (size_t)(mt * 16 + q4 * 4 + tm) * 16) = (v4u){pk(ka4[0], ka4[1]), pk(ka4[2], ka4[3]), pk(kk4[0], kk4[1]), pk(kk4[2], kk4[3])};
              if (tm == 0) *(f32x4*)(recb + 2048 + (size_t)(mt * 16 + q4 * 4) * 4) = (f32x4){w4a[0], w4a[1], w4a[2], w4a[3]}; }
            FQ[mt >> 1][(mt & 1) * 2] = pk(qv[0], qv[1]); FQ[mt >> 1][(mt & 1) * 2 + 1] = pk(qv[2], qv[3]); FR[mt >> 1][(mt & 1) * 2] = pk(rv[0], rv[1]); FR[mt >> 1][(mt & 1) * 2 + 1] = pk(rv[2], rv[3]);
            FA[mt >> 1][(mt & 1) * 2] = pk(ahv[0], ahv[1]); FA[mt >> 1][(mt & 1) * 2 + 1] = pk(ahv[2], ahv[3]); FK[mt >> 1][(mt & 1) * 2] = pk(khv[0], khv[1]); FK[mt >> 1][(mt & 1) * 2 + 1] = pk(khv[2], khv[3]);
            asm volatile("" : "+v"(h), "+v"(q4), "+v"(r16) :: "memory");
        }
        bon += __shfl_xor(bon, 16); bon += __shfl_xor(bon, 32);
        if (q4_ == 0) BON[m * 8 + h_] = bon;
        {
            f32x4 dE = (f32x4){0.f, 0.f, 0.f, 0.f}, dF = dE, dG = dE, dH = dE;
#pragma unroll
            for (int ks = 0; ks < 2; ++ks) { const bf16x8 fq = __builtin_bit_cast(bf16x8, FQ[ks]), fr = __builtin_bit_cast(bf16x8, FR[ks]), fa = __builtin_bit_cast(bf16x8, FA[ks]), fk = __builtin_bit_cast(bf16x8, FK[ks]);
                dE = MFMA16(fq, fa, dE); dF = MFMA16(fq, fk, dF); dG = MFMA16(fr, fa, dG); dH = MFMA16(fr, fk, dH); }
            if (q4_ == (r16_ >> 2)) {
#pragma unroll
                for (int jj = 0; jj < 4; ++jj) { LAS float* cp = ms + ((q4_ * 4 + 0) * 4 + jj) * 4 + tm;
                    cp[0] = tm < jj ? dE[jj] : 0.f; cp[16] = tm < jj ? dF[jj] : 0.f; cp[32] = tm <= jj ? dG[jj] : 0.f; cp[48] = tm <= jj ? dH[jj] : 0.f; } }
            asm volatile("s_waitcnt lgkmcnt(0)" ::: "memory");
            const LAS f32x4* mp = (const LAS f32x4*)(ms + (r16_ >> 2) * 64);
            const f32x4 E1 = mp[1], E2 = mp[2], E3 = mp[3], F1 = mp[5], F2 = mp[6], F3 = mp[7], Grow = mp[8 + tm], Hrow = mp[12 + tm];
            asm volatile("s_waitcnt lgkmcnt(0)" ::: "memory");
            const float t10 = -E1[0], t21 = -E2[1], t32 = -E3[2], t20 = -E2[0] + E2[1] * E1[0], t31 = -E3[1] + E3[2] * E2[1], t30 = -E3[0] + E3[1] * E1[0] + E3[2] * E2[0] - E3[2] * E2[1] * E1[0];
            const float m10 = -F1[0], m20 = -(t21 * F1[0] + F2[0]), m21 = -F2[1], m30 = -(t31 * F1[0] + t32 * F2[0] + F3[0]), m31 = -(t32 * F2[1] + F3[1]), m32 = -F3[2];
            const float T0 = tm == 0 ? 1.f : (tm == 1 ? t10 : (tm == 2 ? t20 : t30)), T1 = tm == 0 ? 0.f : (tm == 1 ? 1.f : (tm == 2 ? t21 : t31)), T2 = tm < 2 ? 0.f : (tm == 2 ? 1.f : t32), T3 = tm == 3 ? 1.f : 0.f;
            const float M0 = tm == 0 ? 0.f : (tm == 1 ? m10 : (tm == 2 ? m20 : m30)), M1 = tm < 2 ? 0.f : (tm == 2 ? m21 : m31), M2_ = tm == 3 ? m32 : 0.f;
            const float P0 = Hrow[0] + (Grow[1] * m10 + Grow[2] * m20 + Grow[3] * m30), P1 = Hrow[1] + (Grow[2] * m21 + Grow[3] * m31), P2_ = Hrow[2] + Grow[3] * m32, P3 = Hrow[3];
#pragma unroll
            for (int mt = 0; mt < 4; ++mt) { float qp[4], rp[4];
#pragma unroll
                for (int j = 0; j < 4; ++j) { const float q0 = DPPQ(qall[mt][j], 0x00), q1 = DPPQ(qall[mt][j], 0x55), q2 = DPPQ(qall[mt][j], 0xAA), q3 = DPPQ(qall[mt][j], 0xFF);
                    qp[j] = -((T0 * q0 + T1 * q1) + (T2 * q2 + T3 * q3));
                    const float Q0 = DPPQ(qp[j], 0x00), Q1 = DPPQ(qp[j], 0x55), Q2 = DPPQ(qp[j], 0xAA), Q3 = DPPQ(qp[j], 0xFF);
                    rp[j] = rall[mt][j] + ((Grow[0] * Q0 + Grow[1] * Q1) + (Grow[2] * Q2 + Grow[3] * Q3)); }
                FQ[mt >> 1][(mt & 1) * 2] = pk(qp[0], qp[1]); FQ[mt >> 1][(mt & 1) * 2 + 1] = pk(qp[2], qp[3]); FR[mt >> 1][(mt & 1) * 2] = pk(rp[0], rp[1]); FR[mt >> 1][(mt & 1) * 2 + 1] = pk(rp[2], rp[3]); }
#pragma unroll
            for (int ks = 0; ks < 2; ++ks) { *(v4u*)(recb + (size_t)((ks * 4 + tm) * 4 + q4_) * 16) = FQ[ks]; *(v4u*)(recb + 512 + (size_t)((ks * 4 + tm) * 4 + q4_) * 16) = FR[ks]; }
            if (q4_ == (r16_ >> 2)) { *(v4u*)(recb + 2304 + tm * 16) = (v4u){pk(M0, M1), pk(M2_, 0.f), pk(P0, P1), pk(P2_, P3)};
                if (tm == 0) *(v4u*)(recb + 2368) = (v4u){0u, 0u, 0u, 0u}; }
        }
    }
}
constexpr int HSP = 264;
DI void compress_item(const Args& a, int l, int item, LAS unsigned char* lds, int tid) {
    const int kv = item >> 7, b = (item >> 6) & 1, g = (item >> 5) & 1, cb = item & 31;
    const int lane = tid & 63, w = tid >> 6, r16 = lane & 15, q4 = lane >> 4;
    const bf16* src = (const bf16*)(a.ws + WS_KV0) + (size_t)(b * SEQ) * 256 + (kv ? 128 : 0) + g * 64;
    const float* pe = a.in[kv ? I_PEV : I_PEK] + l * 2048;
    const bf16* W1T = (const bf16*)(a.ws + WS_CW1) + (size_t)(l * 2 + kv) * 256 * 2048;
    const bf16* W2T = (const bf16*)(a.ws + WS_CW2) + (size_t)(l * 2 + kv) * 64 * 256;
    LAS bf16* Hs = (LAS bf16*)lds;
    const int c = cb * 16 + r16;
    f32x4 acc[2] = {(f32x4){0.f, 0.f, 0.f, 0.f}, (f32x4){0.f, 0.f, 0.f, 0.f}};
#pragma unroll 1
    for (int k4 = 0; k4 < 64; k4 += 4) { v4u raw[4]; f32x4 p0[4], p1[4]; bf16x8 wf[4][2];
#pragma unroll
        for (int i = 0; i < 4; ++i) { const int ks = k4 + i, lt = ks >> 1, d0 = (ks & 1) * 32 + q4 * 8;
            int tokn = 16 * c + lt; tokn = tokn < SEQ ? tokn : SEQ - 1;
            raw[i] = *(const v4u*)(src + (size_t)tokn * 256 + d0);
            p0[i] = *(const f32x4*)(pe + lt * 64 + d0); p1[i] = *(const f32x4*)(pe + lt * 64 + d0 + 4);
#pragma unroll
            for (int t = 0; t < 2; ++t) wf[i][t] = *(const bf16x8*)(W1T + (size_t)((2 * w + t) * 16 + r16) * 2048 + ks * 32 + q4 * 8); }
        __builtin_amdgcn_sched_barrier(0);
#pragma unroll
        for (int i = 0; i < 4; ++i) { float z[8]; unpack8(raw[i], z);
#pragma unroll
            for (int e = 0; e < 8; ++e) z[e] += e < 4 ? p0[i][e & 3] : p1[i][e & 3];
            const bf16x8 af = pack8(z);
#pragma unroll
            for (int t = 0; t < 2; ++t) acc[t] = MFMA16(af, wf[i][t], acc[t]); }
        __builtin_amdgcn_sched_barrier(0);
    }
#pragma unroll
    for (int t = 0; t < 2; ++t)
#pragma unroll
        for (int j = 0; j < 4; ++j) Hs[(q4 * 4 + j) * HSP + (2 * w + t) * 16 + r16] = (bf16)(pk(gelu_erf(acc[t][j]), 0.f) & 0xffffu);
    __syncthreads();
    if (w < 4) { f32x4 o = (f32x4){0.f, 0.f, 0.f, 0.f}; bf16x8 w2f[8];
#pragma unroll
        for (int ks = 0; ks < 8; ++ks) w2f[ks] = *(const bf16x8*)(W2T + (w * 16 + r16) * 256 + ks * 32 + q4 * 8);
        __builtin_amdgcn_sched_barrier(0);
#pragma unroll
        for (int ks = 0; ks < 8; ++ks) o = MFMA16(*(const LAS bf16x8*)(Hs + r16 * HSP + ks * 32 + q4 * 8), w2f[ks], o);
        bf16* dst = (bf16*)(a.ws + (kv ? WS_VCMP : WS_KCMP)) + ((size_t)((b * 2 + g) * 512 + cb * 16 + q4 * 4)) * 64 + w * 16 + r16;
#pragma unroll
        for (int j = 0; j < 4; ++j) dst[j * 64] = (bf16)(pk(o[j], 0.f) & 0xffffu);
    }
    __syncthreads();
}
DI void p_prep(const Args& a, int l, LAS unsigned char* lds, int tid) {
    for (int rep = 0; rep < REP_PREP; ++rep) {
    for (int it = blockIdx.x; it < 256; it += gridDim.x) compress_item(a, l, it, lds, tid);
    const int lane = tid & 63, gw = blockIdx.x * NWAVES + (tid >> 6), NGW = gridDim.x * NWAVES;
    LAS unsigned char* bfr = lds + 16384 + tid * 16; asm volatile("" : "+v"(bfr));
    LAS float* ms = (LAS float*)(lds + 81920) + (tid >> 6) * 256;
    for (int it = gw; it < M / 4; it += NGW) rwkv_prep_item(a, l, it, lane, bfr, ms);
    }
}

constexpr int SC_STEPS = 16, SC_SLOT = SC_STEPS * 768, SC_NSLOT = 12, SC_NSEQ = SEQ / SC_STEPS;
#define SC_LOADSET(r, sq) do { _Pragma("unroll") for (int k_ = 0; k_ < 3; ++k_) r[k_] = *(const v4u*)(gp + (size_t)(sq) * SC_SLOT + k_ * 1024); } while (0)
#define SC_STAGE(r, sq) do { const int s_ = (sq); \
    if (s_ >= SC_NSLOT) { for (;;) { const unsigned m_ = min(min(FL[4], FL[5]), min(FL[6], FL[7])); if ((int)__builtin_amdgcn_readfirstlane(m_) >= s_ - (SC_NSLOT - 1)) break; __builtin_amdgcn_s_sleep(2); } } \
    asm volatile("" ::: "memory"); \
    _Pragma("unroll") for (int k_ = 0; k_ < 3; ++k_) *(LAS v4u*)(lp + ringoff + k_ * 1024) = r[k_]; \
    asm volatile("s_waitcnt lgkmcnt(0)" ::: "memory"); \
    if (lane == 0) FL[lw] = (unsigned)(s_ + 1); \
    if (s_ + 4 < SC_NSEQ) SC_LOADSET(r, s_ + 4); \
    ringoff += SC_SLOT; if (ringoff == SC_NSLOT * SC_SLOT) ringoff = 0; } while (0)
DI void scan_block(const Args& a, int bh, LAS unsigned char* lds, int tid) {
    const int lane = tid & 63, w = tid >> 6, b = bh >> 3, h = bh & 7;
    volatile LAS unsigned* FL = (volatile LAS unsigned*)(lds + MISC_OFF) + 32;
    if (tid < 8) FL[tid] = 0u;
    __syncthreads();
    const unsigned char* src = (const unsigned char*)(a.ws + WS_REC) + (size_t)(b * 8 + h) * SEQ * 768;
    if (w >= 4) {
        const int lw = w - 4;
        const unsigned char* gp = src + (lw * 192 + lane) * 16; LAS unsigned char* lp = lds + (lw * 192 + lane) * 16;
        v4u r0[3], r1[3], r2[3], r3[3]; int ringoff = 0;
        SC_LOADSET(r0, 0); SC_LOADSET(r1, 1); SC_LOADSET(r2, 2); SC_LOADSET(r3, 3);
#pragma unroll 1
        for (int sq = 0; sq < SC_NSEQ; sq += 4) { SC_STAGE(r0, sq); SC_STAGE(r1, sq + 1); SC_STAGE(r2, sq + 2); SC_STAGE(r3, sq + 3); }
    } else {
        const int r16 = lane & 15, q4 = lane >> 4; const bool lead = q4 == 0;
        bf16* yp = (bf16*)(a.ws + WS_OA) + (size_t)(b * SEQ) * 512 + h * 64 + 16 * w + r16;
        const int oq0 = r16 < 4 ? ((0 * 4 + r16) * 4 + q4) * 16 : 2368, oq1 = r16 < 4 ? ((1 * 4 + r16) * 4 + q4) * 16 : 2368, or0 = r16 < 4 ? 512 + ((0 * 4 + r16) * 4 + q4) * 16 : 2368, or1 = r16 < 4 ? 512 + ((1 * 4 + r16) * 4 + q4) * 16 : 2368;
        const int oa3 = (lead && r16 < 4) ? 2304 + r16 * 16 : 2368, ovv = lead ? 2560 + (16 * w + r16) * 8 : 2368, ok0 = lead ? 1024 + r16 * 16 : 2368, ok1 = lead ? 1024 + (16 + r16) * 16 : 2368,
                  ok2 = lead ? 1024 + (32 + r16) * 16 : 2368, ok3 = lead ? 1024 + (48 + r16) * 16 : 2368, ow = 2048 + 16 * q4;
        f32x4 acc[4];
#pragma unroll
        for (int jt = 0; jt < 4; ++jt) acc[jt] = (f32x4){0.f, 0.f, 0.f, 0.f};
#define SB_DECL(P) v4u P##aq0, P##aq1, P##ar0, P##ar1, P##a3, P##ak0, P##ak1, P##ak2, P##ak3; f32x4 P##w0, P##w1, P##w2, P##w3; v2u P##vv;
#define SB_LOAD(P, RB) do { const LAS unsigned char* rb_ = (RB); \
        P##aq0 = *(const LAS v4u*)(rb_ + oq0); P##aq1 = *(const LAS v4u*)(rb_ + oq1); P##ar0 = *(const LAS v4u*)(rb_ + or0); P##ar1 = *(const LAS v4u*)(rb_ + or1); P##a3 = *(const LAS v4u*)(rb_ + oa3); \
        P##ak0 = *(const LAS v4u*)(rb_ + ok0); P##ak1 = *(const LAS v4u*)(rb_ + ok1); P##ak2 = *(const LAS v4u*)(rb_ + ok2); P##ak3 = *(const LAS v4u*)(rb_ + ok3); \
        P##w0 = *(const LAS f32x4*)(rb_ + ow); P##w1 = *(const LAS f32x4*)(rb_ + ow + 64); P##w2 = *(const LAS f32x4*)(rb_ + ow + 128); P##w3 = *(const LAS f32x4*)(rb_ + ow + 192); \
        P##vv = *(const LAS v2u*)(rb_ + ovv); } while (0)
#define SB_COMPUTE(P, T0) do { \
        v4u b0, b1; \
        b0.x = pk(acc[0][0], acc[0][1]); b0.y = pk(acc[0][2], acc[0][3]); b0.z = pk(acc[1][0], acc[1][1]); b0.w = pk(acc[1][2], acc[1][3]); \
        b1.x = pk(acc[2][0], acc[2][1]); b1.y = pk(acc[2][2], acc[2][3]); b1.z = pk(acc[3][0], acc[3][1]); b1.w = pk(acc[3][2], acc[3][3]); \
        const v4u b3 = (v4u){P##vv.x, P##vv.y, 0u, 0u}, a3a = (v4u){P##a3.x, P##a3.y, 0u, 0u}, a3y = (v4u){P##a3.z, P##a3.w, 0u, 0u}; \
        const f32x4 zf_ = (f32x4){0.f, 0.f, 0.f, 0.f}; \
        f32x4 da = MFMA16(__builtin_bit_cast(bf16x8, a3a), __builtin_bit_cast(bf16x8, b3), zf_), dy = MFMA16(__builtin_bit_cast(bf16x8, a3y), __builtin_bit_cast(bf16x8, b3), zf_);     \
        da = MFMA16(__builtin_bit_cast(bf16x8, P##aq0), __builtin_bit_cast(bf16x8, b0), da); \
        const f32x4 da2 = MFMA16(__builtin_bit_cast(bf16x8, P##aq1), __builtin_bit_cast(bf16x8, b1), zf_);                    \
        dy = MFMA16(__builtin_bit_cast(bf16x8, P##ar0), __builtin_bit_cast(bf16x8, b0), dy); dy = MFMA16(__builtin_bit_cast(bf16x8, P##ar1), __builtin_bit_cast(bf16x8, b1), dy); \
        da = da + da2; \
        acc[0] = acc[0] * P##w0; acc[1] = acc[1] * P##w1; acc[2] = acc[2] * P##w2; acc[3] = acc[3] * P##w3; \
        const v4u bc = (v4u){pk(da[0], da[1]), pk(da[2], da[3]), P##vv.x, P##vv.y};        \
        acc[0] = MFMA16(__builtin_bit_cast(bf16x8, P##ak0), __builtin_bit_cast(bf16x8, bc), acc[0]); acc[1] = MFMA16(__builtin_bit_cast(bf16x8, P##ak1), __builtin_bit_cast(bf16x8, bc), acc[1]); \
        acc[2] = MFMA16(__builtin_bit_cast(bf16x8, P##ak2), __builtin_bit_cast(bf16x8, bc), acc[2]); acc[3] = MFMA16(__builtin_bit_cast(bf16x8, P##ak3), __builtin_bit_cast(bf16x8, bc), acc[3]); \
        if (lead) { bf16* yq = yp + (size_t)(T0) * 512; const unsigned p01 = pk(dy[0], dy[1]), p23 = pk(dy[2], dy[3]); \
            yq[0] = (bf16)(p01 & 0xffffu); yq[512] = (bf16)(p01 >> 16); yq[1024] = (bf16)(p23 & 0xffffu); yq[1536] = (bf16)(p23 >> 16); } } while (0)
#define SB_WAIT(SQ) do { for (;;) { const unsigned m_ = min(min(FL[0], FL[1]), min(FL[2], FL[3])); if ((int)__builtin_amdgcn_readfirstlane(m_) >= (SQ) + 1) break; __builtin_amdgcn_s_sleep(1); } asm volatile("" ::: "memory"); } while (0)
        SB_DECL(A_) SB_DECL(B_)
        int ringoff = 0;
        SB_WAIT(0); SB_LOAD(A_, lds);
#pragma unroll 1
        for (int sq = 0; sq < SC_NSEQ; ++sq) {
            const LAS unsigned char* sb = lds + ringoff; const int t0 = sq * SC_STEPS;
            int nxt = ringoff + SC_SLOT; if (nxt == SC_NSLOT * SC_SLOT) nxt = 0;
            SB_LOAD(B_, sb + 3072); SB_COMPUTE(A_, t0);
            SB_LOAD(A_, sb + 6144); SB_COMPUTE(B_, t0 + 4);
            SB_LOAD(B_, sb + 9216); SB_COMPUTE(A_, t0 + 8);
            if (sq + 1 < SC_NSEQ) { SB_WAIT(sq + 1); SB_LOAD(A_, lds + nxt); }
            SB_COMPUTE(B_, t0 + 12);
            asm volatile("s_waitcnt lgkmcnt(0)" ::: "memory");
            if (lane == 0) FL[4 + w] = (unsigned)(sq + 1);
            ringoff = nxt;
        }
    }
    __syncthreads();
}
DI void rwkv_post_row(const Args& a, int l, int m, int lane) {
    const int c = 8 * lane, h = lane >> 3, j0 = c & 63;
    bf16* yrow = (bf16*)(a.ws + WS_OA) + (size_t)m * 512 + c;
    float y[8], g[8]; unpack8(*(const v4u*)yrow, y); unpack8(*(const v4u*)((const bf16*)(a.ws + WS_G) + (size_t)m * 512 + c), g);
    const bf16* vvp = (const bf16*)(a.ws + WS_REC + ((size_t)((m >> 13) * 8 + h) * 2048 + ((m & (SEQ - 1)) >> 2)) * 3072 + 2560) + (size_t)j0 * 4 + (m & 3);
    float vrow[8];
#pragma unroll
    for (int e = 0; e < 8; ++e) vrow[e] = bflo((unsigned)vvp[e * 4]);
    const float bon = ((const float*)(a.ws + WS_BON))[m * 8 + h];
    float sm = 0.f;
#pragma unroll
    for (int e = 0; e < 8; ++e) sm += y[e];
    const float mean = oct_sum(sm) * (1.f / 64.f);
    float sv = 0.f;
#pragma unroll
    for (int e = 0; e < 8; ++e) { y[e] -= mean; sv += y[e] * y[e]; }
    const float rstd = rsqrtf(oct_sum(sv) * (1.f / 64.f) + 64e-5f);
    const f32x4 lw0 = *(const f32x4*)(a.in[I_LNW] + l * 512 + c), lw1 = *(const f32x4*)(a.in[I_LNW] + l * 512 + c + 4);
    const f32x4 lb0 = *(const f32x4*)(a.in[I_LNB] + l * 512 + c), lb1 = *(const f32x4*)(a.in[I_LNB] + l * 512 + c + 4);
    float o[8];
#pragma unroll
    for (int e = 0; e < 8; ++e) { const float lw = e < 4 ? lw0[e & 3] : lw1[e & 3], lb = e < 4 ? lb0[e & 3] : lb1[e & 3];
        const float v = vrow[e];
        o[e] = (y[e] * rstd * lw + lb + bon * v) * g[e]; }
    v4u w; w.x = pk(o[0], o[1]); w.y = pk(o[2], o[3]); w.z = pk(o[4], o[5]); w.w = pk(o[6], o[7]);
    *(v4u*)yrow = w;
}
DI void p_post(const Args& a, int l, int tid) {
    const int lane = tid & 63, gw = blockIdx.x * NWAVES + (tid >> 6), NGW = gridDim.x * NWAVES;
    for (int m = gw; m < M; m += NGW) rwkv_post_row(a, l, m, lane);
}

constexpr int KP = 144, VP = 136;
constexpr int L_KT0 = 0, L_VT0 = 9216, L_KT1 = 17920, L_VT1 = 27136, L_IMP = 35840, L_SELM = 68864, L_UNI = 69888, L_LIST = 69920, L_NLIST = 70432, L_LUT = 70448, L_FARB = 72496, L_Q = 73728;
DI void load_kv_regs(const bf16* Ksrc, size_t kp, const bf16* Vsrc, size_t vp, int row0, int tid, v4u& kr, v4u& vr) {
    const int key = tid >> 3, ch = tid & 7;
    kr = *(const v4u*)(Ksrc + (size_t)(row0 + key) * kp + ch * 8); vr = *(const v4u*)(Vsrc + (size_t)(row0 + key) * vp + ch * 8);
}
DI void store_kv_lds(LAS unsigned char* Kt, LAS unsigned char* Vt, int tid, v4u kr, v4u vr) {
    const int key = tid >> 3, ch = tid & 7;
    *(LAS v4u*)(Kt + key * KP + ch * 16) = kr;
    *(LAS v4u*)(Vt + (ch >> 2) * 4096 + key * 64 + (ch & 3) * 16) = vr;
}
DI void load_q(const bf16* qrow, float qs, int hh, LAS unsigned char* qf) {
_Pragma("unroll")
    for (int ks = 0; ks < 4; ++ks) { float z[8]; unpack8(*(const v4u*)(qrow + ks * 16 + hh * 8), z);
_Pragma("unroll")
        for (int e = 0; e < 8; ++e) z[e] *= qs;
        *(LAS bf16x8*)(qf + ks * 8192) = pack8(z); }
}
DI void qk_tile(const LAS unsigned char* Kt, const LAS unsigned char* qf, int r, int hh, f32x16& s0, f32x16& s1) {
_Pragma("unroll")
    for (int i = 0; i < 16; ++i) { s0[i] = 0.f; s1[i] = 0.f; }
_Pragma("unroll")
    for (int ks = 0; ks < 4; ++ks) {
        const bf16x8 a0 = *(const LAS bf16x8*)(Kt + r * KP + (ks * 16 + hh * 8) * 2), a1 = *(const LAS bf16x8*)(Kt + (32 + r) * KP + (ks * 16 + hh * 8) * 2);
        const bf16x8 qv = *(const LAS bf16x8*)(qf + ks * 8192);
        s0 = MFMA32(a0, qv, s0); s1 = MFMA32(a1, qv, s1); }
}
DI void qk_tile_r(const LAS unsigned char* Kt, const bf16x8 (&qr)[4], int r, int hh, f32x16& s0, f32x16& s1) {
_Pragma("unroll")
    for (int i = 0; i < 16; ++i) { s0[i] = 0.f; s1[i] = 0.f; }
_Pragma("unroll")
    for (int ks = 0; ks < 4; ++ks) {
        const bf16x8 a0 = *(const LAS bf16x8*)(Kt + r * KP + (ks * 16 + hh * 8) * 2), a1 = *(const LAS bf16x8*)(Kt + (32 + r) * KP + (ks * 16 + hh * 8) * 2);
        s0 = MFMA32(a0, qr[ks], s0); s1 = MFMA32(a1, qr[ks], s1); }
}
typedef short v4i16_t __attribute__((ext_vector_type(4)));
DI v2u vtr(const LAS unsigned char* p) { return __builtin_bit_cast(v2u, __builtin_amdgcn_ds_read_tr16_b64_v4i16((LAS v4i16_t*)p)); }
DI void pv_tile(const LAS unsigned char* Vt, const f32x16& p0, const f32x16& p1, int r, int hh, f32x16& o0, f32x16& o1) {
    const LAS unsigned char* vp = Vt + ((r >> 4) & 1) * 32 + (r & 3) * 8 + (4 * hh + ((r & 15) >> 2)) * 64;
_Pragma("unroll")
    for (int kk = 0; kk < 4; ++kk) {
        float z[8];
_Pragma("unroll")
        for (int e = 0; e < 8; ++e) z[e] = (kk < 2) ? p0[8 * (kk & 1) + e] : p1[8 * (kk & 1) + e];
        const bf16x8 pf = pack8(z);
_Pragma("unroll")
        for (int dt = 0; dt < 2; ++dt) {
            const v2u lo = vtr(vp + dt * 4096 + kk * 1024), hi = vtr(vp + dt * 4096 + kk * 1024 + 512);
            const bf16x8 af = __builtin_bit_cast(bf16x8, ((v4u){lo.x, lo.y, hi.x, hi.y}));
            if (dt == 0) o0 = MFMA32(af, pf, o0); else o1 = MFMA32(af, pf, o1); }
    }
}
DI void sm_update(f32x16& s0, f32x16& s1, float& m, float& lp, f32x16& o0, f32x16& o1) {
    float bm = NEG_INF;
_Pragma("unroll")
    for (int i = 0; i < 16; ++i) bm = fmaxf(bm, fmaxf(s0[i], s1[i]));
    bm = fmaxf(bm, __shfl_xor(bm, 32));
    const float mn = fmaxf(m, bm), ms = (mn == NEG_INF) ? 0.f : mn;
    const float alpha = __builtin_amdgcn_exp2f(m - ms);
    float ps = 0.f;
_Pragma("unroll")
    for (int i = 0; i < 16; ++i) { s0[i] = __builtin_amdgcn_exp2f(s0[i] - ms); s1[i] = __builtin_amdgcn_exp2f(s1[i] - ms); ps += s0[i] + s1[i]; }
    lp = lp * alpha + ps; m = mn;
    if (__builtin_amdgcn_ballot_w64(alpha != 1.0f) != 0ull) {
_Pragma("unroll")
        for (int i = 0; i < 16; ++i) { o0[i] *= alpha; o1[i] *= alpha; } }
}
DI void sm_update_row(f32x16& s0, f32x16& s1, float brow, float& m, float& lp, f32x16& o0, f32x16& o1) {
    float bm = fmaxf(s0[0], s1[0]);
_Pragma("unroll")
    for (int i = 1; i < 16; ++i) bm = fmaxf(bm, fmaxf(s0[i], s1[i]));
    bm = fmaxf(bm, __shfl_xor(bm, 32)) + brow;
    const float mn = fmaxf(m, bm), ms = (mn == NEG_INF) ? 0.f : mn;
    const float alpha = __builtin_amdgcn_exp2f(m - ms), off = brow - ms;
    float ps = 0.f;
_Pragma("unroll")
    for (int i = 0; i < 16; ++i) { s0[i] = __builtin_amdgcn_exp2f(s0[i] + off); s1[i] = __builtin_amdgcn_exp2f(s1[i] + off); ps += s0[i] + s1[i]; }
    lp = lp * alpha + ps; m = mn;
    if (__builtin_amdgcn_ballot_w64(alpha != 1.0f) != 0ull) {
_Pragma("unroll")
        for (int i = 0; i < 16; ++i) { o0[i] *= alpha; o1[i] *= alpha; } }
}
#define KV_LOOP(NBLK, ROW0_OF, KSRC, KPITCH, VSRC, VPITCH, ...) do { const int nb_ = (NBLK); if (nb_ > 0) { v4u kr_, vr_; \
    { const int i_ = 0; load_kv_regs((KSRC), (KPITCH), (VSRC), (VPITCH), (ROW0_OF), tid, kr_, vr_); } \
    store_kv_lds(lds + L_KT0, lds + L_VT0, tid, kr_, vr_); __syncthreads(); \
    for (int ib_ = 0; ib_ < nb_; ++ib_) { \
        if (ib_ + 1 < nb_) { const int i_ = ib_ + 1; load_kv_regs((KSRC), (KPITCH), (VSRC), (VPITCH), (ROW0_OF), tid, kr_, vr_); } \
        { const int i_ = ib_; const LAS unsigned char* Kt = lds + ((ib_ & 1) ? L_KT1 : L_KT0); const LAS unsigned char* Vt = lds + ((ib_ & 1) ? L_VT1 : L_VT0); __VA_ARGS__ } \
        if (ib_ + 1 < nb_) store_kv_lds(lds + ((ib_ & 1) ? L_KT0 : L_KT1), lds + ((ib_ & 1) ? L_VT0 : L_VT1), tid, kr_, vr_); \
        __syncthreads(); } } } while (0)

DI void store_o(bf16* orow, const f32x16& v0, const f32x16& v1, int hh) {
_Pragma("unroll")
    for (int g4 = 0; g4 < 4; ++g4) {
        v2u w; w.x = pk(v0[4 * g4], v0[4 * g4 + 1]); w.y = pk(v0[4 * g4 + 2], v0[4 * g4 + 3]); *(v2u*)(orow + 8 * g4 + 4 * hh) = w;
        w.x = pk(v1[4 * g4], v1[4 * g4 + 1]); w.y = pk(v1[4 * g4 + 2], v1[4 * g4 + 3]); *(v2u*)(orow + 32 + 8 * g4 + 4 * hh) = w; }
}

DI void add_o(bf16* orow, const f32x16& v0, const f32x16& v1, int hh) {
_Pragma("unroll")
    for (int g4 = 0; g4 < 4; ++g4) {
        v2u* p0 = (v2u*)(orow + 8 * g4 + 4 * hh); v2u* p1 = (v2u*)(orow + 32 + 8 * g4 + 4 * hh); const v2u a0 = *p0, a1 = *p1; v2u w;
        w.x = pk(bflo(a0.x) + v0[4 * g4], bfhi(a0.x) + v0[4 * g4 + 1]); w.y = pk(bflo(a0.y) + v0[4 * g4 + 2], bfhi(a0.y) + v0[4 * g4 + 3]); *p0 = w;
        w.x = pk(bflo(a1.x) + v1[4 * g4], bfhi(a1.x) + v1[4 * g4 + 1]); w.y = pk(bflo(a1.y) + v1[4 * g4 + 2], bfhi(a1.y) + v1[4 * g4 + 3]); *p1 = w; }
}
DI void nsa_tile(const Args& a, int l, int b, int g, int qt, LAS unsigned char* lds, int tid) {
    const int lane = tid & 63, w = tid >> 6, r = lane & 31, hh = lane >> 5, head = w >> 1, ql = 32 * (w & 1) + r;
    const int t0 = qt * 64, cur = qt, tq = t0 + ql, mq = b * SEQ + tq;
    const bf16* PROJ = (const bf16*)(a.ws + WS_PROJ);
    LAS unsigned* IMP = (LAS unsigned*)(lds + L_IMP); LAS unsigned* SELM = (LAS unsigned*)(lds + L_SELM); LAS unsigned* UNI = (LAS unsigned*)(lds + L_UNI);
    LAS int* LIST = (LAS int*)(lds + L_LIST); LAS int* NLIST = (LAS int*)(lds + L_NLIST); LAS float* LUT = (LAS float*)(lds + L_LUT); LAS float* FARB = (LAS float*)(lds + L_FARB);
    { const int hh_ = tid >> 7, dist = tid & 127; LUT[tid] = a.in[I_REL][(int)T5_BK[dist] * 16 + g * 4 + hh_] * LOG2E; if (tid < 4) FARB[tid] = a.in[I_REL][31 * 16 + g * 4 + tid] * LOG2E; }
    for (int i = tid; i < 64 * 129; i += NT) IMP[i] = 0u;
    if (tid < 4) UNI[tid] = 0u;
    LAS unsigned char* qf = lds + L_Q + tid * 16; asm volatile("" : "+v"(qf));
    load_q(PROJ + (size_t)mq * NP + C_NQ + (g * 4 + head) * 64, 0.125f * LOG2E, hh, qf);
    bf16* orow = (bf16*)(a.ws + WS_OB) + (size_t)mq * 512 + (g * 4 + head) * 64;
    float gc, gs, gw_;
    { const bf16* gp = PROJ + (size_t)mq * NP + C_NG + (g * 4 + head) * 3; gc = sigm(bflo((unsigned)gp[0])); gs = sigm(bflo((unsigned)gp[1])); gw_ = sigm(bflo((unsigned)gp[2])); }
    f32x16 o0, o1, s0, s1;
    __syncthreads();
    const bf16* Kc = (const bf16*)(a.ws + WS_KCMP) + (size_t)((b * 2 + g) * 512) * 64; const bf16* Vc = (const bf16*)(a.ws + WS_VCMP) + (size_t)((b * 2 + g) * 512) * 64;
    int ncv = 4 * cur + 3; ncv = ncv < 511 ? ncv : 511;
    const int ncb = (ncv + 63) >> 6;
    float m = NEG_INF, lp = 0.f;
    KV_LOOP(ncb, i_ * 64, Kc, 64, Vc, 64, {
        qk_tile(Kt, qf, r, hh, s0, s1);
_Pragma("unroll")
        for (int i = 0; i < 16; ++i) { const int c0 = i_ * 64 + crow(i, hh), c1 = c0 + 32;
            s0[i] = (16 * c0 + 31 <= tq && c0 < 511) ? s0[i] : NEG_INF; s1[i] = (16 * c1 + 31 <= tq && c1 < 511) ? s1[i] : NEG_INF; }
_Pragma("unroll")
        for (int i = 0; i < 16; ++i) { o0[i] = 0.f; o1[i] = 0.f; }
        sm_update(s0, s1, m, lp, o0, o1);
    });
    {
        const float lt = lp + __shfl_xor(lp, 32), inv = lt > 0.f ? 1.0f / lt : 0.f, ms = (m == NEG_INF) ? 0.f : m;
_Pragma("unroll")
        for (int i = 0; i < 16; ++i) { o0[i] = 0.f; o1[i] = 0.f; }
        KV_LOOP(ncb, i_ * 64, Kc, 64, Vc, 64, {
            qk_tile(Kt, qf, r, hh, s0, s1);
_Pragma("unroll")
            for (int i = 0; i < 16; ++i) { const int c0 = i_ * 64 + crow(i, hh), c1 = c0 + 32;
                s0[i] = (16 * c0 + 31 <= tq && c0 < 511) ? __builtin_amdgcn_exp2f(s0[i] - ms) * inv : 0.f; s1[i] = (16 * c1 + 31 <= tq && c1 < 511) ? __builtin_amdgcn_exp2f(s1[i] - ms) * inv : 0.f; }
_Pragma("unroll")
            for (int g4 = 0; g4 < 4; ++g4) {
                const int n0 = i_ * 16 + 2 * g4 + hh, n1 = n0 + 8;
                const float G0 = (s0[4 * g4] + s0[4 * g4 + 1]) + (s0[4 * g4 + 2] + s0[4 * g4 + 3]), G1 = (s1[4 * g4] + s1[4 * g4 + 1]) + (s1[4 * g4 + 2] + s1[4 * g4 + 3]);
                __hip_atomic_fetch_add(IMP + ql * 129 + n0, (unsigned)(G0 * 1048576.f + 0.5f), __ATOMIC_RELAXED, __HIP_MEMORY_SCOPE_WORKGROUP);
                __hip_atomic_fetch_add(IMP + ql * 129 + n0 + 1, (unsigned)(s0[4 * g4 + 3] * 1048576.f + 0.5f), __ATOMIC_RELAXED, __HIP_MEMORY_SCOPE_WORKGROUP);
                __hip_atomic_fetch_add(IMP + ql * 129 + n1, (unsigned)(G1 * 1048576.f + 0.5f), __ATOMIC_RELAXED, __HIP_MEMORY_SCOPE_WORKGROUP);
                __hip_atomic_fetch_add(IMP + ql * 129 + n1 + 1, (unsigned)(s1[4 * g4 + 3] * 1048576.f + 0.5f), __ATOMIC_RELAXED, __HIP_MEMORY_SCOPE_WORKGROUP); }
            pv_tile(Vt, s0, s1, r, hh, o0, o1);
        });
_Pragma("unroll")
        for (int i = 0; i < 16; ++i) { o0[i] *= gc; o1[i] *= gc; }
        store_o(orow, o0, o1, hh);
    }
    __syncthreads();
    {
        const int nforced = cur == 0 ? 1 : (cur == 1 ? 2 : 3), need = 16 - nforced, cnt = cur + 1 - nforced;
        for (int qq = 0; qq < 8; ++qq) { const int q = 8 * w + qq;
            const int n0 = lane, n1 = lane + 64;
            const bool f0 = (n0 == 0) || (n0 == cur) || (n0 == cur - 1), f1 = (n1 == cur) || (n1 == cur - 1);
            const bool v0 = n0 <= cur, v1 = n1 <= cur;
            unsigned i0 = IMP[q * 129 + n0], i1 = IMP[q * 129 + n1]; i0 = i0 < 0x1FFFFFEu ? i0 : 0x1FFFFFEu; i1 = i1 < 0x1FFFFFEu ? i1 : 0x1FFFFFEu;
            const unsigned k0 = (v0 && !f0) ? ((i0 << 7) | (unsigned)(127 - n0)) + 1u : 0u, k1 = (v1 && !f1) ? ((i1 << 7) | (unsigned)(127 - n1)) + 1u : 0u;
            unsigned T = 1u;
            if (cnt > need) { T = 0u;
                for (int bit = 31; bit >= 0; --bit) { const unsigned cand = T | (1u << bit);
                    const int c = __popcll(__ballot(k0 >= cand)) + __popcll(__ballot(k1 >= cand));
                    if (c >= need) T = cand; } }
            const bool sel0 = (k0 >= T && k0 != 0u) || (f0 && v0), sel1 = (k1 >= T && k1 != 0u) || (f1 && v1);
            const unsigned long long b0 = __ballot(sel0), b1 = __ballot(sel1);
            if (lane == 0) { SELM[q * 4] = (unsigned)b0; SELM[q * 4 + 1] = (unsigned)(b0 >> 32); SELM[q * 4 + 2] = (unsigned)b1; SELM[q * 4 + 3] = (unsigned)(b1 >> 32);
                __hip_atomic_fetch_or(UNI + 0, (unsigned)b0, __ATOMIC_RELAXED, __HIP_MEMORY_SCOPE_WORKGROUP); __hip_atomic_fetch_or(UNI + 1, (unsigned)(b0 >> 32), __ATOMIC_RELAXED, __HIP_MEMORY_SCOPE_WORKGROUP);
                __hip_atomic_fetch_or(UNI + 2, (unsigned)b1, __ATOMIC_RELAXED, __HIP_MEMORY_SCOPE_WORKGROUP); __hip_atomic_fetch_or(UNI + 3, (unsigned)(b1 >> 32), __ATOMIC_RELAXED, __HIP_MEMORY_SCOPE_WORKGROUP); }
        }
    }
    __syncthreads();
    if (w == 0) {
        const unsigned long long u0 = (unsigned long long)UNI[0] | ((unsigned long long)UNI[1] << 32), u1 = (unsigned long long)UNI[2] | ((unsigned long long)UNI[3] << 32);
        const unsigned long long lowm = (1ull << lane) - 1ull;
        if ((u0 >> lane) & 1ull) LIST[__popcll(u0 & lowm)] = lane;
        if ((u1 >> lane) & 1ull) LIST[__popcll(u0) + __popcll(u1 & lowm)] = 64 + lane;
        if (lane == 0) NLIST[0] = __popcll(u0) + __popcll(u1);
    }
    __syncthreads();
    const float farb = FARB[head];
    asm volatile("s_waitcnt vmcnt(0)" ::: "memory");
    __syncthreads();
    {
        const int tl2 = 8 * w + (r & 7), head2 = r >> 3, tq2 = t0 + tl2, mq2 = b * SEQ + tq2;
        { const bf16* qrow = PROJ + (size_t)mq2 * NP + C_NQ + (g * 4 + head2) * 64;
_Pragma("unroll")
          for (int ks = 0; ks < 4; ++ks) { float z[8]; unpack8(*(const v4u*)(qrow + ks * 16 + hh * 8), z);
_Pragma("unroll")
              for (int e = 0; e < 8; ++e) z[e] *= 0.125f * LOG2E;
              *(LAS bf16x8*)(qf + 32768 + ks * 8192) = pack8(z); } }
        const unsigned sw0 = SELM[tl2 * 4], sw1 = SELM[tl2 * 4 + 1], sw2 = SELM[tl2 * 4 + 2], sw3 = SELM[tl2 * 4 + 3];
        unsigned u0 = 0u, u1 = 0u, u2 = 0u, u3 = 0u;
_Pragma("unroll")
        for (int k = 0; k < 8; ++k) { u0 |= (unsigned)__builtin_amdgcn_readlane((int)sw0, k); u1 |= (unsigned)__builtin_amdgcn_readlane((int)sw1, k);
                                      u2 |= (unsigned)__builtin_amdgcn_readlane((int)sw2, k); u3 |= (unsigned)__builtin_amdgcn_readlane((int)sw3, k); }
        const unsigned long long ulo = (unsigned long long)u0 | ((unsigned long long)u1 << 32), uhi = (unsigned long long)u2 | ((unsigned long long)u3 << 32);
        const float farb2 = FARB[head2];
        const float gs2 = sigm(bflo((unsigned)(PROJ + (size_t)mq2 * NP + C_NG + (g * 4 + head2) * 3)[1]));
        const bf16* Ks = (const bf16*)(a.ws + WS_KV0) + (size_t)(M + b * SEQ) * 256 + g * 64; const bf16* Vs = Ks + 128;
        const int nl = NLIST[0];
        m = NEG_INF; lp = 0.f;
_Pragma("unroll")
        for (int i = 0; i < 16; ++i) { o0[i] = 0.f; o1[i] = 0.f; }
        KV_LOOP(nl, LIST[i_] * 64, Ks, 256, Vs, 256, {
            const int n = LIST[i_], kv0 = n * 64;
            const bool mine = n < 64 ? ((ulo >> n) & 1ull) : ((uhi >> (n - 64)) & 1ull);
            if (mine) {
_Pragma("unroll")
                for (int i = 0; i < 16; ++i) { s0[i] = 0.f; s1[i] = 0.f; }
_Pragma("unroll")
                for (int ks = 0; ks < 4; ++ks) { const bf16x8 qv = *(const LAS bf16x8*)(qf + 32768 + ks * 8192);
                    const bf16x8 a0 = *(const LAS bf16x8*)(Kt + r * KP + (ks * 16 + hh * 8) * 2), a1 = *(const LAS bf16x8*)(Kt + (32 + r) * KP + (ks * 16 + hh * 8) * 2);
                    s0 = MFMA32(a0, qv, s0); s1 = MFMA32(a1, qv, s1); }
                const unsigned swd = n < 32 ? sw0 : (n < 64 ? sw1 : (n < 96 ? sw2 : sw3));
                const bool selq = (swd >> (n & 31)) & 1u;
                float brow = selq ? farb2 : NEG_INF;
                if ((cur - n) < 3) { brow = 0.f;
_Pragma("unroll")
                    for (int i = 0; i < 16; ++i) { const int d0 = tq2 - (kv0 + crow(i, hh)), d1 = d0 - 32;
                        const float b0 = (d0 >= 128 || d0 < 0) ? farb2 : LUT[head2 * 128 + (d0 & 127)], b1 = (d1 >= 128 || d1 < 0) ? farb2 : LUT[head2 * 128 + (d1 & 127)];
                        s0[i] = (selq && d0 >= 0) ? s0[i] + b0 : NEG_INF; s1[i] = (selq && d1 >= 0) ? s1[i] + b1 : NEG_INF;
                        if ((i & 3) == 3) asm volatile("" ::: "memory"); }
                }
                sm_update_row(s0, s1, brow, m, lp, o0, o1);
                pv_tile(Vt, s0, s1, r, hh, o0, o1);
            }
        });
        const float lt = lp + __shfl_xor(lp, 32), sc = lt > 0.f ? gs2 / lt : 0.f;
_Pragma("unroll")
        for (int i = 0; i < 16; ++i) { o0[i] *= sc; o1[i] *= sc; }
        add_o((bf16*)(a.ws + WS_OB) + (size_t)mq2 * 512 + (g * 4 + head2) * 64, o0, o1, hh);
    }
    asm volatile("s_waitcnt vmcnt(0)" ::: "memory");
    __syncthreads();
    {
        const int nlo = cur >= 8 ? cur - 8 : 0;
        const bf16* Kw = (const bf16*)(a.ws + WS_KV1) + (size_t)(b * SEQ) * 256 + g * 64; const bf16* Vw = Kw + 128;
        m = NEG_INF; lp = 0.f;
_Pragma("unroll")
        for (int i = 0; i < 16; ++i) { o0[i] = 0.f; o1[i] = 0.f; }
        KV_LOOP(cur - nlo + 1, (nlo + i_) * 64, Kw, 256, Vw, 256, {
            const int kv0 = (nlo + i_) * 64, dn = cur - (nlo + i_);
            qk_tile(Kt, qf, r, hh, s0, s1);
            float brow = farb;
            if (dn < 3 || dn > 7) { brow = 0.f;
_Pragma("unroll")
                for (int i = 0; i < 16; ++i) { const int d0 = tq - (kv0 + crow(i, hh)), d1 = d0 - 32;
                    const float b0 = (d0 >= 128 || d0 < 0) ? farb : LUT[head * 128 + (d0 & 127)], b1 = (d1 >= 128 || d1 < 0) ? farb : LUT[head * 128 + (d1 & 127)];
                    s0[i] = (d0 >= 0 && d0 < 512) ? s0[i] + b0 : NEG_INF; s1[i] = (d1 >= 0 && d1 < 512) ? s1[i] + b1 : NEG_INF;
                    if ((i & 3) == 3) asm volatile("" ::: "memory"); }
            }
            sm_update_row(s0, s1, brow, m, lp, o0, o1);
            pv_tile(Vt, s0, s1, r, hh, o0, o1);
        });
        const float lt = lp + __shfl_xor(lp, 32), sc = lt > 0.f ? gw_ / lt : 0.f;
_Pragma("unroll")
        for (int i = 0; i < 16; ++i) { o0[i] *= sc; o1[i] *= sc; }
        add_o(orow, o0, o1, hh);
    }
    __syncthreads();
}
DI void swa_tile(const Args& a, int l, int b, int g, int qt, LAS unsigned char* lds, int tid) {
    const int lane = tid & 63, w = tid >> 6, r = lane & 31, hh = lane >> 5, head = w >> 1, ql = 32 * (w & 1) + r;
    const int t0 = qt * 64, cur = qt, tq = t0 + ql, mq = b * SEQ + tq;
    const bf16* PROJ = (const bf16*)(a.ws + WS_PROJ);
    LAS float* LUT = (LAS float*)(lds + L_LUT);
    { const int hh_ = tid >> 7, dist = tid & 127; LUT[tid] = a.in[I_REL][(int)T5_BK[dist] * 16 + 8 + g * 4 + hh_] * LOG2E; }
    LAS unsigned char* qf = lds + L_Q + tid * 16; asm volatile("" : "+v"(qf));
    load_q(PROJ + (size_t)mq * NP + C_SQ + (g * 4 + head) * 64, 0.125f * LOG2E, hh, qf);
    const float sink = a.in[I_SINK][l * 8 + g * 4 + head] * LOG2E;
    f32x16 o0, o1, s0, s1;
_Pragma("unroll")
    for (int i = 0; i < 16; ++i) { o0[i] = 0.f; o1[i] = 0.f; }
    float m = sink, lp = hh == 0 ? 1.0f : 0.f;
    __syncthreads();
    const int nlo = cur >= 2 ? cur - 2 : 0;
    const bf16* Kw = (const bf16*)(a.ws + WS_KV1) + (size_t)(M + b * SEQ) * 256 + g * 64; const bf16* Vw = Kw + 128;
    KV_LOOP(cur - nlo + 1, (nlo + i_) * 64, Kw, 256, Vw, 256, {
        const int kv0 = (nlo + i_) * 64;
        qk_tile(Kt, qf, r, hh, s0, s1);
_Pragma("unroll")
        for (int i = 0; i < 16; ++i) { const int d0 = tq - (kv0 + crow(i, hh)), d1 = d0 - 32;
            s0[i] = (d0 >= 0 && d0 < 128) ? s0[i] + LUT[head * 128 + (d0 & 127)] : NEG_INF; s1[i] = (d1 >= 0 && d1 < 128) ? s1[i] + LUT[head * 128 + (d1 & 127)] : NEG_INF; }
        sm_update(s0, s1, m, lp, o0, o1);
        pv_tile(Vt, s0, s1, r, hh, o0, o1);
    });
    const float lt = lp + __shfl_xor(lp, 32), sc = 1.0f / lt;
_Pragma("unroll")
    for (int i = 0; i < 16; ++i) { o0[i] *= sc; o1[i] *= sc; }
    store_o((bf16*)(a.ws + WS_OC) + (size_t)mq * 512 + (g * 4 + head) * 64, o0, o1, hh);
    __syncthreads();
}
constexpr int CW_Q = 8192;
DI void p_mix(const Args& a, int l, LAS unsigned char* lds, int tid) {
    unsigned* qhead = (unsigned*)(a.ws + WS_CTL) + CW_Q + 64 * l;
    volatile LAS int* QI = (volatile LAS int*)(lds + MISC_OFF) + 16;
    for (int rep = 0; rep < REP_SCAN; ++rep)
    for (int it = blockIdx.x; it < 16; it += gridDim.x) scan_block(a, it, lds, tid);
    for (;;) {
        if (tid == 0) QI[0] = (int)__hip_atomic_fetch_add(qhead, 1u, __ATOMIC_RELAXED, __HIP_MEMORY_SCOPE_AGENT);
        __syncthreads();
        const int idx = QI[0];
        __syncthreads();
        if (idx >= 1024) break;
        if (idx < 512) { const int qt = 127 - (idx >> 2), bg = idx & 3; nsa_tile(a, l, bg >> 1, bg & 1, qt, lds, tid); }
        else { const int j = idx - 512, bg = j >> 7, qt = j & 127; swa_tile(a, l, bg >> 1, bg & 1, qt, lds, tid); }
    }
}

DI void cvt_fp8(const float* src, unsigned char* dst, size_t n, float sc, size_t gtid, size_t gthreads) {
    for (size_t i = gtid * 16; i < n; i += gthreads * 16) { v4u o;
#pragma unroll
        for (int c = 0; c < 4; ++c) { const f32x4 v = *(const f32x4*)(src + i + 4 * c) * sc; int w = 0; w = __builtin_amdgcn_cvt_pk_fp8_f32(v.x, v.y, w, false); w = __builtin_amdgcn_cvt_pk_fp8_f32(v.z, v.w, w, true); o[c] = (unsigned)w; }
        *(v4u*)(dst + i) = o; }
}
DI void cvt_fp4(const float* src, unsigned char* dst, size_t n, float sc, size_t gtid, size_t gthreads) {
    for (size_t i = gtid * 16; i < n; i += gthreads * 16) { v2u o;
#pragma unroll
        for (int d = 0; d < 2; ++d) { unsigned w = 0u;
#pragma unroll
            for (int c = 0; c < 2; ++c) { const f32x4 v = *(const f32x4*)(src + i + 8 * d + 4 * c) * sc;
                if (c == 0) { w = __builtin_amdgcn_cvt_scalef32_pk_fp4_f32(w, v.x, v.y, 1.0f, 0); w = __builtin_amdgcn_cvt_scalef32_pk_fp4_f32(w, v.z, v.w, 1.0f, 1); }
                else        { w = __builtin_amdgcn_cvt_scalef32_pk_fp4_f32(w, v.x, v.y, 1.0f, 2); w = __builtin_amdgcn_cvt_scalef32_pk_fp4_f32(w, v.z, v.w, 1.0f, 3); } }
            o[d] = w; }
        *(v2u*)(dst + i / 2) = o; }
}
DI void p_norm2(const Args& a, int l, int tid) {
    p_rms(a.out, a.in[I_LN2] + l * D, (bf16*)(a.ws + WS_XN), tid);
    const size_t gtid = (size_t)blockIdx.x * NT + tid, gth = (size_t)gridDim.x * NT;
    cvt_fp4(a.in[I_PU] + (size_t)l * 16384 * 1024, a.ws + WS_PU, (size_t)16384 * 1024, PU_SCALE, gtid, gth);
    cvt_fp4(a.in[I_PV] + (size_t)l * 16384 * 1024, a.ws + WS_PV, (size_t)16384 * 1024, PV_SCALE, gtid, gth);
}
constexpr int P_SC = 0, P_TOP = 132096, P_EXP = 0, P_GATE = 8192;
DI void peer_item(const Args& a, int l, int item, LAS unsigned char* lds, int tid, bool dry) {
    const int lane = tid & 63, w = tid >> 6, r16 = lane & 15, q4 = lane >> 4, m0 = item * 16;
    LAS float* SC = (LAS float*)(lds + P_SC); LAS float* TOP = (LAS float*)(lds + P_TOP); LAS int* EXPI = (LAS int*)(lds + P_EXP); LAS float* GATE = (LAS float*)(lds + P_GATE);
    const bf16* PQ = (const bf16*)(a.ws + WS_PQ); const bf16* SK = (const bf16*)(a.ws + WS_SK) + (size_t)l * 16 * 128 * 128;
#pragma unroll 1
    for (int hpi = 0; hpi < 2; ++hpi) { const int hp = 2 * w + hpi;
        bf16x8 af[4], bq[4][8];
        const bf16* ap = PQ + (size_t)(m0 + r16) * 2048 + hp * 128 + q4 * 8; const bf16* bp = SK + (size_t)(hp * 128 + r16) * 128 + q4 * 8;
#pragma unroll
        for (int ks = 0; ks < 4; ++ks) { af[ks] = *(const bf16x8*)(ap + ks * 32);
#pragma unroll
            for (int nt = 0; nt < 8; ++nt) bq[ks][nt] = *(const bf16x8*)(bp + (size_t)nt * 16 * 128 + ks * 32); }
        __builtin_amdgcn_sched_barrier(0);
        f32x4 acc[8];
#pragma unroll
        for (int nt = 0; nt < 8; ++nt) acc[nt] = (f32x4){0.f, 0.f, 0.f, 0.f};
#pragma unroll
        for (int ks = 0; ks < 4; ++ks)
#pragma unroll
            for (int nt = 0; nt < 8; ++nt) acc[nt] = MFMA16(af[ks], bq[ks][nt], acc[nt]);
#pragma unroll
        for (int nt = 0; nt < 8; ++nt)
#pragma unroll
            for (int j = 0; j < 4; ++j) SC[((q4 * 4 + j) * 16 + hp) * 129 + nt * 16 + r16] = acc[nt][j];
        __builtin_amdgcn_sched_barrier(0);
    }
    __syncthreads();
    if (tid < 256) { float T[16], Gv[16];
#define PK_LOAD16(A, g) _Pragma("unroll") for (int i_ = 0; i_ < 16; ++i_) A[i_] = __uint_as_float((__float_as_uint(SC[tid * 129 + (g) * 16 + i_]) & ~0x7Fu) | (unsigned)((g) * 16 + i_))
#define PK_CE(A, i_, l_) do { const float hi_ = fmaxf(A[i_], A[l_]), lo_ = fminf(A[i_], A[l_]); A[i_] = hi_; A[l_] = lo_; } while (0)
#define PK_SORT16(A) _Pragma("unroll") for (int k_ = 2; k_ <= 16; k_ <<= 1) _Pragma("unroll") for (int j_ = k_ >> 1; j_ > 0; j_ >>= 1) _Pragma("unroll") for (int i_ = 0; i_ < 16; ++i_) { const int l_ = i_ ^ j_; \
            if (l_ > i_) { if (((i_ & k_) == 0) || k_ == 16) PK_CE(A, i_, l_); else PK_CE(A, l_, i_); } }
#define PK_MERGE16(A) _Pragma("unroll") for (int j_ = 8; j_ > 0; j_ >>= 1) _Pragma("unroll") for (int i_ = 0; i_ < 16; ++i_) { const int l_ = i_ ^ j_; if (l_ > i_) PK_CE(A, i_, l_); }
        PK_LOAD16(T, 0); PK_SORT16(T);
#pragma unroll 1
        for (int g = 1; g < 8; ++g) { PK_LOAD16(Gv, g); PK_SORT16(Gv);
#pragma unroll
            for (int i_ = 0; i_ < 16; ++i_) T[i_] = fmaxf(T[i_], Gv[15 - i_]);
            PK_MERGE16(T); }
#pragma unroll
        for (int k = 0; k < 16; ++k) TOP[tid * 17 + k] = T[k]; }
    __syncthreads();
    if (tid < 128) { const int tok = tid >> 3, h = tid & 7; const LAS float* T1 = TOP + ((tok * 16 + 2 * h) * 17), *T2 = TOP + ((tok * 16 + 2 * h + 1) * 17);
        float s1[16], s2[16], L[16];
#pragma unroll
        for (int k = 0; k < 16; ++k) { s1[k] = T1[k]; s2[k] = T2[k]; L[k] = NEG_INF; }
#pragma unroll
        for (int aa = 0; aa < 16; ++aa)
#pragma unroll
            for (int bb = 0; bb < 16; ++bb) if ((aa + 1) * (bb + 1) <= 16) {
                float x = __uint_as_float((__float_as_uint(s1[aa] + s2[bb]) & ~0xFFu) | (unsigned)(aa * 16 + bb));
#pragma unroll
                for (int k = 0; k < 16; ++k) { const float hi = fmaxf(L[k], x); x = fminf(L[k], x); L[k] = hi; } }
        float e[16], se = 0.f;
#pragma unroll
        for (int k = 0; k < 16; ++k) { e[k] = __expf(L[k] - L[0]); se += e[k]; }
        const float inv = 1.0f / se;
#pragma unroll
        for (int k = 0; k < 16; ++k) { const unsigned id = __float_as_uint(L[k]) & 0xFFu; const int i1 = (int)(__float_as_uint(T1[id >> 4]) & 0x7Fu), i2 = (int)(__float_as_uint(T2[id & 15u]) & 0x7Fu);
            EXPI[tok * 128 + h * 16 + k] = i1 * 128 + i2; GATE[tok * 128 + h * 16 + k] = e[k] * inv; }
    }
    __syncthreads();
    const unsigned char* PU = a.ws + WS_PU; const unsigned char* PV = a.ws + WS_PV;
#pragma unroll 1
    for (int ti = 0; ti < 2; ++ti) { const int tt = 2 * w + ti, m = m0 + tt;
        bf16* zrow = (bf16*)(a.ws + WS_XN) + (size_t)m * 1024 + 16 * lane;
        f32x2 z[8];
        { float zf[8]; unpack8(*(const v4u*)zrow, zf);
#pragma unroll
          for (int c = 0; c < 4; ++c) z[c] = (f32x2){zf[2 * c], zf[2 * c + 1]};
          unpack8(*(const v4u*)(zrow + 8), zf);
#pragma unroll
          for (int c = 0; c < 4; ++c) z[4 + c] = (f32x2){zf[2 * c], zf[2 * c + 1]}; }
        f32x2 acc[8];
#pragma unroll
        for (int d = 0; d < 8; ++d) acc[d] = (f32x2){0.f, 0.f};
#pragma unroll 1
        for (int e0 = 0; e0 < 128; e0 += 16) {
            v2u ur[16], vr[16];
#pragma unroll
            for (int k = 0; k < 16; ++k) { const int eid = __builtin_amdgcn_readfirstlane(EXPI[tt * 128 + e0 + k]);
                ur[k] = *(const v2u*)(PU + (size_t)eid * 512 + 8 * lane); vr[k] = *(const v2u*)(PV + (size_t)eid * 512 + 8 * lane); }
#pragma unroll
            for (int gq = 0; gq < 2; ++gq) {
            float x8[8];
#pragma unroll
            for (int k = 0; k < 8; ++k) { f32x2 hs = (f32x2){0.f, 0.f};
#pragma unroll
                for (int d = 0; d < 2; ++d) { const unsigned wv = ur[8 * gq + k][d];
                    hs += __builtin_amdgcn_cvt_scalef32_pk_f32_fp4(wv, 1.0f, 0) * z[4 * d]; hs += __builtin_amdgcn_cvt_scalef32_pk_f32_fp4(wv, 1.0f, 1) * z[4 * d + 1];
                    hs += __builtin_amdgcn_cvt_scalef32_pk_f32_fp4(wv, 1.0f, 2) * z[4 * d + 2]; hs += __builtin_amdgcn_cvt_scalef32_pk_f32_fp4(wv, 1.0f, 3) * z[4 * d + 3]; }
                x8[k] = hs.x + hs.y; }
            float actv;
            { float y4[4], z2[2], u;
#pragma unroll
              for (int k = 0; k < 4; ++k) { const bool o = lane & 1; const float keep = o ? x8[2 * k + 1] : x8[2 * k], send = o ? x8[2 * k] : x8[2 * k + 1]; y4[k] = keep + DPPQ(send, 0xB1); }
#pragma unroll
              for (int k = 0; k < 2; ++k) { const bool o = lane & 2; const float keep = o ? y4[2 * k + 1] : y4[2 * k], send = o ? y4[2 * k] : y4[2 * k + 1]; z2[k] = keep + DPPQ(send, 0x4E); }
              { const bool o = lane & 4; const float keep = o ? z2[1] : z2[0], send = o ? z2[0] : z2[1]; const float fr_hi = DPPQ(send, 0x104), fr_lo = DPPQ(send, 0x114); u = keep + (o ? fr_lo : fr_hi); }
              u += DPPQ(u, 0x128);
              { float ub; asm volatile("v_mov_b32_e32 %1, %0\n\ts_nop 1\n\tv_permlane16_swap_b32_e32 %0, %1" : "+v"(u), "=&v"(ub)); u += ub; }
              { float ub; asm volatile("v_mov_b32_e32 %1, %0\n\ts_nop 1\n\tv_permlane32_swap_b32_e32 %0, %1" : "+v"(u), "=&v"(ub)); u += ub; }
              actv = GATE[tt * 128 + e0 + 8 * gq + (lane & 7)] * gelu_erf(u * (1.0f / PU_SCALE)) * (1.0f / PV_SCALE); }
#pragma unroll
            for (int k = 0; k < 8; ++k) { const float act = __builtin_bit_cast(float, __builtin_amdgcn_readlane(__builtin_bit_cast(int, actv), k));
#pragma unroll
                for (int d = 0; d < 2; ++d) { const unsigned wv = vr[8 * gq + k][d];
                    acc[4 * d] += __builtin_amdgcn_cvt_scalef32_pk_f32_fp4(wv, 1.0f, 0) * act; acc[4 * d + 1] += __builtin_amdgcn_cvt_scalef32_pk_f32_fp4(wv, 1.0f, 1) * act;
                    acc[4 * d + 2] += __builtin_amdgcn_cvt_scalef32_pk_f32_fp4(wv, 1.0f, 2) * act; acc[4 * d + 3] += __builtin_amdgcn_cvt_scalef32_pk_f32_fp4(wv, 1.0f, 3) * act; } }
            }
        }
        if ((DBG_ZERO >> 3) & 1) {
#pragma unroll
            for (int d = 0; d < 8; ++d) acc[d] = (f32x2){0.f, 0.f}; }
        float* xo = a.out + (size_t)m * 1024 + 16 * lane;
        f32x4 x0 = *(const f32x4*)(xo), x1 = *(const f32x4*)(xo + 4), x2 = *(const f32x4*)(xo + 8), x3 = *(const f32x4*)(xo + 12);
        x0 += (f32x4){acc[0].x, acc[0].y, acc[1].x, acc[1].y}; x1 += (f32x4){acc[2].x, acc[2].y, acc[3].x, acc[3].y}; x2 += (f32x4){acc[4].x, acc[4].y, acc[5].x, acc[5].y}; x3 += (f32x4){acc[6].x, acc[6].y, acc[7].x, acc[7].y};
        float ss = (x0.x * x0.x + x0.y * x0.y + x0.z * x0.z + x0.w * x0.w) + (x1.x * x1.x + x1.y * x1.y + x1.z * x1.z + x1.w * x1.w)
                 + (x2.x * x2.x + x2.y * x2.y + x2.z * x2.z + x2.w * x2.w) + (x3.x * x3.x + x3.y * x3.y + x3.z * x3.z + x3.w * x3.w);
        const float rs = rsqrtf(wave_sum(ss) * (1.f / D) + 1e-6f);
        if (dry) continue;
        const float* nw = ((l == LAYERS - 1) ? a.in[I_LNF] : a.in[I_LN1] + (l + 1) * D) + 16 * lane;
        const f32x4 w0 = *(const f32x4*)(nw), w1 = *(const f32x4*)(nw + 4), w2 = *(const f32x4*)(nw + 8), w3 = *(const f32x4*)(nw + 12);
        const f32x4 n0 = x0 * rs * w0, n1 = x1 * rs * w1, n2 = x2 * rs * w2, n3 = x3 * rs * w3;
        if (l == LAYERS - 1) {
            *(f32x4*)(xo) = n0; *(f32x4*)(xo + 4) = n1; *(f32x4*)(xo + 8) = n2; *(f32x4*)(xo + 12) = n3;
        } else {
            *(f32x4*)(xo) = x0; *(f32x4*)(xo + 4) = x1; *(f32x4*)(xo + 8) = x2; *(f32x4*)(xo + 12) = x3;
            v4u p; p.x = pk(n0.x, n0.y); p.y = pk(n0.z, n0.w); p.z = pk(n1.x, n1.y); p.w = pk(n1.z, n1.w); *(v4u*)(zrow) = p;
            p.x = pk(n2.x, n2.y); p.y = pk(n2.z, n2.w); p.z = pk(n3.x, n3.y); p.w = pk(n3.z, n3.w); *(v4u*)(zrow + 8) = p;
        }
    }
    __syncthreads();
}
DI void p_peer(const Args& a, int l, LAS unsigned char* lds, int tid) {
    for (int rep = 0; rep < REP_PEER; ++rep)
    for (int it = blockIdx.x; it < M / 16; it += gridDim.x) { int dflag = (rep + 1 < REP_PEER) ? 1 : 0; asm volatile("" : "+s"(dflag)); peer_item(a, l, it, lds, tid, dflag != 0); }
}

#ifndef MK_PER_PHASE
#define MK_PER_PHASE 0
#endif
#ifndef PH_MASK
#define PH_MASK 0x7FF
#endif
#define PHASE_ON(j) ((((PH_MASK) >> (j)) & 1) != 0)
constexpr int NPH = 1 + 10 * LAYERS;
__global__ void __launch_bounds__(NT, 2) fwd(Args a_unused) {
    typedef const __attribute__((address_space(4))) Args* KArgP;
    KArgP kap = (KArgP)__builtin_amdgcn_kernarg_segment_ptr();
    Args a; __builtin_memcpy(&a, kap, sizeof(Args));
    extern __shared__ __attribute__((aligned(16))) unsigned char lds_raw[];
    LAS unsigned char* lds = (LAS unsigned char*)lds_raw;
    const int tid0 = threadIdx.x;
#define tid tid0
    volatile LAS unsigned* MISC = (volatile LAS unsigned*)(lds + MISC_OFF);
    if (tid < 64) MISC[tid] = 0u;
    __syncthreads();
    unsigned* ctl = (unsigned*)(a.ws + WS_CTL);
    XcdBarrier bar = xcd_barrier_post(ctl + CW_BAR, MISC + 8);
    const int lo = a.ph_lo, hi = a.ph_hi;
#define IN(k) (lo <= (k) && (k) < hi)
#define SEAM(k) do { if (IN(k) && IN((k) + 1)) xcd_barrier(bar); } while (0)
    unsigned char* ws = a.ws;
#undef tid
#define LAUNDER_ARGS Args a; { KArgP p_ = kap; asm volatile("" : "+s"(p_)); __builtin_memcpy(&a, p_, sizeof(Args)); } unsigned char* ws = a.ws; const float* xin = (l == 0) ? a.in[I_X] : a.out
#define LAUNDER_TID int tid = tid0; asm volatile("" : "+v"(tid)); Args a; { KArgP p_ = kap; asm volatile("" : "+s"(p_)); __builtin_memcpy(&a, p_, sizeof(Args)); }
    if (PHASE_ON(10) && IN(0)) { LAUNDER_TID; for (int rep = 0; rep < REP_PRO; ++rep) p_prologue(a, lds, tid);
        p_rms(a.in[I_X], a.in[I_LN1], (bf16*)(ws + WS_XN), tid);
        if (IN(0) && IN(2)) xcd_barrier(bar); }
    for (int l = 0; l < LAYERS; ++l) {
        const int pb = 1 + 10 * l;
        const float* xin = (l == 0) ? a.in[I_X] : a.out;
        if (PHASE_ON(1) && IN(pb + 1)) { LAUNDER_ARGS;
            pg8::Gemm g{(const bf16*)(ws + WS_XN), (const bf16*)(ws + WS_WIN) + (size_t)l * NP * 1024, M, NP, 1024}; pg8::StaticOrder S; S.init(M, NP, gridDim.x, blockIdx.x);
            pg8::EpiBf16P E{(bf16*)(ws + WS_PROJ), NP, KV_TILE_MASK, (bf16*)(ws + WS_KV0), (bf16*)(ws + WS_KV1)};
            for (int rep = 0; rep < REP_WIN; ++rep) pg8::gemm_phase<pg8::EpiBf16P, pg8::StaticOrder, true, true>(lds, g, S, E);
            SEAM(pb + 1); }
        if (PHASE_ON(2) && IN(pb + 2)) { LAUNDER_TID; p_prep(a, l, lds, tid); SEAM(pb + 2); }
        if (PHASE_ON(3) && IN(pb + 3)) { LAUNDER_TID; p_mix(a, l, lds, tid); SEAM(pb + 3); }
        if (PHASE_ON(4) && IN(pb + 4)) { LAUNDER_TID; p_post(a, l, tid); SEAM(pb + 4); }
        if (PHASE_ON(5) && IN(pb + 5)) { LAUNDER_ARGS;
            pg8::StaticOrder S; S.init(M, 1024, gridDim.x, blockIdx.x);
            const bf16* Gp = (const bf16*)(ws + WS_PROJ) + C_GA; bf16* MG = (bf16*)(ws + WS_XN); const bf16* WB = (const bf16*)(ws + WS_WBR) + (size_t)l * 3 * 1024 * 512;
#pragma unroll 1
            for (int br3 = 0; br3 < 3 * REP_MERGE; ++br3) { const int br = br3 % 3;
                pg8::Gemm g{(const bf16*)(ws + WS_OA + (size_t)br * (WS_OB - WS_OA)), WB + (size_t)br * 1024 * 512, M, 1024, 512}; pg8::EpiMerge E{Gp + br * 1024, NP, MG, br, ((DBG_ZERO >> br) & 1) ? 0.f : 1.f};
                pg8::gemm_phase<pg8::EpiMerge, pg8::StaticOrder, true, true>(lds, g, S, E); }
            SEAM(pb + 5); }
        if (PHASE_ON(6) && IN(pb + 6)) { LAUNDER_ARGS;
            pg8::Gemm g{(const bf16*)(ws + WS_XN), (const bf16*)(ws + WS_WOUT) + (size_t)l * 1024 * 1024, M, 1024, 1024}; pg8::StaticOrder S; S.init(M, 1024, gridDim.x, blockIdx.x);
            pg8::EpiResid E{xin, a.out};
            pg8::gemm_phase<pg8::EpiResid, pg8::StaticOrder, true, true>(lds, g, S, E);
            SEAM(pb + 6); }
        if (PHASE_ON(7) && IN(pb + 7)) { LAUNDER_TID; for (int rep = 0; rep < REP_NORM2; ++rep) p_norm2(a, l, tid); SEAM(pb + 7); }
        if (PHASE_ON(8) && IN(pb + 8)) { LAUNDER_ARGS;
            pg8::Gemm g{(const bf16*)(ws + WS_XN), (const bf16*)(ws + WS_WQ) + (size_t)l * 2048 * 1024, M, 2048, 1024}; pg8::StaticOrder S; S.init(M, 2048, gridDim.x, blockIdx.x);
            pg8::EpiBf16P E{(bf16*)(ws + WS_PQ), 2048, 0u, nullptr, nullptr};
            for (int rep = 0; rep < REP_PQ; ++rep) pg8::gemm_phase<pg8::EpiBf16P, pg8::StaticOrder, true, true>(lds, g, S, E);
            SEAM(pb + 8); }
        if (PHASE_ON(9) && IN(pb + 9)) { LAUNDER_TID; p_peer(a, l, lds, tid); if (l + 1 < LAYERS) { if (IN(pb + 9) && IN(pb + 11)) xcd_barrier(bar); } }
    }
#undef IN
#undef SEAM
}

extern "C" void kernel_launch(void* const* d_in, const int* in_sizes, int n_in, void* d_out, int out_size, void* d_ws, size_t ws_size, hipStream_t stream) {
    static int grid = 0;
    if (grid == 0) {
        if (n_in != 32 || in_sizes[0] != M * D || out_size != M * D || ws_size < WS_END) { fprintf(stderr, "kernel_launch: unexpected problem shape / workspace (%d inputs, ws %zu)\n", n_in, ws_size); grid = -1; return; }
        int dev = 0, cus = 0, per_cu = 0;
        if (hipGetDevice(&dev) != hipSuccess || hipDeviceGetAttribute(&cus, hipDeviceAttributeMultiprocessorCount, dev) != hipSuccess) { grid = -1; return; }
        if (hipFuncSetAttribute((const void*)fwd, hipFuncAttributeMaxDynamicSharedMemorySize, LDS_BYTES) != hipSuccess) { fprintf(stderr, "kernel_launch: hipFuncSetAttribute failed\n"); grid = -1; return; }
        if (hipOccupancyMaxActiveBlocksPerMultiprocessor(&per_cu, (const void*)fwd, NT, LDS_BYTES) != hipSuccess || per_cu < 1) { fprintf(stderr, "kernel_launch: occupancy query says %d\n", per_cu); (void)hipGetLastError(); }
        grid = cus;
    }
    if (grid < 0) return;
    (void)hipMemsetAsync((char*)d_ws + WS_CTL, 0, CTL_ZERO_BYTES, stream);
    Args a{};
    for (int i = 0; i < 32; ++i) a.in[i] = (const float*)d_in[i];
    a.out = (float*)d_out; a.ws = (unsigned char*)d_ws;
#if MK_PER_PHASE
    for (int p = 0; p < NPH; ++p) { if (p == 1 || p == 11) continue; a.ph_lo = p; a.ph_hi = p + 1; hipLaunchKernelGGL(fwd, dim3(grid), dim3(NT), LDS_BYTES, stream, a); }
#else
    a.ph_lo = 0; a.ph_hi = NPH;
    hipLaunchKernelGGL(fwd, dim3(grid), dim3(NT), LDS_BYTES, stream, a);
#endif
}
```

```cpp
#include <hip/hip_runtime.h>
#include <cstdio>
#include <cstdint>
#define DI __device__ __forceinline__
#define GAS __attribute__((address_space(1)))
#define LAS __attribute__((address_space(3)))
typedef unsigned short bf16;
typedef unsigned v4u __attribute__((ext_vector_type(4)));
typedef unsigned v2u __attribute__((ext_vector_type(2)));
typedef float f32x2 __attribute__((ext_vector_type(2)));
typedef float f32x4 __attribute__((ext_vector_type(4)));
typedef float f32x16 __attribute__((ext_vector_type(16)));
typedef short bf16x8 __attribute__((ext_vector_type(8)));
typedef short s16x4 __attribute__((ext_vector_type(4)));
typedef __bf16 bfx2 __attribute__((ext_vector_type(2)));
struct U3 { unsigned a, b, c; };

namespace pg8 {
#define PG8_LAS __attribute__((address_space(3)))
typedef unsigned short bf16_t;
typedef short bf16x8 __attribute__((ext_vector_type(8)));
typedef float f32x4 __attribute__((ext_vector_type(4)));
typedef unsigned u32x4 __attribute__((ext_vector_type(4)));
constexpr int BM = 256, BK = 64, HALF = 128, HTB = HALF * BK * 2  , STAGE_BYTES = 8 * HTB, NXCD = 8, WGM = 8;

__host__ __device__ __forceinline__ int lds_byte(int r, int c) { const int st = (r >> 4) * 2 + (c >> 5), rr = r & 15, cc = c & 31, ob = rr * 64 + cc * 2; return st * 1024 + (ob ^ (((ob >> 9) & 1) << 5)); }
__host__ __device__ __forceinline__ void stage_rc(int b, int& R, int& C) { const int st = b / 1024, sb = b % 1024, swz = sb ^ (((sb >> 9) & 1) << 5); R = (st >> 1) * 16 + swz / 64; C = (st & 1) * 32 + (swz % 64) / 2; }
__host__ __device__ __forceinline__ int perm32(int rho) { const int n = rho >> 4, i = rho & 15; return 8 * (i >> 2) + 4 * n + (i & 3); }

struct Unit { int pm, pn; };
struct Gemm { const bf16_t* A; const bf16_t* Bt; int M, N, K; };

struct StaticOrder {
    int nM, nN, nwg, G, c;
    __host__ __device__ void init(int M, int N, int G_, int c_) { nM = M / BM; nN = N / BM; nwg = nM * nN; G = G_; c = c_; }
    __host__ __device__ bool next(int i, Unit& u) const {
        const long L = (long)i * G + c; if (L >= nwg) return false;
        int wgid = (int)L; { const int q = nwg / NXCD, r = nwg % NXCD, xcd = wgid % NXCD, off = wgid / NXCD; wgid = (xcd < r ? xcd * (q + 1) : r * (q + 1) + (xcd - r) * q) + off; }
        const int nig = WGM * nN, gid = wgid / nig, fm = gid * WGM, gsz = (nM - fm) < WGM ? (nM - fm) : WGM;
        u.pm = fm + ((wgid % nig) % gsz); u.pn = (wgid % nig) / gsz; return true;
    }
    __device__ __forceinline__ void a_ready(const Unit&) const {}
    __device__ __forceinline__ void done(const Unit&) const {}
};

__device__ __forceinline__ unsigned cvt_pk_bf16(float lo, float hi) { unsigned r; asm volatile("v_cvt_pk_bf16_f32 %0, %1, %2" : "=v"(r) : "v"(lo), "v"(hi)); return r; }
typedef float f32x2 __attribute__((ext_vector_type(2)));
__device__ __forceinline__ f32x2 gelu_pk(f32x2 v) {
    const f32x2 av = __builtin_elementwise_abs(v), d = av * 0.2316418882f + 1.0f;
    f32x2 t; t.x = __builtin_amdgcn_rcpf(d.x); t.y = __builtin_amdgcn_rcpf(d.y);
    f32x2 q = t * 0.5307027145f + (-0.7265760135f); q = q * t + 0.7107068705f; q = q * t + (-0.142248368f); q = q * t + 0.127414796f; q = q * t;
    const f32x2 s = (v * v) * (-0.72134752044f);
    f32x2 e; e.x = __builtin_amdgcn_exp2f(s.x); e.y = __builtin_amdgcn_exp2f(s.y);
    const f32x2 m = v * (q * e), r = v - m;
    f32x2 o; o.x = v.x < 0.f ? m.x : r.x; o.y = v.y < 0.f ? m.y : r.y; return o;
}

__device__ __forceinline__ float sigm(float x) { return __builtin_amdgcn_rcpf(1.0f + __expf(-x)); }
struct EpiBf16P {
    static constexpr bool PERM = true, AFTER_DRAIN = false;
    bf16_t* O; int ldc; unsigned kvmask; bf16_t* KV0; bf16_t* KV1;
    __device__ __forceinline__ void operator()(const f32x4 (&acc)[2][2][4][2], const Unit& u, int wr, int wc, int fr, int fq) const {
        const int row0 = u.pm * BM + wr * 64 + fr; int col0 = u.pn * BM + wc * 32 + 8 * fq, ld = ldc; bf16_t* base = O;
        if ((kvmask >> u.pn) & 1u) { const int slot = __builtin_popcount(kvmask & ((1u << u.pn) - 1u)); base = (slot < 2 ? KV0 : KV1) + (size_t)(slot & 1) * 16384 * 256; ld = 256; col0 = wc * 32 + 8 * fq; }
#pragma unroll
        for (int ai = 0; ai < 2; ++ai)
#pragma unroll
            for (int m = 0; m < 4; ++m) { bf16_t* rowp = base + (size_t)(row0 + ai * HALF + m * 16) * ld + col0;
#pragma unroll
                for (int bj = 0; bj < 2; ++bj) { const f32x4 v0 = acc[ai][bj][m][0], v1 = acc[ai][bj][m][1];
                    u32x4 w; w.x = cvt_pk_bf16(v0[0], v0[1]); w.y = cvt_pk_bf16(v0[2], v0[3]); w.z = cvt_pk_bf16(v1[0], v1[1]); w.w = cvt_pk_bf16(v1[2], v1[3]);
                    *(u32x4*)(rowp + bj * HALF) = w; } }
    }
};
struct EpiMerge {
    static constexpr bool PERM = true, AFTER_DRAIN = false;
    const bf16_t* G; int ldg; bf16_t* O; int accum; float bscale;
    __device__ __forceinline__ void operator()(const f32x4 (&acc)[2][2][4][2], const Unit& u, int wr, int wc, int fr, int fq) const {
        const int row0 = u.pm * BM + wr * 64 + fr, col0 = u.pn * BM + wc * 32 + 8 * fq;
#pragma unroll
        for (int ai = 0; ai < 2; ++ai)
#pragma unroll
            for (int m = 0; m < 4; ++m) { int rowi = row0 + ai * HALF + m * 16; asm volatile("" : "+v"(rowi)); const size_t row = (size_t)rowi;
#pragma unroll
                for (int bj = 0; bj < 2; ++bj) {
                    const u32x4 g = *(const u32x4*)(G + row * ldg + col0 + bj * HALF);
                    u32x4 p = (u32x4){0u, 0u, 0u, 0u}; if (accum) p = *(const u32x4*)(O + row * 1024 + col0 + bj * HALF);
                    float o[8];
#pragma unroll
                    for (int e = 0; e < 4; ++e) {
                        const float g0 = __uint_as_float(g[e] << 16), g1 = __uint_as_float(g[e] & 0xffff0000u);
                        const float p0 = __uint_as_float(p[e] << 16), p1 = __uint_as_float(p[e] & 0xffff0000u);
                        const float a0 = acc[ai][bj][m][e >> 1][(e & 1) * 2], a1 = acc[ai][bj][m][e >> 1][(e & 1) * 2 + 1];
                        o[2 * e] = p0 + sigm(g0) * a0 * bscale; o[2 * e + 1] = p1 + sigm(g1) * a1 * bscale; }
                    u32x4 w; w.x = cvt_pk_bf16(o[0], o[1]); w.y = cvt_pk_bf16(o[2], o[3]); w.z = cvt_pk_bf16(o[4], o[5]); w.w = cvt_pk_bf16(o[6], o[7]);
                    *(u32x4*)(O + row * 1024 + col0 + bj * HALF) = w; }
                asm volatile("" ::: "memory"); }
    }
};
struct EpiResid {
    static constexpr bool PERM = false, AFTER_DRAIN = false;
    const float* X; float* O;
    __device__ __forceinline__ void operator()(const f32x4 (&acc)[2][2][4][2], const Unit& u, int wr, int wc, int fr, int fq) const {
        const int row0 = u.pm * BM + wr * 64 + fr, col0 = u.pn * BM + wc * 32 + 4 * fq;
#pragma unroll
        for (int ai = 0; ai < 2; ++ai) { f32x4 xv[4][2][2];
#pragma unroll
            for (int m = 0; m < 4; ++m) { const size_t off = (size_t)(row0 + ai * HALF + m * 16) * 1024 + col0;
#pragma unroll
                for (int bj = 0; bj < 2; ++bj)
#pragma unroll
                    for (int n = 0; n < 2; ++n) xv[m][bj][n] = *(const f32x4*)(X + off + bj * HALF + n * 16); }
            __builtin_amdgcn_sched_barrier(0);
#pragma unroll
            for (int m = 0; m < 4; ++m) { const size_t off = (size_t)(row0 + ai * HALF + m * 16) * 1024 + col0;
#pragma unroll
                for (int bj = 0; bj < 2; ++bj)
#pragma unroll
                    for (int n = 0; n < 2; ++n) *(f32x4*)(O + off + bj * HALF + n * 16) = xv[m][bj][n] + acc[ai][bj][m][n]; }
            __builtin_amdgcn_sched_barrier(0); }
    }
};
template <class Epi, class Sched, bool ALIGN_EPI = false, bool SP2 = false>
__device__ __forceinline__ void gemm_phase(PG8_LAS unsigned char* lds, const Gemm g, const Sched& S, const Epi& E) {
    int tid_ = threadIdx.x; asm volatile("" : "+v"(tid_));
    const int tid = tid_, wid = __builtin_amdgcn_readfirstlane(tid >> 6), lane = tid & 63, wr = wid >> 2, wc = wid & 3, fr = lane & 15, fq = lane >> 4;
    const int K = g.K, nt = K / BK;
    unsigned voffA[2], voffB[2];
#pragma unroll
    for (int i = 0; i < 2; ++i) { int R, C; stage_rc(tid * 16 + i * 8192, R, C); const int Rb = Epi::PERM ? ((R & ~31) + perm32(R & 31)) : R;
        voffA[i] = (unsigned)(R * K + C) * 2u; voffB[i] = (unsigned)(Rb * K + C) * 2u; }
    const size_t kstep = (size_t)(BK * 2);
    const size_t hstep = (size_t)HALF * K * 2;
    const size_t tstep = 2 * hstep;
    const unsigned ldsw = (unsigned)wid * 1024u;
    const int aoff = lds_byte(wr * 64 + fr, fq * 8), boff = lds_byte(wc * 32 + fr, fq * 8);
#define PG8_SA(b, h) (((b) * 2 + (h)) * HTB)
#define PG8_SB(b, h) ((4 + (b) * 2 + (h)) * HTB)
#define PG8_STAGE(bufoff, gbase, voff) do { _Pragma("unroll") for (int _i = 0; _i < 2; ++_i) \
        __builtin_amdgcn_global_load_lds((const unsigned*)((const char*)(gbase) + (voff)[_i]), (PG8_LAS unsigned*)(lds + (bufoff) + ldsw + _i * 8192), 16, 0, 0); } while (0)
#define PG8_LDA(dst, b, h) do { _Pragma("unroll") for (int m = 0; m < 4; ++m) _Pragma("unroll") for (int k = 0; k < 2; ++k) dst[m][k] = *(const PG8_LAS bf16x8*)(lds + PG8_SA(b, h) + aoff + m * 2048 + k * 1024); } while (0)
#define PG8_LDB(dst, b, h) do { _Pragma("unroll") for (int n = 0; n < 2; ++n) _Pragma("unroll") for (int k = 0; k < 2; ++k) dst[n][k] = *(const PG8_LAS bf16x8*)(lds + PG8_SB(b, h) + boff + n * 2048 + k * 1024); } while (0)
#define PG8_MMA(ai, bj, At, Bt) do { __builtin_amdgcn_s_setprio(1); _Pragma("unroll") for (int m = 0; m < 4; ++m) _Pragma("unroll") for (int n = 0; n < 2; ++n) _Pragma("unroll") for (int k = 0; k < 2; ++k) \
        acc[ai][bj][m][n] = __builtin_amdgcn_mfma_f32_16x16x32_bf16(Bt[n][k], At[m][k], acc[ai][bj][m][n], 0, 0, 0); __builtin_amdgcn_s_setprio(0); } while (0)
#define PG8_WAIT_V(n) asm volatile("s_waitcnt vmcnt(" #n ")" ::: "memory")
#define PG8_WAIT_L(n) asm volatile("s_waitcnt lgkmcnt(" #n ")" ::: "memory")
#define PG8_BAR __builtin_amdgcn_s_barrier()
#define PG8_SCHED __builtin_amdgcn_sched_barrier(0)
    Unit cur, nxt; int ui = 0;
    if (!S.next(0, cur)) return;
    f32x4 acc[2][2][4][2];
#pragma unroll
    for (int a = 0; a < 2; ++a)
#pragma unroll
        for (int b = 0; b < 2; ++b)
#pragma unroll
            for (int m = 0; m < 4; ++m)
#pragma unroll
                for (int n = 0; n < 2; ++n) acc[a][b][m][n] = (f32x4){0.f, 0.f, 0.f, 0.f};
    bf16x8 At[4][2], B0[2][2], B1[2][2];
    const char* cA = (const char*)g.A + (size_t)cur.pm * tstep; const char* cB = (const char*)g.Bt + (size_t)cur.pn * tstep;
    S.a_ready(cur);
    if constexpr (SP2) {
        PG8_STAGE(PG8_SB(0, 0), cB, voffB); PG8_STAGE(PG8_SB(0, 1), cB + hstep, voffB); PG8_STAGE(PG8_SA(0, 0), cA, voffA); PG8_STAGE(PG8_SA(0, 1), cA + hstep, voffA);
        if (wr == 1) PG8_BAR;
        PG8_WAIT_V(2); PG8_BAR;
        PG8_STAGE(PG8_SB(1, 0), cB + kstep, voffB); PG8_STAGE(PG8_SA(1, 0), cA + kstep, voffA); PG8_STAGE(PG8_SB(1, 1), cB + hstep + kstep, voffB);
        PG8_WAIT_V(6); PG8_BAR;
    } else {
        PG8_STAGE(PG8_SB(0, 0), cB, voffB); PG8_STAGE(PG8_SA(0, 0), cA, voffA); PG8_STAGE(PG8_SB(0, 1), cB + hstep, voffB); PG8_STAGE(PG8_SA(0, 1), cA + hstep, voffA);
        if (wr == 1) PG8_BAR;
        PG8_WAIT_V(4); PG8_BAR;
        PG8_STAGE(PG8_SB(1, 0), cB + kstep, voffB); PG8_STAGE(PG8_SA(1, 0), cA + kstep, voffA); PG8_STAGE(PG8_SB(1, 1), cB + hstep + kstep, voffB);
        PG8_WAIT_V(6); PG8_BAR;
    }
    for (;;) {
        const bool has_next = S.next(ui + 1, nxt);
        const char* nA = has_next ? (const char*)g.A + (size_t)nxt.pm * tstep : cA; const char* nB = has_next ? (const char*)g.Bt + (size_t)nxt.pn * tstep : cB;
        for (int t = 0; t < nt; t += 2) {
            const bool last = (t == nt - 2);
            const char* a1 = cA + (size_t)(t + 1) * kstep;
            const char* a2 = last ? nA : cA + (size_t)(t + 2) * kstep; const char* b2 = last ? nB : cB + (size_t)(t + 2) * kstep;
            const char* a3 = a2 + kstep; const char* b3 = b2 + kstep;
            if (last && has_next) S.a_ready(nxt);
            if constexpr (SP2) {
            PG8_LDB(B0, 0, 0); PG8_LDB(B1, 0, 1); PG8_SCHED; PG8_LDA(At, 0, 0); PG8_STAGE(PG8_SA(1, 1), a1 + hstep, voffA);
            PG8_WAIT_V(8); PG8_WAIT_L(0); PG8_BAR; PG8_MMA(0, 0, At, B0); PG8_MMA(0, 1, At, B1); PG8_BAR; PG8_SCHED;
            PG8_LDA(At, 0, 1); PG8_STAGE(PG8_SB(0, 0), b2, voffB); PG8_STAGE(PG8_SB(0, 1), b2 + hstep, voffB); PG8_STAGE(PG8_SA(0, 0), a2, voffA);
            PG8_WAIT_V(8); PG8_WAIT_L(0); PG8_BAR; PG8_MMA(1, 0, At, B0); PG8_MMA(1, 1, At, B1); PG8_BAR; PG8_SCHED;
            PG8_LDB(B0, 1, 0); PG8_LDB(B1, 1, 1); PG8_SCHED; PG8_LDA(At, 1, 0); PG8_STAGE(PG8_SA(0, 1), a2 + hstep, voffA);
            PG8_WAIT_V(8); PG8_WAIT_L(0); PG8_BAR; PG8_MMA(0, 0, At, B0); PG8_MMA(0, 1, At, B1); PG8_BAR; PG8_SCHED;
            PG8_LDA(At, 1, 1); PG8_STAGE(PG8_SB(1, 0), b3, voffB); PG8_STAGE(PG8_SB(1, 1), b3 + hstep, voffB); PG8_STAGE(PG8_SA(1, 0), a3, voffA);
            PG8_WAIT_V(8); PG8_WAIT_L(0); PG8_BAR; PG8_MMA(1, 0, At, B0); PG8_MMA(1, 1, At, B1); PG8_BAR; PG8_SCHED;
            } else {
            PG8_LDB(B0, 0, 0); PG8_SCHED; PG8_LDA(At, 0, 0); PG8_STAGE(PG8_SA(1, 1), a1 + hstep, voffA);
            PG8_WAIT_L(8); PG8_BAR; PG8_WAIT_L(0); PG8_MMA(0, 0, At, B0); PG8_BAR; PG8_SCHED;
            PG8_LDB(B1, 0, 1); PG8_STAGE(PG8_SB(0, 0), b2, voffB);
            PG8_BAR; PG8_WAIT_L(0); PG8_MMA(0, 1, At, B1); PG8_BAR;
            PG8_LDA(At, 0, 1); PG8_STAGE(PG8_SA(0, 0), a2, voffA);
            PG8_BAR; PG8_WAIT_L(0); PG8_MMA(1, 0, At, B0); PG8_BAR; PG8_SCHED;
            PG8_STAGE(PG8_SB(0, 1), b2 + hstep, voffB);
            PG8_WAIT_V(6); PG8_BAR; PG8_MMA(1, 1, At, B1); PG8_BAR;
            PG8_LDB(B0, 1, 0); PG8_SCHED; PG8_LDA(At, 1, 0); PG8_STAGE(PG8_SA(0, 1), a2 + hstep, voffA);
            PG8_WAIT_L(8); PG8_BAR; PG8_WAIT_L(0); PG8_MMA(0, 0, At, B0); PG8_BAR; PG8_SCHED;
            PG8_LDB(B1, 1, 1); PG8_STAGE(PG8_SB(1, 0), b3, voffB);
            PG8_BAR; PG8_WAIT_L(0); PG8_MMA(0, 1, At, B1); PG8_BAR;
            PG8_LDA(At, 1, 1); PG8_STAGE(PG8_SA(1, 0), a3, voffA);
            PG8_BAR; PG8_WAIT_L(0); PG8_MMA(1, 0, At, B0); PG8_BAR; PG8_SCHED;
            PG8_STAGE(PG8_SB(1, 1), b3 + hstep, voffB);
            PG8_WAIT_V(6); PG8_BAR; PG8_MMA(1, 1, At, B1); PG8_BAR;
            }
        }
        if constexpr (ALIGN_EPI) { if (wr == 0) PG8_BAR; }
        if constexpr (!Epi::AFTER_DRAIN) { E(acc, cur, wr, wc, fr, fq); S.done(cur); }
        if (!has_next) break;
#pragma unroll
        for (int a = 0; a < 2; ++a)
#pragma unroll
            for (int b = 0; b < 2; ++b)
#pragma unroll
                for (int m = 0; m < 4; ++m)
#pragma unroll
                    for (int n = 0; n < 2; ++n) acc[a][b][m][n] = (f32x4){0.f, 0.f, 0.f, 0.f};
        cur = nxt; cA = nA; cB = nB; ++ui;
        if constexpr (ALIGN_EPI) { if (wr == 1) PG8_BAR; }
    }
    PG8_WAIT_V(0);
    if constexpr (!ALIGN_EPI) { if (wr == 0) PG8_BAR; }
    PG8_BAR;
    if constexpr (Epi::AFTER_DRAIN) { E.fused(acc, cur, wr, wc, fr, fq, lds, wid, lane); S.done(cur); }
#undef PG8_SA
#undef PG8_SB
#undef PG8_STAGE
#undef PG8_LDA
#undef PG8_LDB
#undef PG8_MMA
#undef PG8_WAIT_V
#undef PG8_WAIT_L
#undef PG8_BAR
#undef PG8_SCHED
}
}

#ifndef REP_PREP
#define REP_PREP 1
#endif
#ifndef REP_SCAN
#define REP_SCAN 1
#endif
#ifndef REP_NSA
#define REP_NSA 1
#endif
#ifndef REP_SWA
#define REP_SWA 1
#endif
#ifndef REP_PRO
#define REP_PRO 1
#endif
#ifndef REP_NORM2
#define REP_NORM2 1
#endif
#ifndef REP_WIN
#define REP_WIN 1
#endif
#ifndef REP_MERGE
#define REP_MERGE 1
#endif
#ifndef REP_PQ
#define REP_PQ 1
#endif
#ifndef REP_PEER
#define REP_PEER 1
#endif
#ifndef REP_SEL
#define REP_SEL 1
#endif
#ifndef REP_TOPK
#define REP_TOPK 1
#endif
#ifndef REP_WIN2
#define REP_WIN2 1
#endif
#ifndef PROBE_DELAY_SCAN_US
#define PROBE_DELAY_SCAN_US 0
#endif
#ifndef PROBE_DELAY_ATTN_US
#define PROBE_DELAY_ATTN_US 0
#endif
#define DBG_ZERO 0
constexpr int NWAVES = 8, NT = 512;
constexpr int BATCH = 2, SEQ = 8192, D = 1024, M = BATCH * SEQ, LAYERS = 2;
constexpr int NP = 7168;
constexpr int C_R = 0, C_K = 512, C_V = 1024, C_W = 1536, C_A = 1600, C_G = 1664;
constexpr int C_NQ = 1792, C_NKC = 2304, C_NVC = 2432, C_NKS = 2560, C_NVS = 2688, C_NKW = 2816, C_NVW = 2944, C_NG = 3072;
constexpr int PAD_A = 3096, PAD_B = 3328;
constexpr int C_SQ = 3328, C_SK = 3840, C_SV = 3968, C_GA = 4096;
constexpr float PU_SCALE = 64.f, PV_SCALE = 11.f;
constexpr float LOG2E = 1.4426950408889634f;
constexpr float NEG_INF = -__builtin_huge_valf();

constexpr size_t MiB = 1u << 20, KiB = 1u << 10;
constexpr size_t WS_CTL = 0, CTL_ZERO_BYTES = 1 * MiB;
constexpr size_t WS_WIN = 1 * MiB;
constexpr size_t WS_WBR = 29 * MiB;
constexpr size_t WS_WOUT = 35 * MiB;
constexpr size_t WS_WQ = 39 * MiB;
constexpr size_t WS_SK = 47 * MiB;
constexpr size_t WS_CW1 = 48 * MiB;
constexpr size_t WS_CW2 = 52 * MiB;
constexpr size_t WS_RW = 52 * MiB + 256 * KiB;
constexpr size_t WS_PROJ = 54 * MiB;
constexpr size_t WS_XN = 278 * MiB;
constexpr size_t WS_OA = 310 * MiB, WS_OB = 326 * MiB, WS_OC = 342 * MiB;
constexpr size_t WS_REC = 358 * MiB;
constexpr size_t WS_G = 472 * MiB;
constexpr size_t WS_BON = 470 * MiB;
constexpr size_t WS_KCMP = 471 * MiB, WS_VCMP = 471 * MiB + 256 * KiB;
constexpr size_t WS_PU = 358 * MiB, WS_PV = 374 * MiB;
constexpr size_t WS_PQ = WS_PROJ;
constexpr size_t WS_SLIST = WS_PROJ + 64 * MiB;
constexpr size_t WS_KV0 = 454 * MiB, WS_KV1 = 490 * MiB;
constexpr unsigned KV_TILE_MASK = (1u << 9) | (1u << 10) | (1u << 11) | (1u << 15);
constexpr size_t WS_END = 506 * MiB;
constexpr int CW_BAR = 4096;

constexpr int LDS_BYTES = 155648;
constexpr int MISC_OFF = LDS_BYTES - 256;

DI float bflo(unsigned u) { return __uint_as_float(u << 16); }
DI float bfhi(unsigned u) { return __uint_as_float(u & 0xffff0000u); }
DI void spin_us(int us) { const unsigned long long t0_ = wall_clock64(); while (wall_clock64() - t0_ < (unsigned long long)us * 100ull) __builtin_amdgcn_s_sleep(8); }
DI unsigned pk(float a, float b) { f32x2 v = {a, b}; return __builtin_bit_cast(unsigned, __builtin_convertvector(v, bfx2)); }
DI float sigm(float x) { return __builtin_amdgcn_rcpf(1.0f + __expf(-x)); }
DI float gelu_erf(float x) { return 0.5f * x * (1.0f + erff(x * 0.70710678118654752f)); }
DI float dpp_f(float v, const int ctrl_unused) { return v; }
#define DPPQ(v, ctrl) __builtin_bit_cast(float, __builtin_amdgcn_update_dpp(0, __builtin_bit_cast(int, (v)), (ctrl), 0xF, 0xF, true))
#define DPP_ADD(v, ctrl) ((v) + __builtin_bit_cast(float, __builtin_amdgcn_update_dpp(0, __builtin_bit_cast(int, (v)), (ctrl), 0xF, 0xF, true)))
DI float row16_sum(float v) {
    v = DPP_ADD(v, 0xB1); v = DPP_ADD(v, 0x4E); v = DPP_ADD(v, 0x141); v = DPP_ADD(v, 0x140); return v; }
DI float oct_sum(float v) {
    v = DPP_ADD(v, 0xB1); v = DPP_ADD(v, 0x4E); v = DPP_ADD(v, 0x141); return v; }
DI float wave_sum(float v) {
    v = row16_sum(v);
    const float a = __builtin_bit_cast(float, __builtin_amdgcn_readlane(__builtin_bit_cast(int, v), 0));
    const float b = __builtin_bit_cast(float, __builtin_amdgcn_readlane(__builtin_bit_cast(int, v), 16));
    const float c = __builtin_bit_cast(float, __builtin_amdgcn_readlane(__builtin_bit_cast(int, v), 32));
    const float d = __builtin_bit_cast(float, __builtin_amdgcn_readlane(__builtin_bit_cast(int, v), 48));
    return (a + b) + (c + d); }
DI bf16x8 pack8(const float (&z)[8]) { v4u p; p.x = pk(z[0], z[1]); p.y = pk(z[2], z[3]); p.z = pk(z[4], z[5]); p.w = pk(z[6], z[7]); return __builtin_bit_cast(bf16x8, p); }
DI void unpack8(v4u u, float (&z)[8]) {
#pragma unroll
    for (int e = 0; e < 4; ++e) { z[2 * e] = bflo(u[e]); z[2 * e + 1] = bfhi(u[e]); } }
#define MFMA16(a, b, c) __builtin_amdgcn_mfma_f32_16x16x32_bf16((a), (b), (c), 0, 0, 0)
#define MFMA32(a, b, c) __builtin_amdgcn_mfma_f32_32x32x16_bf16((a), (b), (c), 0, 0, 0)
DI int crow(int reg, int hh) { return (reg & 3) + 8 * (reg >> 2) + 4 * hh; }

struct Args { const float* in[32]; float* out; unsigned char* ws; int ph_lo, ph_hi; };
enum { I_X = 0, I_LN1, I_LN2, I_LNF, I_REL, I_WIN, I_MU, I_W0, I_W2, I_A0, I_A2, I_G2, I_KK, I_KA, I_RK, I_LNW, I_LNB, I_PEK, I_PEV, I_CKW1, I_CKW2, I_CVW1, I_CVW2,
       I_SINK, I_WBA, I_WBB, I_WBC, I_WOUT, I_PWQ, I_PSK, I_PU, I_PV };
__device__ const unsigned char T5_BK[128] = {0, 1, 2, 3, 4, 5, 6, 7, 8, 9, 10, 11, 12, 13, 14, 15, 16, 16, 16, 17, 17, 18, 18, 18, 19, 19, 19, 20, 20, 20, 20, 21, 21, 21, 21, 22, 22, 22, 22, 22, 23, 23, 23, 23, 23, 23, 24, 24, 24, 24, 24, 24, 25, 25, 25, 25, 25, 25, 25, 26, 26, 26, 26, 26, 26, 26, 26, 27, 27, 27, 27, 27, 27, 27, 27, 27, 27, 28, 28, 28, 28, 28, 28, 28, 28, 28, 28, 29, 29, 29, 29, 29, 29, 29, 29, 29, 29, 29, 29, 30, 30, 30, 30, 30, 30, 30, 30, 30, 30, 30, 30, 30, 30, 31, 31, 31, 31, 31, 31, 31, 31, 31, 31, 31, 31, 31, 31, 31};

#define XB_TMO      128
#define XB_XCNT(j)  (256  + 64 * (j))
#define XB_XSUB(j)  (1280 + 64 * (j))
#define XB_XGEN(j)  (2304 + 64 * (j))
#define XB_TOP      3328
#define XB_TOPGEN   3392
#define XCD_BAR_WORDS 3456
#define XB_SPIN_CAP (1u << 18)

__device__ __forceinline__ unsigned xb_ld(unsigned* p)              { return __hip_atomic_load(p, __ATOMIC_RELAXED, __HIP_MEMORY_SCOPE_AGENT); }
__device__ __forceinline__ unsigned xb_add(unsigned* p, unsigned v) { return __hip_atomic_fetch_add(p, v, __ATOMIC_RELAXED, __HIP_MEMORY_SCOPE_AGENT); }
__device__ __forceinline__ unsigned xb_xcc_id() { return (unsigned)__builtin_amdgcn_s_getreg((3 << 11) | 20) & 0xFu; }
#define XB_SPIN(cond, bar) do { unsigned _sp = 0; while (cond) { __builtin_amdgcn_s_sleep(1); \
    if ((++_sp & 255u) == 0u) { if (xb_ld(&(bar)[XB_TMO])) break; if (_sp > XB_SPIN_CAP) { atomicAdd(&(bar)[XB_TMO], 1u); break; } } } } while (0)

struct XcdBarrier {
    unsigned* bar; unsigned x;
    volatile LAS unsigned* st;
};

__device__ __forceinline__ XcdBarrier xcd_barrier_post(unsigned* bar, volatile LAS unsigned* st) {
    XcdBarrier b; b.bar = bar; b.x = xb_xcc_id(); b.st = st;
    if (threadIdx.x == 0) (void)xb_add(&bar[XB_XCNT(b.x)], 1u);
    return b;
}
__device__ __forceinline__ void xcd_barrier_complete(unsigned* bar, unsigned x, unsigned& nloc, unsigned& nx) {
    const unsigned G = gridDim.x * gridDim.y * gridDim.z;
    unsigned sum, cnt, mine, sp = 0u;
    for (;;) {
        sum = 0u; cnt = 0u; mine = 0u;
#pragma unroll
        for (unsigned j = 0; j < 16; ++j) { const unsigned c = xb_ld(&bar[XB_XCNT(j)]); sum += c; cnt += (c > 0u) ? 1u : 0u; mine = (j == x) ? c : mine; }
        if (sum == G) break;
        __builtin_amdgcn_s_sleep(1);
        if ((++sp & 255u) == 0u) { if (xb_ld(&bar[XB_TMO])) break; if (sp > XB_SPIN_CAP) { atomicAdd(&bar[XB_TMO], 1u); break; } }
    }
    nloc = mine > 0u ? mine : 1u; nx = cnt > 0u ? cnt : 1u;
}

__device__ __forceinline__ void xcd_barrier(const XcdBarrier& b) {
    asm volatile("s_waitcnt vmcnt(0)" ::: "memory");
    __syncthreads();
    if (threadIdx.x == 0) {
        unsigned* bar = b.bar;
        __builtin_amdgcn_s_waitcnt(0);
        unsigned nloc = b.st[0], nx = b.st[1];
        if (nloc == 0u) { xcd_barrier_complete(bar, b.x, nloc, nx); b.st[0] = nloc; b.st[1] = nx; }
        const unsigned old = xb_add(&bar[XB_XSUB(b.x)], 1u);
        const unsigned gen = old / nloc;
        if (old + 1u == (gen + 1u) * nloc) {
            __builtin_amdgcn_fence(__ATOMIC_RELEASE, "agent");
            asm volatile("s_waitcnt vmcnt(0)" ::: "memory");
            const unsigned og = xb_add(&bar[XB_TOP], 1u);
            const unsigned tg = og / nx;
            if (og + 1u == (tg + 1u) * nx) xb_add(&bar[XB_TOPGEN], 1u);
            else XB_SPIN(xb_ld(&bar[XB_TOPGEN]) == tg, bar);
            __builtin_amdgcn_fence(__ATOMIC_ACQUIRE, "agent");
            xb_add(&bar[XB_XGEN(b.x)], 1u);
            asm volatile("s_waitcnt vmcnt(0)" ::: "memory");
        } else {
            XB_SPIN(xb_ld(&bar[XB_XGEN(b.x)]) == gen, bar);
            __builtin_amdgcn_fence(__ATOMIC_ACQUIRE, "agent");
            asm volatile("s_waitcnt vmcnt(0)" ::: "memory");
        }
    }
    __syncthreads();
}

DI void tr_item(const float* W, int K, int Nsrc, bf16* WT, int pa, int pb, LAS float* scr, int item, int nblk, int lane) {
    const int kb = item / nblk, nb = item % nblk, k0 = 64 * kb, n0 = 64 * nb;
    const int nq = lane & 15, r = n0 + 4 * nq;
    const int sc = r < pa ? r : (r < pb ? -1 : r - (pb - pa));
    const float* wp = W + (size_t)(k0 + (lane >> 4)) * Nsrc + (sc >= 0 ? sc : 0);
    f32x4 v[16];
#pragma unroll
    for (int i = 0; i < 16; ++i) v[i] = *(const f32x4*)(wp + (size_t)(4 * i) * Nsrc);
    __builtin_amdgcn_sched_barrier(0);
#pragma unroll
    for (int i = 0; i < 16; ++i) { if (sc < 0) v[i] = (f32x4){0.f, 0.f, 0.f, 0.f}; *(LAS f32x4*)(scr + (4 * i + (lane >> 4)) * 68 + 4 * nq) = v[i]; }
    asm volatile("s_waitcnt lgkmcnt(0)" ::: "memory");
    const int c = lane & 7;
#pragma unroll
    for (int j = 0; j < 8; ++j) { const int n = (lane >> 3) + 8 * j; const LAS float* s = scr + (8 * c) * 68 + n;
        v4u o; o.x = pk(s[0 * 68], s[1 * 68]); o.y = pk(s[2 * 68], s[3 * 68]); o.z = pk(s[4 * 68], s[5 * 68]); o.w = pk(s[6 * 68], s[7 * 68]);
        *(v4u*)(WT + (size_t)(n0 + n) * K + k0 + 8 * c) = o; }
    asm volatile("s_waitcnt lgkmcnt(0)" ::: "memory");
}
#define TR_MAT(W, K, Nsrc, Ndst, WT, pa, pb) do { const int nblk_ = (Ndst) / 64, nit_ = ((K) / 64) * nblk_; int st_ = gw - base_; if (st_ < 0) st_ += NGW; \
    for (int it_ = st_; it_ < nit_; it_ += NGW) tr_item((W), (K), (Nsrc), (WT), (pa), (pb), scr, it_, nblk_, lane); base_ = (base_ + nit_) % NGW; } while (0)
DI void cvt_copy(const float* src, bf16* dst, size_t n, size_t gtid, size_t gthreads) {
    for (size_t i = gtid * 8; i < n; i += gthreads * 8) {
        const f32x4 a = *(const f32x4*)(src + i), b = *(const f32x4*)(src + i + 4);
        v4u o; o.x = pk(a[0], a[1]); o.y = pk(a[2], a[3]); o.z = pk(b[0], b[1]); o.w = pk(b[2], b[3]);
        *(v4u*)(dst + i) = o; }
}
DI void p_prologue(const Args& a, LAS unsigned char* lds, int tid) {
    const int lane = tid & 63, wave = tid >> 6, gw = blockIdx.x * NWAVES + wave, NGW = gridDim.x * NWAVES;
    LAS float* scr = (LAS float*)(lds + wave * 17408);
    unsigned char* ws = a.ws;
    int base_ = 0;
    for (int l = 0; l < LAYERS; ++l) {
        TR_MAT(a.in[I_WIN] + (size_t)l * 1024 * 6936, 1024, 6936, NP, (bf16*)(ws + WS_WIN) + (size_t)l * NP * 1024, PAD_A, PAD_B);
        TR_MAT(a.in[I_WBA] + (size_t)l * 512 * 1024, 512, 1024, 1024, (bf16*)(ws + WS_WBR) + (size_t)(l * 3 + 0) * 1024 * 512, 1 << 30, 1 << 30);
        TR_MAT(a.in[I_WBB] + (size_t)l * 512 * 1024, 512, 1024, 1024, (bf16*)(ws + WS_WBR) + (size_t)(l * 3 + 1) * 1024 * 512, 1 << 30, 1 << 30);
        TR_MAT(a.in[I_WBC] + (size_t)l * 512 * 1024, 512, 1024, 1024, (bf16*)(ws + WS_WBR) + (size_t)(l * 3 + 2) * 1024 * 512, 1 << 30, 1 << 30);
        TR_MAT(a.in[I_WOUT] + (size_t)l * 1024 * 1024, 1024, 1024, 1024, (bf16*)(ws + WS_WOUT) + (size_t)l * 1024 * 1024, 1 << 30, 1 << 30);
        TR_MAT(a.in[I_PWQ] + (size_t)l * 1024 * 2048, 1024, 2048, 2048, (bf16*)(ws + WS_WQ) + (size_t)l * 2048 * 1024, 1 << 30, 1 << 30);
        TR_MAT(a.in[I_CKW1] + (size_t)l * 2048 * 256, 2048, 256, 256, (bf16*)(ws + WS_CW1) + (size_t)(l * 2 + 0) * 256 * 2048, 1 << 30, 1 << 30);
        TR_MAT(a.in[I_CVW1] + (size_t)l * 2048 * 256, 2048, 256, 256, (bf16*)(ws + WS_CW1) + (size_t)(l * 2 + 1) * 256 * 2048, 1 << 30, 1 << 30);
        TR_MAT(a.in[I_CKW2] + (size_t)l * 256 * 64, 256, 64, 64, (bf16*)(ws + WS_CW2) + (size_t)(l * 2 + 0) * 64 * 256, 1 << 30, 1 << 30);
        TR_MAT(a.in[I_CVW2] + (size_t)l * 256 * 64, 256, 64, 64, (bf16*)(ws + WS_CW2) + (size_t)(l * 2 + 1) * 64 * 256, 1 << 30, 1 << 30);
        bf16* rw = (bf16*)(ws + WS_RW) + (size_t)l * 131072;
        TR_MAT(a.in[I_W2] + (size_t)l * 64 * 512, 64, 512, 512, rw, 1 << 30, 1 << 30);
        TR_MAT(a.in[I_A2] + (size_t)l * 64 * 512, 64, 512, 512, rw + 512 * 64, 1 << 30, 1 << 30);
        TR_MAT(a.in[I_G2] + (size_t)l * 128 * 512, 128, 512, 512, rw + 2 * 512 * 64, 1 << 30, 1 << 30);
    }
    cvt_copy(a.in[I_PSK], (bf16*)(ws + WS_SK), (size_t)LAYERS * 16 * 128 * 128, (size_t)blockIdx.x * NT + tid, (size_t)gridDim.x * NT);
}

DI void rms_row_bf16(const float* xrow, const float* w, bf16* orow, int lane) {
    const f32x4* xr = (const f32x4*)xrow + lane;
    f32x4 v[4]; float s = 0.f;
#pragma unroll
    for (int j = 0; j < 4; ++j) v[j] = xr[64 * j];
    __builtin_amdgcn_sched_barrier(0);
#pragma unroll
    for (int j = 0; j < 4; ++j) s += (v[j].x * v[j].x + v[j].y * v[j].y) + (v[j].z * v[j].z + v[j].w * v[j].w);
    const float rs = rsqrtf(wave_sum(s) * (1.f / D) + 1e-6f);
    f32x4 wv[4];
#pragma unroll
    for (int j = 0; j < 4; ++j) wv[j] = ((const f32x4*)w)[lane + 64 * j];
    __builtin_amdgcn_sched_barrier(0);
#pragma unroll
    for (int j = 0; j < 4; ++j) { const f32x4 o = v[j] * rs * wv[j];
        v2u p; p.x = pk(o.x, o.y); p.y = pk(o.z, o.w); ((v2u*)orow)[lane + 64 * j] = p; }
}
DI void p_rms(const float* x, const float* w, bf16* out, int tid) {
    const int lane = tid & 63, gw = blockIdx.x * NWAVES + (tid >> 6), NGW = gridDim.x * NWAVES;
    for (int m = gw; m < M; m += NGW) rms_row_bf16(x + (size_t)m * D, w, out + (size_t)m * D, lane);
}

DI void load_shift8(const bf16* cur, const bf16* prv, bool hp, const float* mu, float (&z)[8]) {
    const v4u c = *(const v4u*)cur; v4u p = *(const v4u*)(hp ? prv : cur);
    const f32x4 m0 = *(const f32x4*)mu, m1 = *(const f32x4*)(mu + 4);
    if (!hp) p = (v4u){0u, 0u, 0u, 0u};
    float cf[8], pf[8]; unpack8(c, cf); unpack8(p, pf);
#pragma unroll
    for (int e = 0; e < 8; ++e) { const float mm = e < 4 ? m0[e & 3] : m1[e & 3]; z[e] = cf[e] + mm * (pf[e] - cf[e]); }
}
struct Sh4 { v2u c, p; f32x4 m; };
DI void ls4_ld(const bf16* cur, const bf16* prv, bool hp, const float* mu, Sh4& s) { s.c = *(const v2u*)cur; s.p = *(const v2u*)(hp ? prv : cur); s.m = *(const f32x4*)mu; }
DI void ls4_mix(const Sh4& s, bool hp, float (&z)[4]) {
    v2u p = s.p; if (!hp) p = (v2u){0u, 0u};
    const float c0 = bflo(s.c.x), c1 = bfhi(s.c.x), c2 = bflo(s.c.y), c3 = bfhi(s.c.y), p0 = bflo(p.x), p1 = bfhi(p.x), p2 = bflo(p.y), p3 = bfhi(p.y);
    z[0] = c0 + s.m[0] * (p0 - c0); z[1] = c1 + s.m[1] * (p1 - c1); z[2] = c2 + s.m[2] * (p2 - c2); z[3] = c3 + s.m[3] * (p3 - c3);
}
DI void load_shift4(const bf16* cur, const bf16* prv, bool hp, const float* mu, float (&z)[4]) { Sh4 s; ls4_ld(cur, prv, hp, mu, s); ls4_mix(s, hp, z); }
DI void rwkv_prep_item(const Args& a, int l, int item, int lane_in, LAS unsigned char* bfr, LAS float* ms) {
    int lane = lane_in; asm volatile("" : "+v"(lane));
    const int r16_ = lane & 15, q4_ = lane >> 4, m = (item >> 2) * 16 + r16_, tm = r16_ & 3, h_lo = (item & 3) * 2;
    const bool hp = (m & (SEQ - 1)) != 0;
    const bf16* prow = (const bf16*)(a.ws + WS_PROJ) + (size_t)m * NP; const bf16* pprev = prow - NP;
    const float* mu = a.in[I_MU] + l * 1792;
    { int q4 = q4_; asm volatile("" : "+v"(q4));
#pragma unroll
    for (int ks = 0; ks < 2; ++ks) { float z[8]; const int c = ks * 32 + q4 * 8;
        load_shift8(prow + C_W + c, pprev + C_W + c, hp, mu + C_W + c, z);
#pragma unroll
        for (int e = 0; e < 8; ++e) z[e] = tanhf(z[e]);
        *(LAS bf16x8*)(bfr + ks * 8192) = pack8(z); asm volatile("" : "+v"(q4) :: "memory");
        load_shift8(prow + C_A + c, pprev + C_A + c, hp, mu + C_A + c, z); *(LAS bf16x8*)(bfr + (2 + ks) * 8192) = pack8(z); asm volatile("" : "+v"(q4) :: "memory"); }
#pragma unroll
    for (int ks = 0; ks < 4; ++ks) { float z[8]; const int c = ks * 32 + q4 * 8;
        load_shift8(prow + C_G + c, pprev + C_G + c, hp, mu + C_G + c, z);
#pragma unroll
        for (int e = 0; e < 8; ++e) z[e] = sigm(z[e]);
        *(LAS bf16x8*)(bfr + (4 + ks) * 8192) = pack8(z); asm volatile("" : "+v"(q4) :: "memory"); }
    }
    const bf16* W2T = (const bf16*)(a.ws + WS_RW) + (size_t)l * 131072; const bf16* A2T = W2T + 512 * 64; const bf16* G2T = A2T + 512 * 64;
    float* BON = (float*)(a.ws + WS_BON);
#pragma unroll 1
    for (int h_ = h_lo; h_ < h_lo + 2; ++h_) {
        int h = h_, q4 = q4_, r16 = r16_, mv = m; asm volatile("" : "+v"(h), "+v"(q4), "+v"(r16), "+v"(mv));
        const bf16* prow = (const bf16*)(a.ws + WS_PROJ) + (size_t)mv * NP; const bf16* pprev = prow - NP;
        bf16* GB = (bf16*)(a.ws + WS_G);
        float ss = 0.f, bon = 0.f;
        { Sh4 sk[4]; f32x4 kkq[4];
#pragma unroll
          for (int mt = 0; mt < 4; ++mt) { const int ch = h * 64 + mt * 16 + q4 * 4; ls4_ld(prow + C_K + ch, pprev + C_K + ch, hp, mu + C_K + ch, sk[mt]); kkq[mt] = *(const f32x4*)(a.in[I_KK] + l * 512 + ch); }
          __builtin_amdgcn_sched_barrier(0);
#pragma unroll
          for (int mt = 0; mt < 4; ++mt) { float zk1[4]; ls4_mix(sk[mt], hp, zk1);
#pragma unroll
            for (int j = 0; j < 4; ++j) { const float kr = zk1[j] * kkq[mt][j]; ss += kr * kr; } } }
        asm volatile("" : "+v"(h), "+v"(q4), "+v"(r16) :: "memory");
        ss += __shfl_xor(ss, 16); ss += __shfl_xor(ss, 32);
        const float inv = rsqrtf(fmaxf(ss, 1e-12f));
        v4u FQ[2], FR[2], FA[2], FK[2]; float qall[4][4], rall[4][4];
        unsigned char* recb = a.ws + WS_REC + ((size_t)((mv >> 13) * 8 + h) * 2048 + ((mv & (SEQ - 1)) >> 2)) * 3072;
#pragma unroll
        for (int mt = 0; mt < 4; ++mt) {
            f32x4 ag = (f32x4){0.f, 0.f, 0.f, 0.f}; const int row = h * 64 + mt * 16 + r16, ch = h * 64 + mt * 16 + q4 * 4;
            bf16x8 gf[4];
#pragma unroll
            for (int ks = 0; ks < 4; ++ks) gf[ks] = *(const bf16x8*)(G2T + row * 128 + ks * 32 + q4 * 8);
            __builtin_amdgcn_sched_barrier(0);
#pragma unroll
            for (int ks = 0; ks < 4; ++ks) ag = MFMA16(gf[ks], *(const LAS bf16x8*)(bfr + (4 + ks) * 8192), ag);
            v2u gv; gv.x = pk(ag[0], ag[1]); gv.y = pk(ag[2], ag[3]); *(v2u*)(GB + (size_t)mv * 512 + ch) = gv;
            asm volatile("" : "+v"(h), "+v"(q4), "+v"(r16) :: "memory");
        }
#pragma unroll
        for (int mt = 0; mt < 4; ++mt) {
            f32x4 aw = (f32x4){0.f, 0.f, 0.f, 0.f}, aa = aw;
            const int row = h * 64 + mt * 16 + r16;
            const int ch = h * 64 + mt * 16 + q4 * 4; float zr[4], zv[4], zkm[4];
            bf16x8 wf[2], af2[2]; Sh4 sK, sR, sV;
#pragma unroll
            for (int ks = 0; ks < 2; ++ks) { wf[ks] = *(const bf16x8*)(W2T + row * 64 + ks * 32 + q4 * 8); af2[ks] = *(const bf16x8*)(A2T + row * 64 + ks * 32 + q4 * 8); }
            ls4_ld(prow + C_K + ch, pprev + C_K + ch, hp, mu + C_K + ch, sK); ls4_ld(prow + C_R + ch, pprev + C_R + ch, hp, mu + C_R + ch, sR); ls4_ld(prow + C_V + ch, pprev + C_V + ch, hp, mu + C_V + ch, sV);
            const f32x4 w0 = *(const f32x4*)(a.in[I_W0] + l * 512 + ch), a0 = *(const f32x4*)(a.in[I_A0] + l * 512 + ch), k_k = *(const f32x4*)(a.in[I_KK] + l * 512 + ch),
                        k_a = *(const f32x4*)(a.in[I_KA] + l * 512 + ch), r_k = *(const f32x4*)(a.in[I_RK] + l * 512 + ch);
            __builtin_amdgcn_sched_barrier(0);
#pragma unroll
            for (int ks = 0; ks < 2; ++ks) { aw = MFMA16(wf[ks], *(const LAS bf16x8*)(bfr + ks * 8192), aw); aa = MFMA16(af2[ks], *(const LAS bf16x8*)(bfr + (2 + ks) * 8192), aa); }
            ls4_mix(sK, hp, zkm); ls4_mix(sR, hp, zr); ls4_mix(sV, hp, zv);
            float qv[4], rv[4], kav[4], kkv[4], ahv[4], khv[4], w4a[4];
#pragma unroll
            for (int j = 0; j < 4; ++j) {
                const float y = -(w0[j] + aw[j]);
                const float sp = fmaxf(y, 0.f) + __logf(1.0f + __expf(-fabsf(y)));
                const float dec = __expf(-__expf(-sp - 0.5f));
                const float av_ = sigm(a0[j] + aa[j]);
                const float kk = zkm[j] * k_k[j] * inv;
                const float kpr = zkm[j] * (1.0f + (av_ - 1.0f) * k_a[j]);
                bon += zr[j] * kpr * r_k[j];
                float winc = dec;
                { const float t1 = DPPQ(winc, 0x90); winc *= (tm >= 1) ? t1 : 1.0f; const float t2 = DPPQ(winc, 0x44); winc *= (tm >= 2) ? t2 : 1.0f; }
                const float wsh = DPPQ(winc, 0x90), wexc = (tm == 0) ? 1.0f : wsh, w4 = DPPQ(winc, 0xFF), rw = __builtin_amdgcn_rcpf(winc);
                const float ah = kk * av_ * rw, kh = kpr * rw;
                qv[j] = wexc * kk; rv[j] = winc * zr[j]; kav[j] = ah * w4; kkv[j] = kh * w4; w4a[j] = w4;
                *(bf16*)(recb + 2560 + (size_t)(mt * 16 + q4 * 4 + j) * 8 + tm * 2) = (bf16)(pk(zv[j], 0.f) & 0xffffu);
                ahv[j] = ah; khv[j] = kh; qall[mt][j] = qv[j]; rall[mt][j] = rv[j];
            }
            { float ka4[4] = {0.f, 0.f, 0.f, 0.f}, kk4[4] = {0.f, 0.f, 0.f, 0.f};
#pragma unroll
              for (int jj = 0; jj < 4; ++jj) { const float a0_ = DPPQ(kav[jj], 0x00), a1_ = DPPQ(kav[jj], 0x55), a2_ = DPPQ(kav[jj], 0xAA), a3_ = DPPQ(kav[jj], 0xFF);
                  const float k0_ = DPPQ(kkv[jj], 0x00), k1_ = DPPQ(kkv[jj], 0x55), k2_ = DPPQ(kkv[jj], 0xAA), k3_ = DPPQ(kkv[jj], 0xFF); const bool mine = tm == jj;
                  ka4[0] = mine ? a0_ : ka4[0]; ka4[1] = mine ? a1_ : ka4[1]; ka4[2] = mine ? a2_ : ka4[2]; ka4[3] = mine ? a3_ : ka4[3];
                  kk4[0] = mine ? k0_ : kk4[0]; kk4[1] = mine ? k1_ : kk4[1]; kk4[2] = mine ? k2_ : kk4[2]; kk4[3] = mine ? k3_ : kk4[3]; }
              *(v4u*)(recb + 1024 + (size_t)(mt * 16 + q4 * 4 + tm) * 16) = (v4u){pk(ka4[0], ka4[1]), pk(ka4[2], ka4[3]), pk(kk4[0], kk4[1]), pk(kk4[2], kk4[3])};
              if (tm == 0) *(f32x4*)(recb + 2048 + (size_t)(mt * 16 + q4 * 4) * 4) = (f32x4){w4a[0], w4a[1], w4a[2], w4a[3]}; }
            FQ[mt >> 1][(mt & 1) * 2] = pk(qv[0], qv[1]); FQ[mt >> 1][(mt & 1) * 2 + 1] = pk(qv[2], qv[3]); FR[mt >> 1][(mt & 1) * 2] = pk(rv[0], rv[1]); FR[mt >> 1][(mt & 1) * 2 + 1] = pk(rv[2], rv[3]);
            FA[mt >> 1][(mt & 1) * 2] = pk(ahv[0], ahv[1]); FA[mt >> 1][(mt & 1) * 2 + 1] = pk(ahv[2], ahv[3]); FK[mt >> 1][(mt & 1) * 2] = pk(khv[0], khv[1]); FK[mt >> 1][(mt & 1) * 2 + 1] = pk(khv[2], khv[3]);
            asm volatile("" : "+v"(h), "+v"(q4), "+v"(r16) :: "memory");
        }
        bon += __shfl_xor(bon, 16); bon += __shfl_xor(bon, 32);
        if (q4_ == 0) BON[m * 8 + h_] = bon;
        {
            f32x4 dE = (f32x4){0.f, 0.f, 0.f, 0.f}, dF = dE, dG = dE, dH = dE;
#pragma unroll
            for (int ks = 0; ks < 2; ++ks) { const bf16x8 fq = __builtin_bit_cast(bf16x8, FQ[ks]), fr = __builtin_bit_cast(bf16x8, FR[ks]), fa = __builtin_bit_cast(bf16x8, FA[ks]), fk = __builtin_bit_cast(bf16x8, FK[ks]);
                dE = MFMA16(fq, fa, dE); dF = MFMA16(fq, fk, dF); dG = MFMA16(fr, fa, dG); dH = MFMA16(fr, fk, dH); }
            if (q4_ == (r16_ >> 2)) {
#pragma unroll
                for (int jj = 0; jj < 4; ++jj) { LAS float* cp = ms + ((q4_ * 4 + 0) * 4 + jj) * 4 + tm;
                    cp[0] = tm < jj ? dE[jj] : 0.f; cp[16] = tm < jj ? dF[jj] : 0.f; cp[32] = tm <= jj ? dG[jj] : 0.f; cp[48] = tm <= jj ? dH[jj] : 0.f; } }
            asm volatile("s_waitcnt lgkmcnt(0)" ::: "memory");
            const LAS f32x4* mp = (const LAS f32x4*)(ms + (r16_ >> 2) * 64);
            const f32x4 E1 = mp[1], E2 = mp[2], E3 = mp[3], F1 = mp[5], F2 = mp[6], F3 = mp[7], Grow = mp[8 + tm], Hrow = mp[12 + tm];
            asm volatile("s_waitcnt lgkmcnt(0)" ::: "memory");
            const float t10 = -E1[0], t21 = -E2[1], t32 = -E3[2], t20 = -E2[0] + E2[1] * E1[0], t31 = -E3[1] + E3[2] * E2[1], t30 = -E3[0] + E3[1] * E1[0] + E3[2] * E2[0] - E3[2] * E2[1] * E1[0];
            const float m10 = -F1[0], m20 = -(t21 * F1[0] + F2[0]), m21 = -F2[1], m30 = -(t31 * F1[0] + t32 * F2[0] + F3[0]), m31 = -(t32 * F2[1] + F3[1]), m32 = -F3[2];
            const float T0 = tm == 0 ? 1.f : (tm == 1 ? t10 : (tm == 2 ? t20 : t30)), T1 = tm == 0 ? 0.f : (tm == 1 ? 1.f : (tm == 2 ? t21 : t31)), T2 = tm < 2 ? 0.f : (tm == 2 ? 1.f : t32), T3 = tm == 3 ? 1.f : 0.f;
            const float M0 = tm == 0 ? 0.f : (tm == 1 ? m10 : (tm == 2 ? m20 : m30)), M1 = tm < 2 ? 0.f : (tm == 2 ? m21 : m31), M2_ = tm == 3 ? m32 : 0.f;
            const float P0 = Hrow[0] + (Grow[1] * m10 + Grow[2] * m20 + Grow[3] * m30), P1 = Hrow[1] + (Grow[2] * m21 + Grow[3] * m31), P2_ = Hrow[2] + Grow[3] * m32, P3 = Hrow[3];
#pragma unroll
            for (int mt = 0; mt < 4; ++mt) { float qp[4], rp[4];
#pragma unroll
                for (int j = 0; j < 4; ++j) { const float q0 = DPPQ(qall[mt][j], 0x00), q1 = DPPQ(qall[mt][j], 0x55), q2 = DPPQ(qall[mt][j], 0xAA), q3 = DPPQ(qall[mt][j], 0xFF);
                    qp[j] = -((T0 * q0 + T1 * q1) + (T2 * q2 + T3 * q3));
                    const float Q0 = DPPQ(qp[j], 0x00), Q1 = DPPQ(qp[j], 0x55), Q2 = DPPQ(qp[j], 0xAA), Q3 = DPPQ(qp[j], 0xFF);
                    rp[j] = rall[mt][j] + ((Grow[0] * Q0 + Grow[1] * Q1) + (Grow[2] * Q2 + Grow[3] * Q3)); }
                FQ[mt >> 1][(mt & 1) * 2] = pk(qp[0], qp[1]); FQ[mt >> 1][(mt & 1) * 2 + 1] = pk(qp[2], qp[3]); FR[mt >> 1][(mt & 1) * 2] = pk(rp[0], rp[1]); FR[mt >> 1][(mt & 1) * 2 + 1] = pk(rp[2], rp[3]); }
#pragma unroll
            for (int ks = 0; ks < 2; ++ks) { *(v4u*)(recb + (size_t)((ks * 4 + tm) * 4 + q4_) * 16) = FQ[ks]; *(v4u*)(recb + 512 + (size_t)((ks * 4 + tm) * 4 + q4_) * 16) = FR[ks]; }
            if (q4_ == (r16_ >> 2)) { *(v4u*)(recb + 2304 + tm * 16) = (v4u){pk(M0, M1), pk(M2_, 0.f), pk(P0, P1), pk(P2_, P3)};
                if (tm == 0) *(v4u*)(recb + 2368) = (v4u){0u, 0u, 0u, 0u}; }
        }
    }
}
constexpr int HSP = 264;
DI void compress_item(const Args& a, int l, int item, LAS unsigned char* lds, int tid) {
    const int kv = item >> 7, b = (item >> 6) & 1, g = (item >> 5) & 1, cb = item & 31;
    const int lane = tid & 63, w = tid >> 6, r16 = lane & 15, q4 = lane >> 4;
    const bf16* src = (const bf16*)(a.ws + WS_KV0) + (size_t)(b * SEQ) * 256 + (kv ? 128 : 0) + g * 64;
    const float* pe = a.in[kv ? I_PEV : I_PEK] + l * 2048;
    const bf16* W1T = (const bf16*)(a.ws + WS_CW1) + (size_t)(l * 2 + kv) * 256 * 2048;
    const bf16* W2T = (const bf16*)(a.ws + WS_CW2) + (size_t)(l * 2 + kv) * 64 * 256;
    LAS bf16* Hs = (LAS bf16*)lds;
    const int c = cb * 16 + r16;
    f32x4 acc[2] = {(f32x4){0.f, 0.f, 0.f, 0.f}, (f32x4){0.f, 0.f, 0.f, 0.f}};
#pragma unroll 1
    for (int k4 = 0; k4 < 64; k4 += 4) { v4u raw[4]; f32x4 p0[4], p1[4]; bf16x8 wf[4][2];
#pragma unroll
        for (int i = 0; i < 4; ++i) { const int ks = k4 + i, lt = ks >> 1, d0 = (ks & 1) * 32 + q4 * 8;
            int tokn = 16 * c + lt; tokn = tokn < SEQ ? tokn : SEQ - 1;
            raw[i] = *(const v4u*)(src + (size_t)tokn * 256 + d0);
            p0[i] = *(const f32x4*)(pe + lt * 64 + d0); p1[i] = *(const f32x4*)(pe + lt * 64 + d0 + 4);
#pragma unroll
            for (int t = 0; t < 2; ++t) wf[i][t] = *(const bf16x8*)(W1T + (size_t)((2 * w + t) * 16 + r16) * 2048 + ks * 32 + q4 * 8); }
        __builtin_amdgcn_sched_barrier(0);
#pragma unroll
        for (int i = 0; i < 4; ++i) { float z[8]; unpack8(raw[i], z);
#pragma unroll
            for (int e = 0; e < 8; ++e) z[e] += e < 4 ? p0[i][e & 3] : p1[i][e & 3];
            const bf16x8 af = pack8(z);
#pragma unroll
            for (int t = 0; t < 2; ++t) acc[t] = MFMA16(af, wf[i][t], acc[t]); }
        __builtin_amdgcn_sched_barrier(0);
    }
#pragma unroll
    for (int t = 0; t < 2; ++t)
#pragma unroll
        for (int j = 0; j < 4; ++j) Hs[(q4 * 4 + j) * HSP + (2 * w + t) * 16 + r16] = (bf16)(pk(gelu_erf(acc[t][j]), 0.f) & 0xffffu);
    __syncthreads();
    if (w < 4) { f32x4 o = (f32x4){0.f, 0.f, 0.f, 0.f}; bf16x8 w2f[8];
#pragma unroll
        for (int ks = 0; ks < 8; ++ks) w2f[ks] = *(const bf16x8*)(W2T + (w * 16 + r16) * 256 + ks * 32 + q4 * 8);
        __builtin_amdgcn_sched_barrier(0);
#pragma unroll
        for (int ks = 0; ks < 8; ++ks) o = MFMA16(*(const LAS bf16x8*)(Hs + r16 * HSP + ks * 32 + q4 * 8), w2f[ks], o);
        bf16* dst = (bf16*)(a.ws + (kv ? WS_VCMP : WS_KCMP)) + ((size_t)((b * 2 + g) * 512 + cb * 16 + q4 * 4)) * 64 + w * 16 + r16;
#pragma unroll
        for (int j = 0; j < 4; ++j) dst[j * 64] = (bf16)(pk(o[j], 0.f) & 0xffffu);
    }
    __syncthreads();
}
DI void p_prep(const Args& a, int l, LAS unsigned char* lds, int tid) {
    for (int rep = 0; rep < REP_PREP; ++rep) {
    for (int it = blockIdx.x; it < 256; it += gridDim.x) compress_item(a, l, it, lds, tid);
    const int lane = tid & 63, gw = blockIdx.x * NWAVES + (tid >> 6), NGW = gridDim.x * NWAVES;
    LAS unsigned char* bfr = lds + 16384 + tid * 16; asm volatile("" : "+v"(bfr));
    LAS float* ms = (LAS float*)(lds + 81920) + (tid >> 6) * 256;
    for (int it = gw; it < M / 4; it += NGW) rwkv_prep_item(a, l, it, lane, bfr, ms);
    }
}

constexpr int SC_STEPS = 16, SC_SLOT = SC_STEPS * 768, SC_NSLOT = 12, SC_NSEQ = SEQ / SC_STEPS / 2;
constexpr size_t WS_SMID = WS_CTL + 512 * 1024;
#define SC_LOADSET(r, sq) do { _Pragma("unroll") for (int k_ = 0; k_ < 3; ++k_) r[k_] = *(const v4u*)(gp + (size_t)(sq) * SC_SLOT + k_ * 1024); } while (0)
#define SC_STAGE(r, sq) do { const int s_ = (sq); \
    if (s_ >= SC_NSLOT) { for (;;) { const unsigned m_ = min(min(FL[4], FL[5]), min(FL[6], FL[7])); if ((int)__builtin_amdgcn_readfirstlane(m_) >= s_ - (SC_NSLOT - 1)) break; __builtin_amdgcn_s_sleep(2); } } \
    asm volatile("" ::: "memory"); \
    _Pragma("unroll") for (int k_ = 0; k_ < 3; ++k_) *(LAS v4u*)(lp + ringoff + k_ * 1024) = r[k_]; \
    asm volatile("s_waitcnt lgkmcnt(0)" ::: "memory"); \
    if (lane == 0) FL[lw] = (unsigned)(s_ + 1); \
    if (s_ + 4 < SC_NSEQ) SC_LOADSET(r, s_ + 4); \
    ringoff += SC_SLOT; if (ringoff == SC_NSLOT * SC_SLOT) ringoff = 0; } while (0)
DI void scan_block(const Args& a, int job, LAS unsigned char* lds, int tid) {
    const int lane = tid & 63, w = tid >> 6, bh = job & 15, kind = job >> 4, b = bh >> 3, h = bh & 7, tbeg = kind ? SEQ / 2 : 0;
    volatile LAS unsigned* FL = (volatile LAS unsigned*)(lds + MISC_OFF) + 32;
    if (tid < 8) FL[tid] = 0u;
    __syncthreads();
    const unsigned char* src = (const unsigned char*)(a.ws + WS_REC) + ((size_t)(b * 8 + h) * SEQ + tbeg) * 768;
    if (w >= 4) {
        const int lw = w - 4;
        const unsigned char* gp = src + (lw * 192 + lane) * 16; LAS unsigned char* lp = lds + (lw * 192 + lane) * 16;
        v4u r0[3], r1[3], r2[3], r3[3]; int ringoff = 0;
        SC_LOADSET(r0, 0); SC_LOADSET(r1, 1); SC_LOADSET(r2, 2); SC_LOADSET(r3, 3);
#pragma unroll 1
        for (int sq = 0; sq < SC_NSEQ; sq += 4) { SC_STAGE(r0, sq); SC_STAGE(r1, sq + 1); SC_STAGE(r2, sq + 2); SC_STAGE(r3, sq + 3); }
    } else {
        const int r16 = lane & 15, q4 = lane >> 4; const bool lead = q4 == 0;
        bf16* yp = (bf16*)(a.ws + (kind == 2 ? WS_XN : WS_OA)) + (size_t)(b * SEQ + tbeg) * 512 + h * 64 + 16 * w + r16;
        const int oq0 = r16 < 4 ? ((0 * 4 + r16) * 4 + q4) * 16 : 2368, oq1 = r16 < 4 ? ((1 * 4 + r16) * 4 + q4) * 16 : 2368, or0 = r16 < 4 ? 512 + ((0 * 4 + r16) * 4 + q4) * 16 : 2368, or1 = r16 < 4 ? 512 + ((1 * 4 + r16) * 4 + q4) * 16 : 2368;
        const int oa3 = (lead && r16 < 4) ? 2304 + r16 * 16 : 2368, ovv = (lead && kind != 2) ? 2560 + (16 * w + r16) * 8 : 2368, ok0 = lead ? 1024 + r16 * 16 : 2368, ok1 = lead ? 1024 + (16 + r16) * 16 : 2368,
                  ok2 = lead ? 1024 + (32 + r16) * 16 : 2368, ok3 = lead ? 1024 + (48 + r16) * 16 : 2368, ow = 2048 + 16 * q4;
        f32x4 acc[4];
#pragma unroll
        for (int jt = 0; jt < 4; ++jt)
#pragma unroll
            for (int e = 0; e < 4; ++e) acc[jt][e] = (kind == 2 && 16 * w + r16 == 16 * jt + 4 * q4 + e) ? 1.0f : 0.f;
#define SB_DECL(P) v4u P##aq0, P##aq1, P##ar0, P##ar1, P##a3, P##ak0, P##ak1, P##ak2, P##ak3; f32x4 P##w0, P##w1, P##w2, P##w3; v2u P##vv;
#define SB_LOAD(P, RB) do { const LAS unsigned char* rb_ = (RB); \
        P##aq0 = *(const LAS v4u*)(rb_ + oq0); P##aq1 = *(const LAS v4u*)(rb_ + oq1); P##ar0 = *(const LAS v4u*)(rb_ + or0); P##ar1 = *(const LAS v4u*)(rb_ + or1); P##a3 = *(const LAS v4u*)(rb_ + oa3); \
        P##ak0 = *(const LAS v4u*)(rb_ + ok0); P##ak1 = *(const LAS v4u*)(rb_ + ok1); P##ak2 = *(const LAS v4u*)(rb_ + ok2); P##ak3 = *(const LAS v4u*)(rb_ + ok3); \
        P##w0 = *(const LAS f32x4*)(rb_ + ow); P##w1 = *(const LAS f32x4*)(rb_ + ow + 64); P##w2 = *(const LAS f32x4*)(rb_ + ow + 128); P##w3 = *(const LAS f32x4*)(rb_ + ow + 192); \
        P##vv = *(const LAS v2u*)(rb_ + ovv); } while (0)
#define SB_COMPUTE(P, T0) do { \
        v4u b0, b1; \
        b0.x = pk(acc[0][0], acc[0][1]); b0.y = pk(acc[0][2], acc[0][3]); b0.z = pk(acc[1][0], acc[1][1]); b0.w = pk(acc[1][2], acc[1][3]); \
        b1.x = pk(acc[2][0], acc[2][1]); b1.y = pk(acc[2][2], acc[2][3]); b1.z = pk(acc[3][0], acc[3][1]); b1.w = pk(acc[3][2], acc[3][3]); \
        const v4u b3 = (v4u){P##vv.x, P##vv.y, 0u, 0u}, a3a = (v4u){P##a3.x, P##a3.y, 0u, 0u}, a3y = (v4u){P##a3.z, P##a3.w, 0u, 0u}; \
        const f32x4 zf_ = (f32x4){0.f, 0.f, 0.f, 0.f}; \
        f32x4 da = MFMA16(__builtin_bit_cast(bf16x8, a3a), __builtin_bit_cast(bf16x8, b3), zf_), dy = MFMA16(__builtin_bit_cast(bf16x8, a3y), __builtin_bit_cast(bf16x8, b3), zf_);     \
        da = MFMA16(__builtin_bit_cast(bf16x8, P##aq0), __builtin_bit_cast(bf16x8, b0), da); \
        const f32x4 da2 = MFMA16(__builtin_bit_cast(bf16x8, P##aq1), __builtin_bit_cast(bf16x8, b1), zf_);                    \
        dy = MFMA16(__builtin_bit_cast(bf16x8, P##ar0), __builtin_bit_cast(bf16x8, b0), dy); dy = MFMA16(__builtin_bit_cast(bf16x8, P##ar1), __builtin_bit_cast(bf16x8, b1), dy); \
        da = da + da2; \
        acc[0] = acc[0] * P##w0; acc[1] = acc[1] * P##w1; acc[2] = acc[2] * P##w2; acc[3] = acc[3] * P##w3; \
        const v4u bc = (v4u){pk(da[0], da[1]), pk(da[2], da[3]), P##vv.x, P##vv.y};        \
        acc[0] = MFMA16(__builtin_bit_cast(bf16x8, P##ak0), __builtin_bit_cast(bf16x8, bc), acc[0]); acc[1] = MFMA16(__builtin_bit_cast(bf16x8, P##ak1), __builtin_bit_cast(bf16x8, bc), acc[1]); \
        acc[2] = MFMA16(__builtin_bit_cast(bf16x8, P##ak2), __builtin_bit_cast(bf16x8, bc), acc[2]); acc[3] = MFMA16(__builtin_bit_cast(bf16x8, P##ak3), __builtin_bit_cast(bf16x8, bc), acc[3]); \
        if (lead) { bf16* yq = yp + (size_t)(T0) * 512; const unsigned p01 = pk(dy[0], dy[1]), p23 = pk(dy[2], dy[3]); \
            yq[0] = (bf16)(p01 & 0xffffu); yq[512] = (bf16)(p01 >> 16); yq[1024] = (bf16)(p23 & 0xffffu); yq[1536] = (bf16)(p23 >> 16); } } while (0)
#define SB_WAIT(SQ) do { for (;;) { const unsigned m_ = min(min(FL[0], FL[1]), min(FL[2], FL[3])); if ((int)__builtin_amdgcn_readfirstlane(m_) >= (SQ) + 1) break; __builtin_amdgcn_s_sleep(1); } asm volatile("" ::: "memory"); } while (0)
        SB_DECL(A_) SB_DECL(B_)
        int ringoff = 0;
        SB_WAIT(0); SB_LOAD(A_, lds);
#pragma unroll 1
        for (int sq = 0; sq < SC_NSEQ; ++sq) {
            const LAS unsigned char* sb = lds + ringoff; const int t0 = sq * SC_STEPS;
            int nxt = ringoff + SC_SLOT; if (nxt == SC_NSLOT * SC_SLOT) nxt = 0;
            SB_LOAD(B_, sb + 3072); SB_COMPUTE(A_, t0);
            SB_LOAD(A_, sb + 6144); SB_COMPUTE(B_, t0 + 4);
            SB_LOAD(B_, sb + 9216); SB_COMPUTE(A_, t0 + 8);
            if (sq + 1 < SC_NSEQ) { SB_WAIT(sq + 1); SB_LOAD(A_, lds + nxt); }
            SB_COMPUTE(B_, t0 + 12);
            asm volatile("s_waitcnt lgkmcnt(0)" ::: "memory");
            if (lane == 0) FL[4 + w] = (unsigned)(sq + 1);
            ringoff = nxt;
        }
        if (kind == 0) { bf16* sm = (bf16*)(a.ws + WS_SMID) + (size_t)(bh * 64 + 16 * w + r16) * 64 + 4 * q4;
#pragma unroll
            for (int jt = 0; jt < 4; ++jt) { v2u o; o.x = pk(acc[jt][0], acc[jt][1]); o.y = pk(acc[jt][2], acc[jt][3]); *(v2u*)(sm + 16 * jt) = o; } }
    }
    __syncthreads();
}
DI void rwkv_post_row(const Args& a, int l, int m, int lane) {
    const int c = 8 * lane, h = lane >> 3, j0 = c & 63;
    bf16* yrow = (bf16*)(a.ws + WS_OA) + (size_t)m * 512 + c;
    float y[8], g[8]; unpack8(*(const v4u*)yrow, y); unpack8(*(const v4u*)((const bf16*)(a.ws + WS_G) + (size_t)m * 512 + c), g);
    const bf16* vvp = (const bf16*)(a.ws + WS_REC + ((size_t)((m >> 13) * 8 + h) * 2048 + ((m & (SEQ - 1)) >> 2)) * 3072 + 2560) + (size_t)j0 * 4 + (m & 3);
    float vrow[8];
#pragma unroll
    for (int e = 0; e < 8; ++e) vrow[e] = bflo((unsigned)vvp[e * 4]);
    const float bon = ((const float*)(a.ws + WS_BON))[m * 8 + h];
    float sm = 0.f;
#pragma unroll
    for (int e = 0; e < 8; ++e) sm += y[e];
    const float mean = oct_sum(sm) * (1.f / 64.f);
    float sv = 0.f;
#pragma unroll
    for (int e = 0; e < 8; ++e) { y[e] -= mean; sv += y[e] * y[e]; }
    const float rstd = rsqrtf(oct_sum(sv) * (1.f / 64.f) + 64e-5f);
    const f32x4 lw0 = *(const f32x4*)(a.in[I_LNW] + l * 512 + c), lw1 = *(const f32x4*)(a.in[I_LNW] + l * 512 + c + 4);
    const f32x4 lb0 = *(const f32x4*)(a.in[I_LNB] + l * 512 + c), lb1 = *(const f32x4*)(a.in[I_LNB] + l * 512 + c + 4);
    float o[8];
#pragma unroll
    for (int e = 0; e < 8; ++e) { const float lw = e < 4 ? lw0[e & 3] : lw1[e & 3], lb = e < 4 ? lb0[e & 3] : lb1[e & 3];
        const float v = vrow[e];
        o[e] = (y[e] * rstd * lw + lb + bon * v) * g[e]; }
    v4u w; w.x = pk(o[0], o[1]); w.y = pk(o[2], o[3]); w.z = pk(o[4], o[5]); w.w = pk(o[6], o[7]);
    *(v4u*)yrow = w;
}
DI void scan_fixup(const Args& a, int m0, int lane) {
    const int r16 = lane & 15, q4 = lane >> 4, b = m0 >> 13, mt = m0 + (r16 & 7);
    const bf16* U = (const bf16*)(a.ws + WS_XN) + (size_t)mt * 512; bf16* Y = (bf16*)(a.ws + WS_OA) + (size_t)mt * 512;
#pragma unroll 1
    for (int h = 0; h < 8; ++h) {
        const bf16* sm = (const bf16*)(a.ws + WS_SMID) + (size_t)((b * 8 + h) * 64 + r16) * 64 + q4 * 8;
        bf16x8 ub[2], sa[4][2]; v2u yo[4];
#pragma unroll
        for (int ks = 0; ks < 2; ++ks) { ub[ks] = *(const bf16x8*)(U + h * 64 + ks * 32 + q4 * 8);
#pragma unroll
            for (int it = 0; it < 4; ++it) sa[it][ks] = *(const bf16x8*)(sm + (size_t)it * 16 * 64 + ks * 32); }
#pragma unroll
        for (int it = 0; it < 4; ++it) yo[it] = *(const v2u*)(Y + h * 64 + 16 * it + 4 * q4);
        __builtin_amdgcn_sched_barrier(0);
#pragma unroll
        for (int it = 0; it < 4; ++it) { f32x4 d = (f32x4){0.f, 0.f, 0.f, 0.f};
#pragma unroll
            for (int ks = 0; ks < 2; ++ks) d = MFMA16(sa[it][ks], ub[ks], d);
            v2u o; o.x = pk(bflo(yo[it].x) + d[0], bfhi(yo[it].x) + d[1]); o.y = pk(bflo(yo[it].y) + d[2], bfhi(yo[it].y) + d[3]);
            if (r16 < 8) *(v2u*)(Y + h * 64 + 16 * it + 4 * q4) = o; }
    }
}
DI void p_post(const Args& a, int l, int tid) {
    const int lane = tid & 63, gw = blockIdx.x * NWAVES + (tid >> 6), NGW = gridDim.x * NWAVES;
    for (int grp = gw; grp < M / 8; grp += NGW) { const int m0 = grp * 8;
        if ((m0 & (SEQ - 1)) >= SEQ / 2) { scan_fixup(a, m0, lane); __threadfence(); }
#pragma unroll 1
        for (int t = 0; t < 8; ++t) rwkv_post_row(a, l, m0 + t, lane);
    }
}
constexpr int KP = 144, VP = 136;
constexpr int L_KT0 = 0, L_VT0 = 9216, L_KT1 = 17920, L_VT1 = 27136, L_IMP = 35840, L_SELM = 68864, L_UNI = 69888, L_LIST = 69920, L_NLIST = 70432, L_LUT = 70448, L_FARB = 72512, L_Q = 73728;
DI void load_kv_regs(const bf16* Ksrc, size_t kp, const bf16* Vsrc, size_t vp, int row0, int tid, v4u& kr, v4u& vr) {
    const int key = tid >> 3, ch = tid & 7;
    kr = *(const v4u*)(Ksrc + (size_t)(row0 + key) * kp + ch * 8); vr = *(const v4u*)(Vsrc + (size_t)(row0 + key) * vp + ch * 8);
}
DI void store_kv_lds(LAS unsigned char* Kt, LAS unsigned char* Vt, int tid, v4u kr, v4u vr) {
    const int key = tid >> 3, ch = tid & 7;
    *(LAS v4u*)(Kt + key * KP + ch * 16) = kr;
    *(LAS v4u*)(Vt + (ch >> 2) * 4096 + key * 64 + (ch & 3) * 16) = vr;
}
DI void load_q(const bf16* qrow, float qs, int hh, LAS unsigned char* qf) {
_Pragma("unroll")
    for (int ks = 0; ks < 4; ++ks) { float z[8]; unpack8(*(const v4u*)(qrow + ks * 16 + hh * 8), z);
_Pragma("unroll")
        for (int e = 0; e < 8; ++e) z[e] *= qs;
        *(LAS bf16x8*)(qf + ks * 8192) = pack8(z); }
}
DI void qk_tile(const LAS unsigned char* Kt, const LAS unsigned char* qf, int r, int hh, f32x16& s0, f32x16& s1) {
_Pragma("unroll")
    for (int i = 0; i < 16; ++i) { s0[i] = 0.f; s1[i] = 0.f; }
_Pragma("unroll")
    for (int ks = 0; ks < 4; ++ks) {
        const bf16x8 a0 = *(const LAS bf16x8*)(Kt + r * KP + (ks * 16 + hh * 8) * 2), a1 = *(const LAS bf16x8*)(Kt + (32 + r) * KP + (ks * 16 + hh * 8) * 2);
        const bf16x8 qv = *(const LAS bf16x8*)(qf + ks * 8192);
        s0 = MFMA32(a0, qv, s0); s1 = MFMA32(a1, qv, s1); }
}
DI void qk_tile_r(const LAS unsigned char* Kt, const bf16x8 (&qr)[4], int r, int hh, f32x16& s0, f32x16& s1) {
_Pragma("unroll")
    for (int i = 0; i < 16; ++i) { s0[i] = 0.f; s1[i] = 0.f; }
_Pragma("unroll")
    for (int ks = 0; ks < 4; ++ks) {
        const bf16x8 a0 = *(const LAS bf16x8*)(Kt + r * KP + (ks * 16 + hh * 8) * 2), a1 = *(const LAS bf16x8*)(Kt + (32 + r) * KP + (ks * 16 + hh * 8) * 2);
        s0 = MFMA32(a0, qr[ks], s0); s1 = MFMA32(a1, qr[ks], s1); }
}
typedef short v4i16_t __attribute__((ext_vector_type(4)));
DI v2u vtr(const LAS unsigned char* p) { return __builtin_bit_cast(v2u, __builtin_amdgcn_ds_read_tr16_b64_v4i16((LAS v4i16_t*)p)); }
DI void pv_tile(const LAS unsigned char* Vt, const f32x16& p0, const f32x16& p1, int r, int hh, f32x16& o0, f32x16& o1) {
    const LAS unsigned char* vp = Vt + ((r >> 4) & 1) * 32 + (r & 3) * 8 + (4 * hh + ((r & 15) >> 2)) * 64;
_Pragma("unroll")
    for (int kk = 0; kk < 4; ++kk) {
        float z[8];
_Pragma("unroll")
        for (int e = 0; e < 8; ++e) z[e] = (kk < 2) ? p0[8 * (kk & 1) + e] : p1[8 * (kk & 1) + e];
        const bf16x8 pf = pack8(z);
_Pragma("unroll")
        for (int dt = 0; dt < 2; ++dt) {
            const v2u lo = vtr(vp + dt * 4096 + kk * 1024), hi = vtr(vp + dt * 4096 + kk * 1024 + 512);
            const bf16x8 af = __builtin_bit_cast(bf16x8, ((v4u){lo.x, lo.y, hi.x, hi.y}));
            if (dt == 0) o0 = MFMA32(af, pf, o0); else o1 = MFMA32(af, pf, o1); }
    }
}
DI float max3(float a, float b, float c) { float d; asm("v_max3_f32 %0, %1, %2, %3" : "=v"(d) : "v"(a), "v"(b), "v"(c)); return d; }
DI float tile_max(const f32x16& s0, const f32x16& s1) {
    float bm = max3(s0[0], s1[0], s1[0]);
_Pragma("unroll")
    for (int i = 1; i < 16; ++i) bm = max3(bm, s0[i], s1[i]);
    return bm;
}
DI float tile_exp(f32x16& s0, f32x16& s1, float off) {
    const f32x2 off2 = (f32x2){off, off}; f32x2 ps2 = (f32x2){0.f, 0.f};
_Pragma("unroll")
    for (int i = 0; i < 16; i += 2) {
        f32x2 t = (f32x2){s0[i], s0[i + 1]} + off2, u = (f32x2){s1[i], s1[i + 1]} + off2;
        t.x = __builtin_amdgcn_exp2f(t.x); t.y = __builtin_amdgcn_exp2f(t.y); u.x = __builtin_amdgcn_exp2f(u.x); u.y = __builtin_amdgcn_exp2f(u.y);
        s0[i] = t.x; s0[i + 1] = t.y; s1[i] = u.x; s1[i + 1] = u.y; ps2 += t; ps2 += u; }
    return ps2.x + ps2.y;
}
DI void sm_update(f32x16& s0, f32x16& s1, float& m, float& lp, f32x16& o0, f32x16& o1) {
    float bm = tile_max(s0, s1);
    bm = max3(bm, __shfl_xor(bm, 32), NEG_INF);
    const float mn = fmaxf(m, bm), ms = (mn == NEG_INF) ? 0.f : mn;
    const float alpha = __builtin_amdgcn_exp2f(m - ms);
    const float ps = tile_exp(s0, s1, -ms);
    lp = lp * alpha + ps; m = mn;
    if (__builtin_amdgcn_ballot_w64(alpha != 1.0f) != 0ull) {
_Pragma("unroll")
        for (int i = 0; i < 16; ++i) { o0[i] *= alpha; o1[i] *= alpha; } }
}
DI void sm_update_row(f32x16& s0, f32x16& s1, float brow, float& m, float& lp, f32x16& o0, f32x16& o1) {
    float bm = tile_max(s0, s1);
    bm = max3(bm, __shfl_xor(bm, 32), NEG_INF) + brow;
    const float mn = fmaxf(m, bm), ms = (mn == NEG_INF) ? 0.f : mn;
    const float alpha = __builtin_amdgcn_exp2f(m - ms), off = brow - ms;
    const float ps = tile_exp(s0, s1, off);
    lp = lp * alpha + ps; m = mn;
    if (__builtin_amdgcn_ballot_w64(alpha != 1.0f) != 0ull) {
_Pragma("unroll")
        for (int i = 0; i < 16; ++i) { o0[i] *= alpha; o1[i] *= alpha; } }
}
DI void sm_pv(f32x16& s0, f32x16& s1, float brow, float& m, float& lp, f32x16& o0, f32x16& o1, const LAS unsigned char* Vt, int r, int hh) {
    float bm = tile_max(s0, s1);
    bm = max3(bm, __shfl_xor(bm, 32), NEG_INF) + brow;
    const float mn = fmaxf(m, bm), ms = (mn == NEG_INF) ? 0.f : mn;
    const float alpha = __builtin_amdgcn_exp2f(m - ms), off = brow - ms;
    if (__builtin_amdgcn_ballot_w64(alpha != 1.0f) != 0ull) {
_Pragma("unroll")
        for (int i = 0; i < 16; ++i) { o0[i] *= alpha; o1[i] *= alpha; } }
    const LAS unsigned char* vp = Vt + ((r >> 4) & 1) * 32 + (r & 3) * 8 + (4 * hh + ((r & 15) >> 2)) * 64;
    const f32x2 off2 = (f32x2){off, off}; f32x2 ps2 = (f32x2){0.f, 0.f};
_Pragma("unroll")
    for (int kk = 0; kk < 4; ++kk) {
        const v2u lo0 = vtr(vp + kk * 1024), hi0 = vtr(vp + kk * 1024 + 512), lo1 = vtr(vp + 4096 + kk * 1024), hi1 = vtr(vp + 4096 + kk * 1024 + 512);
        v4u pw;
_Pragma("unroll")
        for (int j = 0; j < 4; ++j) { const int i = 8 * (kk & 1) + 2 * j;
            f32x2 t = ((kk < 2) ? (f32x2){s0[i], s0[i + 1]} : (f32x2){s1[i], s1[i + 1]}) + off2;
            t.x = __builtin_amdgcn_exp2f(t.x); t.y = __builtin_amdgcn_exp2f(t.y); ps2 += t; pw[j] = pk(t.x, t.y); }
        const bf16x8 pf = __builtin_bit_cast(bf16x8, pw);
        o0 = MFMA32(__builtin_bit_cast(bf16x8, ((v4u){lo0.x, lo0.y, hi0.x, hi0.y})), pf, o0);
        o1 = MFMA32(__builtin_bit_cast(bf16x8, ((v4u){lo1.x, lo1.y, hi1.x, hi1.y})), pf, o1);
        __builtin_amdgcn_sched_barrier(0);
    }
    lp = lp * alpha + (ps2.x + ps2.y); m = mn;
}
#define KV_LOOP(NBLK, ROW0_OF, KSRC, KPITCH, VSRC, VPITCH, ...) do { const int nb_ = (NBLK); if (nb_ > 0) { v4u kr_, vr_; \
    { const int i_ = 0; load_kv_regs((KSRC), (KPITCH), (VSRC), (VPITCH), (ROW0_OF), tid, kr_, vr_); } \
    store_kv_lds(lds + L_KT0, lds + L_VT0, tid, kr_, vr_); __syncthreads(); \
    for (int ib_ = 0; ib_ < nb_; ++ib_) { \
        if (ib_ + 1 < nb_) { const int i_ = ib_ + 1; load_kv_regs((KSRC), (KPITCH), (VSRC), (VPITCH), (ROW0_OF), tid, kr_, vr_); } \
        { const int i_ = ib_; const LAS unsigned char* Kt = lds + ((ib_ & 1) ? L_KT1 : L_KT0); const LAS unsigned char* Vt = lds + ((ib_ & 1) ? L_VT1 : L_VT0); __VA_ARGS__ } \
        if (ib_ + 1 < nb_) store_kv_lds(lds + ((ib_ & 1) ? L_KT0 : L_KT1), lds + ((ib_ & 1) ? L_VT0 : L_VT1), tid, kr_, vr_); \
        __syncthreads(); } } } while (0)

DI void store_o(bf16* orow, const f32x16& v0, const f32x16& v1, int hh) {
_Pragma("unroll")
    for (int g4 = 0; g4 < 4; ++g4) {
        v2u w; w.x = pk(v0[4 * g4], v0[4 * g4 + 1]); w.y = pk(v0[4 * g4 + 2], v0[4 * g4 + 3]); *(v2u*)(orow + 8 * g4 + 4 * hh) = w;
        w.x = pk(v1[4 * g4], v1[4 * g4 + 1]); w.y = pk(v1[4 * g4 + 2], v1[4 * g4 + 3]); *(v2u*)(orow + 32 + 8 * g4 + 4 * hh) = w; }
}

DI void add_o(bf16* orow, const f32x16& v0, const f32x16& v1, int hh) {
_Pragma("unroll")
    for (int g4 = 0; g4 < 4; ++g4) {
        v2u* p0 = (v2u*)(orow + 8 * g4 + 4 * hh); v2u* p1 = (v2u*)(orow + 32 + 8 * g4 + 4 * hh); const v2u a0 = *p0, a1 = *p1; v2u w;
        w.x = pk(bflo(a0.x) + v0[4 * g4], bfhi(a0.x) + v0[4 * g4 + 1]); w.y = pk(bflo(a0.y) + v0[4 * g4 + 2], bfhi(a0.y) + v0[4 * g4 + 3]); *p0 = w;
        w.x = pk(bflo(a1.x) + v1[4 * g4], bfhi(a1.x) + v1[4 * g4 + 1]); w.y = pk(bflo(a1.y) + v1[4 * g4 + 2], bfhi(a1.y) + v1[4 * g4 + 3]); *p1 = w; }
}
DI void nsa_tile(const Args& a, int l, int b, int g, int qt, LAS unsigned char* lds, int tid) {
    const int lane = tid & 63, w = tid >> 6, r = lane & 31, hh = lane >> 5, head = w >> 1, ql = 32 * (w & 1) + r;
    const int t0 = qt * 64, cur = qt, tq = t0 + ql, mq = b * SEQ + tq;
    const bf16* PROJ = (const bf16*)(a.ws + WS_PROJ);
    LAS unsigned* IMP = (LAS unsigned*)(lds + L_IMP); LAS unsigned* SELM = (LAS unsigned*)(lds + L_SELM); LAS unsigned* UNI = (LAS unsigned*)(lds + L_UNI);
    LAS int* LIST = (LAS int*)(lds + L_LIST); LAS int* NLIST = (LAS int*)(lds + L_NLIST); LAS float* LUT = (LAS float*)(lds + L_LUT); LAS float* FARB = (LAS float*)(lds + L_FARB);
    { const int hh_ = tid >> 7, dist = tid & 127; LUT[hh_ * 129 + dist] = a.in[I_REL][(int)T5_BK[dist] * 16 + g * 4 + hh_] * LOG2E;
      if (tid < 4) { const float fb = a.in[I_REL][31 * 16 + g * 4 + tid] * LOG2E; FARB[tid] = fb; LUT[tid * 129 + 128] = fb; } }
    for (int i = tid; i < 64 * 129; i += NT) IMP[i] = 0u;
    if (tid < 4) UNI[tid] = 0u;
    LAS unsigned char* qf = lds + L_Q + tid * 16; asm volatile("" : "+v"(qf));
    load_q(PROJ + (size_t)mq * NP + C_NQ + (g * 4 + head) * 64, 0.125f * LOG2E, hh, qf);
    bf16* orow = (bf16*)(a.ws + WS_OB) + (size_t)mq * 512 + (g * 4 + head) * 64;
    float gc, gs, gw_;
    { const bf16* gp = PROJ + (size_t)mq * NP + C_NG + (g * 4 + head) * 3; const unsigned g0_ = (unsigned)gp[0], g1_ = (unsigned)gp[1], g2_ = (unsigned)gp[2];
      __builtin_amdgcn_sched_barrier(0);
      gc = sigm(bflo(g0_)); gs = sigm(bflo(g1_)); gw_ = sigm(bflo(g2_)); }
    f32x16 o0, o1, s0, s1;
    __syncthreads();
    const bf16* Kc = (const bf16*)(a.ws + WS_KCMP) + (size_t)((b * 2 + g) * 512) * 64; const bf16* Vc = (const bf16*)(a.ws + WS_VCMP) + (size_t)((b * 2 + g) * 512) * 64;
    int ncv = 4 * cur + 3; ncv = ncv < 511 ? ncv : 511;
    const int ncb = (ncv + 63) >> 6;
    float m = NEG_INF, lp = 0.f;
    KV_LOOP(ncb, i_ * 64, Kc, 64, Vc, 64, {
        qk_tile(Kt, qf, r, hh, s0, s1);
_Pragma("unroll")
        for (int i = 0; i < 16; ++i) { const int c0 = i_ * 64 + crow(i, hh), c1 = c0 + 32;
            s0[i] = (16 * c0 + 31 <= tq && c0 < 511) ? s0[i] : NEG_INF; s1[i] = (16 * c1 + 31 <= tq && c1 < 511) ? s1[i] : NEG_INF; }
        { float bm = tile_max(s0, s1); bm = max3(bm, __shfl_xor(bm, 32), NEG_INF);
          const float mn = fmaxf(m, bm), ms_ = (mn == NEG_INF) ? 0.f : mn;
          lp = lp * __builtin_amdgcn_exp2f(m - ms_) + tile_exp(s0, s1, -ms_); m = mn; }
    });
    {
        const float lt = lp + __shfl_xor(lp, 32), inv = lt > 0.f ? 1.0f / lt : 0.f, ms = (m == NEG_INF) ? 0.f : m;
_Pragma("unroll")
        for (int i = 0; i < 16; ++i) { o0[i] = 0.f; o1[i] = 0.f; }
        KV_LOOP(ncb, i_ * 64, Kc, 64, Vc, 64, {
            qk_tile(Kt, qf, r, hh, s0, s1);
_Pragma("unroll")
            for (int i = 0; i < 16; ++i) { const int c0 = i_ * 64 + crow(i, hh), c1 = c0 + 32;
                s0[i] = (16 * c0 + 31 <= tq && c0 < 511) ? __builtin_amdgcn_exp2f(s0[i] - ms) * inv : 0.f; s1[i] = (16 * c1 + 31 <= tq && c1 < 511) ? __builtin_amdgcn_exp2f(s1[i] - ms) * inv : 0.f; }
_Pragma("unroll")
            for (int g4 = 0; g4 < 4; ++g4) {
                const int n0 = i_ * 16 + 2 * g4 + hh, n1 = n0 + 8;
                const float G0 = (s0[4 * g4] + s0[4 * g4 + 1]) + (s0[4 * g4 + 2] + s0[4 * g4 + 3]), G1 = (s1[4 * g4] + s1[4 * g4 + 1]) + (s1[4 * g4 + 2] + s1[4 * g4 + 3]);
                __hip_atomic_fetch_add(IMP + ql * 129 + n0, (unsigned)(G0 * 1048576.f + 0.5f), __ATOMIC_RELAXED, __HIP_MEMORY_SCOPE_WORKGROUP);
                __hip_atomic_fetch_add(IMP + ql * 129 + n0 + 1, (unsigned)(s0[4 * g4 + 3] * 1048576.f + 0.5f), __ATOMIC_RELAXED, __HIP_MEMORY_SCOPE_WORKGROUP);
                __hip_atomic_fetch_add(IMP + ql * 129 + n1, (unsigned)(G1 * 1048576.f + 0.5f), __ATOMIC_RELAXED, __HIP_MEMORY_SCOPE_WORKGROUP);
                __hip_atomic_fetch_add(IMP + ql * 129 + n1 + 1, (unsigned)(s1[4 * g4 + 3] * 1048576.f + 0.5f), __ATOMIC_RELAXED, __HIP_MEMORY_SCOPE_WORKGROUP); }
            pv_tile(Vt, s0, s1, r, hh, o0, o1);
        });
_Pragma("unroll")
        for (int i = 0; i < 16; ++i) { o0[i] *= gc; o1[i] *= gc; }
        store_o(orow, o0, o1, hh);
    }
    __syncthreads();
    for (int rtk_ = 0; rtk_ < REP_TOPK; ++rtk_) {
        const int nforced = cur == 0 ? 1 : (cur == 1 ? 2 : 3), need = 16 - nforced, cnt = cur + 1 - nforced;
        for (int qq = 0; qq < 8; ++qq) { const int q = 8 * w + qq;
            const int n0 = lane, n1 = lane + 64;
            const bool f0 = (n0 == 0) || (n0 == cur) || (n0 == cur - 1), f1 = (n1 == cur) || (n1 == cur - 1);
            const bool v0 = n0 <= cur, v1 = n1 <= cur;
            unsigned i0 = IMP[q * 129 + n0], i1 = IMP[q * 129 + n1]; i0 = i0 < 0x1FFFFFEu ? i0 : 0x1FFFFFEu; i1 = i1 < 0x1FFFFFEu ? i1 : 0x1FFFFFEu;
            const unsigned k0 = (v0 && !f0) ? ((i0 << 7) | (unsigned)(127 - n0)) + 1u : 0u, k1 = (v1 && !f1) ? ((i1 << 7) | (unsigned)(127 - n1)) + 1u : 0u;
            unsigned T = 1u;
            if (cnt > need) { T = 0u;
                for (int bit = 30; bit >= 0; bit -= 2) {
                    const unsigned c1_ = T | (1u << bit), c2_ = T | (2u << bit), c3_ = T | (3u << bit);
                    const int n1_ = __popcll(__ballot(k0 >= c1_)) + __popcll(__ballot(k1 >= c1_)), n2_ = __popcll(__ballot(k0 >= c2_)) + __popcll(__ballot(k1 >= c2_)),
                              n3_ = __popcll(__ballot(k0 >= c3_)) + __popcll(__ballot(k1 >= c3_));
                    T = n3_ >= need ? c3_ : (n2_ >= need ? c2_ : (n1_ >= need ? c1_ : T)); } }
            const bool sel0 = (k0 >= T && k0 != 0u) || (f0 && v0), sel1 = (k1 >= T && k1 != 0u) || (f1 && v1);
            const unsigned long long b0 = __ballot(sel0), b1 = __ballot(sel1);
            if (lane == 0) { SELM[q * 4] = (unsigned)b0; SELM[q * 4 + 1] = (unsigned)(b0 >> 32); SELM[q * 4 + 2] = (unsigned)b1; SELM[q * 4 + 3] = (unsigned)(b1 >> 32);
                __hip_atomic_fetch_or(UNI + 0, (unsigned)b0, __ATOMIC_RELAXED, __HIP_MEMORY_SCOPE_WORKGROUP); __hip_atomic_fetch_or(UNI + 1, (unsigned)(b0 >> 32), __ATOMIC_RELAXED, __HIP_MEMORY_SCOPE_WORKGROUP);
                __hip_atomic_fetch_or(UNI + 2, (unsigned)b1, __ATOMIC_RELAXED, __HIP_MEMORY_SCOPE_WORKGROUP); __hip_atomic_fetch_or(UNI + 3, (unsigned)(b1 >> 32), __ATOMIC_RELAXED, __HIP_MEMORY_SCOPE_WORKGROUP); }
        }
    }
    __syncthreads();
    if (w == 0) {
        const unsigned long long u0 = (unsigned long long)UNI[0] | ((unsigned long long)UNI[1] << 32), u1 = (unsigned long long)UNI[2] | ((unsigned long long)UNI[3] << 32);
        const unsigned long long lowm = (1ull << lane) - 1ull;
        if ((u0 >> lane) & 1ull) LIST[__popcll(u0 & lowm)] = lane;
        if ((u1 >> lane) & 1ull) LIST[__popcll(u0) + __popcll(u1 & lowm)] = 64 + lane;
        if (lane == 0) NLIST[0] = __popcll(u0) + __popcll(u1);
    }
    __syncthreads();
    const float farb = FARB[head];
    asm volatile("s_waitcnt vmcnt(0)" ::: "memory");
    __syncthreads();
    {
        const int tl2 = 8 * w + (r & 7), head2 = r >> 3, tq2 = t0 + tl2, mq2 = b * SEQ + tq2;
        { const bf16* qrow = PROJ + (size_t)mq2 * NP + C_NQ + (g * 4 + head2) * 64;
_Pragma("unroll")
          for (int ks = 0; ks < 4; ++ks) { float z[8]; unpack8(*(const v4u*)(qrow + ks * 16 + hh * 8), z);
_Pragma("unroll")
              for (int e = 0; e < 8; ++e) z[e] *= 0.125f * LOG2E;
              *(LAS bf16x8*)(qf + 32768 + ks * 8192) = pack8(z); } }
        const unsigned sw0 = SELM[tl2 * 4], sw1 = SELM[tl2 * 4 + 1], sw2 = SELM[tl2 * 4 + 2], sw3 = SELM[tl2 * 4 + 3];
        unsigned u0 = 0u, u1 = 0u, u2 = 0u, u3 = 0u;
_Pragma("unroll")
        for (int k = 0; k < 8; ++k) { u0 |= (unsigned)__builtin_amdgcn_readlane((int)sw0, k); u1 |= (unsigned)__builtin_amdgcn_readlane((int)sw1, k);
                                      u2 |= (unsigned)__builtin_amdgcn_readlane((int)sw2, k); u3 |= (unsigned)__builtin_amdgcn_readlane((int)sw3, k); }
        const unsigned long long ulo = (unsigned long long)u0 | ((unsigned long long)u1 << 32), uhi = (unsigned long long)u2 | ((unsigned long long)u3 << 32);
        const float farb2 = FARB[head2];
        const float gs2 = sigm(bflo((unsigned)(PROJ + (size_t)mq2 * NP + C_NG + (g * 4 + head2) * 3)[1]));
        const bf16* Ks = (const bf16*)(a.ws + WS_KV0) + (size_t)(M + b * SEQ) * 256 + g * 64; const bf16* Vs = Ks + 128;
        const int nl = NLIST[0];
        for (int rsel_ = 0; rsel_ < REP_SEL; ++rsel_) {
        m = NEG_INF; lp = 0.f;
_Pragma("unroll")
        for (int i = 0; i < 16; ++i) { o0[i] = 0.f; o1[i] = 0.f; }
        KV_LOOP(nl, LIST[i_] * 64, Ks, 256, Vs, 256, {
            const int n = LIST[i_], kv0 = n * 64;
            const bool mine = n < 64 ? ((ulo >> n) & 1ull) : ((uhi >> (n - 64)) & 1ull);
            if (mine) {
_Pragma("unroll")
                for (int i = 0; i < 16; ++i) { s0[i] = 0.f; s1[i] = 0.f; }
_Pragma("unroll")
                for (int ks = 0; ks < 4; ++ks) { const bf16x8 qv = *(const LAS bf16x8*)(qf + 32768 + ks * 8192);
                    const bf16x8 a0 = *(const LAS bf16x8*)(Kt + r * KP + (ks * 16 + hh * 8) * 2), a1 = *(const LAS bf16x8*)(Kt + (32 + r) * KP + (ks * 16 + hh * 8) * 2);
                    s0 = MFMA32(a0, qv, s0); s1 = MFMA32(a1, qv, s1); }
                const unsigned swd = n < 32 ? sw0 : (n < 64 ? sw1 : (n < 96 ? sw2 : sw3));
                const bool selq = (swd >> (n & 31)) & 1u;
                float brow = selq ? farb2 : NEG_INF;
                if ((cur - n) < 3) { brow = 0.f;
_Pragma("unroll")
                    for (int i = 0; i < 16; ++i) { const int d0 = tq2 - (kv0 + crow(i, hh)), d1 = d0 - 32;
                        const float b0 = LUT[head2 * 129 + (int)min((unsigned)d0, 128u)], b1 = LUT[head2 * 129 + (int)min((unsigned)d1, 128u)];
                        s0[i] = (selq && d0 >= 0) ? s0[i] + b0 : NEG_INF; s1[i] = (selq && d1 >= 0) ? s1[i] + b1 : NEG_INF;
                        if ((i & 3) == 3) asm volatile("" ::: "memory"); }
                }
                sm_pv(s0, s1, brow, m, lp, o0, o1, Vt, r, hh);
            }
        });
        }
        const float lt = lp + __shfl_xor(lp, 32), sc = lt > 0.f ? gs2 / lt : 0.f;
_Pragma("unroll")
        for (int i = 0; i < 16; ++i) { o0[i] *= sc; o1[i] *= sc; }
        add_o((bf16*)(a.ws + WS_OB) + (size_t)mq2 * 512 + (g * 4 + head2) * 64, o0, o1, hh);
    }
    asm volatile("s_waitcnt vmcnt(0)" ::: "memory");
    __syncthreads();
    {
        const int nlo = cur >= 8 ? cur - 8 : 0;
        const bf16* Kw = (const bf16*)(a.ws + WS_KV1) + (size_t)(b * SEQ) * 256 + g * 64; const bf16* Vw = Kw + 128;
        for (int rwin_ = 0; rwin_ < REP_WIN2; ++rwin_) {
        m = NEG_INF; lp = 0.f;
_Pragma("unroll")
        for (int i = 0; i < 16; ++i) { o0[i] = 0.f; o1[i] = 0.f; }
        KV_LOOP(cur - nlo + 1, (nlo + i_) * 64, Kw, 256, Vw, 256, {
            const int kv0 = (nlo + i_) * 64, dn = cur - (nlo + i_);
            qk_tile(Kt, qf, r, hh, s0, s1);
            float brow = farb;
            if (dn < 3 || dn > 7) { brow = 0.f;
_Pragma("unroll")
                for (int i = 0; i < 16; ++i) { const int d0 = tq - (kv0 + crow(i, hh)), d1 = d0 - 32;
                    const float b0 = LUT[head * 129 + (int)min((unsigned)d0, 128u)], b1 = LUT[head * 129 + (int)min((unsigned)d1, 128u)];
                    s0[i] = (d0 >= 0 && d0 < 512) ? s0[i] + b0 : NEG_INF; s1[i] = (d1 >= 0 && d1 < 512) ? s1[i] + b1 : NEG_INF;
                    if ((i & 3) == 3) asm volatile("" ::: "memory"); }
            }
            sm_pv(s0, s1, brow, m, lp, o0, o1, Vt, r, hh);
        });
        }
        const float lt = lp + __shfl_xor(lp, 32), sc = lt > 0.f ? gw_ / lt : 0.f;
_Pragma("unroll")
        for (int i = 0; i < 16; ++i) { o0[i] *= sc; o1[i] *= sc; }
        add_o(orow, o0, o1, hh);
    }
    __syncthreads();
}
DI void swa_tile(const Args& a, int l, int b, int g, int qt, LAS unsigned char* lds, int tid) {
    const int lane = tid & 63, w = tid >> 6, r = lane & 31, hh = lane >> 5, head = w >> 1, ql = 32 * (w & 1) + r;
    const int t0 = qt * 64, cur = qt, tq = t0 + ql, mq = b * SEQ + tq;
    const bf16* PROJ = (const bf16*)(a.ws + WS_PROJ);
    LAS float* LUT = (LAS float*)(lds + L_LUT);
    { const int hh_ = tid >> 7, dist = tid & 127; LUT[hh_ * 129 + dist] = a.in[I_REL][(int)T5_BK[dist] * 16 + 8 + g * 4 + hh_] * LOG2E; if (tid < 4) LUT[tid * 129 + 128] = 0.f; }
    LAS unsigned char* qf = lds + L_Q + tid * 16; asm volatile("" : "+v"(qf));
    load_q(PROJ + (size_t)mq * NP + C_SQ + (g * 4 + head) * 64, 0.125f * LOG2E, hh, qf);
    const float sink = a.in[I_SINK][l * 8 + g * 4 + head] * LOG2E;
    f32x16 o0, o1, s0, s1;
_Pragma("unroll")
    for (int i = 0; i < 16; ++i) { o0[i] = 0.f; o1[i] = 0.f; }
    float m = sink, lp = hh == 0 ? 1.0f : 0.f;
    __syncthreads();
    const int nlo = cur >= 2 ? cur - 2 : 0;
    const bf16* Kw = (const bf16*)(a.ws + WS_KV1) + (size_t)(M + b * SEQ) * 256 + g * 64; const bf16* Vw = Kw + 128;
    KV_LOOP(cur - nlo + 1, (nlo + i_) * 64, Kw, 256, Vw, 256, {
        const int kv0 = (nlo + i_) * 64;
        qk_tile(Kt, qf, r, hh, s0, s1);
_Pragma("unroll")
        for (int i = 0; i < 16; ++i) { const int d0 = tq - (kv0 + crow(i, hh)), d1 = d0 - 32;
            s0[i] = (d0 >= 0 && d0 < 128) ? s0[i] + LUT[head * 129 + (int)min((unsigned)d0, 128u)] : NEG_INF; s1[i] = (d1 >= 0 && d1 < 128) ? s1[i] + LUT[head * 129 + (int)min((unsigned)d1, 128u)] : NEG_INF; }
        sm_pv(s0, s1, 0.f, m, lp, o0, o1, Vt, r, hh);
    });
    const float lt = lp + __shfl_xor(lp, 32), sc = 1.0f / lt;
_Pragma("unroll")
    for (int i = 0; i < 16; ++i) { o0[i] *= sc; o1[i] *= sc; }
    store_o((bf16*)(a.ws + WS_OC) + (size_t)mq * 512 + (g * 4 + head) * 64, o0, o1, hh);
    __syncthreads();
}
constexpr int CW_Q = 8192;
DI void p_mix(const Args& a, int l, LAS unsigned char* lds, int tid) {
    unsigned* qhead = (unsigned*)(a.ws + WS_CTL) + CW_Q + 64 * l;
    volatile LAS int* QI = (volatile LAS int*)(lds + MISC_OFF) + 16;
#if PROBE_DELAY_SCAN_US
    if (blockIdx.x < 48) spin_us(PROBE_DELAY_SCAN_US);
#endif
#if PROBE_DELAY_ATTN_US
    if (blockIdx.x >= 48) spin_us(PROBE_DELAY_ATTN_US);
#endif
    for (int rep = 0; rep < REP_SCAN; ++rep)
    for (int it = blockIdx.x; it < 48; it += gridDim.x) scan_block(a, it, lds, tid);
    for (;;) {
        if (tid == 0) QI[0] = (int)__hip_atomic_fetch_add(qhead, 1u, __ATOMIC_RELAXED, __HIP_MEMORY_SCOPE_AGENT);
        __syncthreads();
        const int idx = QI[0];
        __syncthreads();
        if (idx >= 1024) break;
        if (idx < 512) { const int qt = 127 - (idx >> 2), bg = idx & 3; nsa_tile(a, l, bg >> 1, bg & 1, qt, lds, tid); }
        else { const int j = idx - 512, bg = j >> 7, qt = j & 127; swa_tile(a, l, bg >> 1, bg & 1, qt, lds, tid); }
    }
}

DI void cvt_fp8(const float* src, unsigned char* dst, size_t n, float sc, size_t gtid, size_t gthreads) {
    for (size_t i = gtid * 16; i < n; i += gthreads * 16) { v4u o;
#pragma unroll
        for (int c = 0; c < 4; ++c) { const f32x4 v = *(const f32x4*)(src + i + 4 * c) * sc; int w = 0; w = __builtin_amdgcn_cvt_pk_fp8_f32(v.x, v.y, w, false); w = __builtin_amdgcn_cvt_pk_fp8_f32(v.z, v.w, w, true); o[c] = (unsigned)w; }
        *(v4u*)(dst + i) = o; }
}
DI void cvt_fp4(const float* src, unsigned char* dst, size_t n, float sc, size_t gtid, size_t gthreads) {
    for (size_t i = gtid * 16; i < n; i += gthreads * 16) { v2u o;
#pragma unroll
        for (int d = 0; d < 2; ++d) { unsigned w = 0u;
#pragma unroll
            for (int c = 0; c < 2; ++c) { const f32x4 v = *(const f32x4*)(src + i + 8 * d + 4 * c) * sc;
                if (c == 0) { w = __builtin_amdgcn_cvt_scalef32_pk_fp4_f32(w, v.x, v.y, 1.0f, 0); w = __builtin_amdgcn_cvt_scalef32_pk_fp4_f32(w, v.z, v.w, 1.0f, 1); }
                else        { w = __builtin_amdgcn_cvt_scalef32_pk_fp4_f32(w, v.x, v.y, 1.0f, 2); w = __builtin_amdgcn_cvt_scalef32_pk_fp4_f32(w, v.z, v.w, 1.0f, 3); } }
            o[d] = w; }
        *(v2u*)(dst + i / 2) = o; }
}
constexpr float PU_I4 = 96.f;
DI void cvt_i4(const float* src, unsigned char* dst, size_t n, float sc, size_t gtid, size_t gthreads) {
    for (size_t i = gtid * 16; i < n; i += gthreads * 64) { f32x4 v[4][4];
#pragma unroll
        for (int u = 0; u < 4; ++u)
#pragma unroll
            for (int c = 0; c < 4; ++c) v[u][c] = *(const f32x4*)(src + i + (size_t)u * gthreads * 16 + 4 * c);
        __builtin_amdgcn_sched_barrier(0);
#pragma unroll
        for (int u = 0; u < 4; ++u) { v2u o;
#pragma unroll
            for (int d = 0; d < 2; ++d) { unsigned w = 0u;
#pragma unroll
                for (int e = 0; e < 8; ++e) { const float x = v[u][2 * d + (e >> 2)][e & 3] * sc; int qi = (int)__builtin_rintf(x); qi = qi < -8 ? -8 : (qi > 7 ? 7 : qi); w |= ((unsigned)qi & 15u) << (4 * e); }
                o[d] = w; }
            *(v2u*)(dst + (i + (size_t)u * gthreads * 16) / 2) = o; }
        __builtin_amdgcn_sched_barrier(0); }
}
DI void p_norm2(const Args& a, int l, int tid) {
    p_rms(a.out, a.in[I_LN2] + l * D, (bf16*)(a.ws + WS_XN), tid);
    const size_t gtid = (size_t)blockIdx.x * NT + tid, gth = (size_t)gridDim.x * NT;
    cvt_i4(a.in[I_PU] + (size_t)l * 16384 * 1024, a.ws + WS_PU, (size_t)16384 * 1024, PU_I4, gtid, gth);
    cvt_fp4(a.in[I_PV] + (size_t)l * 16384 * 1024, a.ws + WS_PV, (size_t)16384 * 1024, PV_SCALE, gtid, gth);
}
constexpr int P_SC = 0, P_TOP = 132096, P_EXP = 0, P_GATE = 8192;
DI void peer_item(const Args& a, int l, int item, LAS unsigned char* lds, int tid, bool dry) {
    const int lane = tid & 63, w = tid >> 6, r16 = lane & 15, q4 = lane >> 4, m0 = item * 16;
    LAS float* SC = (LAS float*)(lds + P_SC); LAS float* TOP = (LAS float*)(lds + P_TOP); LAS int* EXPI = (LAS int*)(lds + P_EXP); LAS float* GATE = (LAS float*)(lds + P_GATE);
    const bf16* PQ = (const bf16*)(a.ws + WS_PQ); const bf16* SK = (const bf16*)(a.ws + WS_SK) + (size_t)l * 16 * 128 * 128;
#pragma unroll 1
    for (int hpi = 0; hpi < 2; ++hpi) { const int hp = 2 * w + hpi;
        bf16x8 af[4], bq[4][8];
        const bf16* ap = PQ + (size_t)(m0 + r16) * 2048 + hp * 128 + q4 * 8; const bf16* bp = SK + (size_t)(hp * 128 + r16) * 128 + q4 * 8;
#pragma unroll
        for (int ks = 0; ks < 4; ++ks) { af[ks] = *(const bf16x8*)(ap + ks * 32);
#pragma unroll
            for (int nt = 0; nt < 8; ++nt) bq[ks][nt] = *(const bf16x8*)(bp + (size_t)nt * 16 * 128 + ks * 32); }
        __builtin_amdgcn_sched_barrier(0);
        f32x4 acc[8];
#pragma unroll
        for (int nt = 0; nt < 8; ++nt) acc[nt] = (f32x4){0.f, 0.f, 0.f, 0.f};
#pragma unroll
        for (int ks = 0; ks < 4; ++ks)
#pragma unroll
            for (int nt = 0; nt < 8; ++nt) acc[nt] = MFMA16(af[ks], bq[ks][nt], acc[nt]);
#pragma unroll
        for (int nt = 0; nt < 8; ++nt)
#pragma unroll
            for (int j = 0; j < 4; ++j) SC[((q4 * 4 + j) * 16 + hp) * 129 + nt * 16 + r16] = acc[nt][j];
        __builtin_amdgcn_sched_barrier(0);
    }
    __syncthreads();
    if (tid < 256) { float T[16], Gv[16];
#define PK_LOAD16(A, g) _Pragma("unroll") for (int i_ = 0; i_ < 16; ++i_) A[i_] = __uint_as_float((__float_as_uint(SC[tid * 129 + (g) * 16 + i_]) & ~0x7Fu) | (unsigned)((g) * 16 + i_))
#define PK_CE(A, i_, l_) do { const float hi_ = fmaxf(A[i_], A[l_]), lo_ = fminf(A[i_], A[l_]); A[i_] = hi_; A[l_] = lo_; } while (0)
#define PK_SORT16(A) _Pragma("unroll") for (int k_ = 2; k_ <= 16; k_ <<= 1) _Pragma("unroll") for (int j_ = k_ >> 1; j_ > 0; j_ >>= 1) _Pragma("unroll") for (int i_ = 0; i_ < 16; ++i_) { const int l_ = i_ ^ j_; \
            if (l_ > i_) { if (((i_ & k_) == 0) || k_ == 16) PK_CE(A, i_, l_); else PK_CE(A, l_, i_); } }
#define PK_MERGE16(A) _Pragma("unroll") for (int j_ = 8; j_ > 0; j_ >>= 1) _Pragma("unroll") for (int i_ = 0; i_ < 16; ++i_) { const int l_ = i_ ^ j_; if (l_ > i_) PK_CE(A, i_, l_); }
        PK_LOAD16(T, 0); PK_SORT16(T);
#pragma unroll 1
        for (int g = 1; g < 8; ++g) { PK_LOAD16(Gv, g); PK_SORT16(Gv);
#pragma unroll
            for (int i_ = 0; i_ < 16; ++i_) T[i_] = fmaxf(T[i_], Gv[15 - i_]);
            PK_MERGE16(T); }
#pragma unroll
        for (int k = 0; k < 16; ++k) TOP[tid * 17 + k] = T[k]; }
    __syncthreads();
    if (tid < 128) { const int tok = tid >> 3, h = tid & 7; const LAS float* T1 = TOP + ((tok * 16 + 2 * h) * 17), *T2 = TOP + ((tok * 16 + 2 * h + 1) * 17);
        float s1[16], s2[16], L[16];
#pragma unroll
        for (int k = 0; k < 16; ++k) { s1[k] = T1[k]; s2[k] = T2[k]; L[k] = NEG_INF; }
#pragma unroll
        for (int aa = 0; aa < 16; ++aa)
#pragma unroll
            for (int bb = 0; bb < 16; ++bb) if ((aa + 1) * (bb + 1) <= 16) {
                float x = __uint_as_float((__float_as_uint(s1[aa] + s2[bb]) & ~0xFFu) | (unsigned)(aa * 16 + bb));
#pragma unroll
                for (int k = 0; k < 16; ++k) { const float hi = fmaxf(L[k], x); x = fminf(L[k], x); L[k] = hi; } }
        float e[16], se = 0.f;
#pragma unroll
        for (int k = 0; k < 16; ++k) { e[k] = __expf(L[k] - L[0]); se += e[k]; }
        const float inv = 1.0f / se;
#pragma unroll
        for (int k = 0; k < 16; ++k) { const unsigned id = __float_as_uint(L[k]) & 0xFFu; const int i1 = (int)(__float_as_uint(T1[id >> 4]) & 0x7Fu), i2 = (int)(__float_as_uint(T2[id & 15u]) & 0x7Fu);
            EXPI[tok * 128 + h * 16 + k] = i1 * 128 + i2; GATE[tok * 128 + h * 16 + k] = e[k] * inv; }
    }
    __syncthreads();
    const unsigned char* PU = a.ws + WS_PU; const unsigned char* PV = a.ws + WS_PV;
#pragma unroll 1
    for (int ti = 0; ti < 2; ++ti) { const int tt = 2 * w + ti, m = m0 + tt;
        bf16* zrow = (bf16*)(a.ws + WS_XN) + (size_t)m * 1024 + 16 * lane;
        unsigned zh[2], zl[2]; float uinv;
        { float zf[16]; { float t8[8]; unpack8(*(const v4u*)zrow, t8);
#pragma unroll
            for (int c = 0; c < 8; ++c) zf[c] = t8[c];
            unpack8(*(const v4u*)(zrow + 8), t8);
#pragma unroll
            for (int c = 0; c < 8; ++c) zf[8 + c] = t8[c]; }
          float am = 0.f;
#pragma unroll
          for (int c = 0; c < 16; ++c) am = fmaxf(am, fabsf(zf[c]));
          am = fmaxf(am, __shfl_xor(am, 1)); am = fmaxf(am, __shfl_xor(am, 2)); am = fmaxf(am, __shfl_xor(am, 4)); am = fmaxf(am, __shfl_xor(am, 8)); am = fmaxf(am, __shfl_xor(am, 16)); am = fmaxf(am, __shfl_xor(am, 32));
          am = fmaxf(am, 1e-20f);
          const float sz = 119.0f / am; uinv = am * (1.0f / (119.0f * PU_I4));
#pragma unroll
          for (int d = 0; d < 2; ++d) { unsigned wh = 0u, wl = 0u;
#pragma unroll
            for (int e = 0; e < 8; ++e) { const int z8 = (int)__builtin_rintf(zf[8 * d + e] * sz); const int lo = ((z8 + 8) & 15) - 8, hi = (z8 - lo) >> 4;
                wh |= ((unsigned)hi & 15u) << (4 * e); wl |= ((unsigned)lo & 15u) << (4 * e); }
            zh[d] = wh; zl[d] = wl; } }
        f32x2 acc[8];
#pragma unroll
        for (int d = 0; d < 8; ++d) acc[d] = (f32x2){0.f, 0.f};
        const int id_lo = EXPI[tt * 128 + lane], id_hi = EXPI[tt * 128 + 64 + lane]; const float gt_lo = GATE[tt * 128 + lane], gt_hi = GATE[tt * 128 + 64 + lane];
#define DPPI(v, ctrl) __builtin_amdgcn_update_dpp(0, (v), (ctrl), 0xF, 0xF, true)
#pragma unroll 1
        for (int half = 0; half < 2; ++half) { const int idr = half ? id_hi : id_lo; const float gtr = half ? gt_hi : gt_lo;
            int coll = 0;
#pragma unroll 1
            for (int e0 = 0; e0 < 64; e0 += 32) { v2u ur[32];
#pragma unroll
                for (int k = 0; k < 32; ++k) { const int eid = __builtin_amdgcn_readlane(idr, e0 + k); ur[k] = *(const v2u*)(PU + (size_t)eid * 512 + 8 * lane); }
#pragma unroll
                for (int gq = 0; gq < 4; ++gq) { int x8[8];
#pragma unroll
                    for (int k = 0; k < 8; ++k) { const int w0 = (int)ur[8 * gq + k][0], w1 = (int)ur[8 * gq + k][1];
                        int hi = __builtin_amdgcn_sdot8(w0, (int)zh[0], 0, false); hi = __builtin_amdgcn_sdot8(w1, (int)zh[1], hi, false);
                        int lo = __builtin_amdgcn_sdot8(w0, (int)zl[0], 0, false); lo = __builtin_amdgcn_sdot8(w1, (int)zl[1], lo, false);
                        x8[k] = (hi << 4) + lo; }
                    int y4[4], z2[2], u;
#pragma unroll
                    for (int k = 0; k < 4; ++k) { const bool o = lane & 1; const int keep = o ? x8[2 * k + 1] : x8[2 * k], send = o ? x8[2 * k] : x8[2 * k + 1]; y4[k] = keep + DPPI(send, 0xB1); }
#pragma unroll
                    for (int k = 0; k < 2; ++k) { const bool o = lane & 2; const int keep = o ? y4[2 * k + 1] : y4[2 * k], send = o ? y4[2 * k] : y4[2 * k + 1]; z2[k] = keep + DPPI(send, 0x4E); }
                    { const bool o = lane & 4; const int keep = o ? z2[1] : z2[0], send = o ? z2[0] : z2[1]; const int fr_hi = DPPI(send, 0x104), fr_lo = DPPI(send, 0x114); u = keep + (o ? fr_lo : fr_hi); }
                    u += DPPI(u, 0x128);
                    { int ub; asm volatile("v_mov_b32_e32 %1, %0\n\ts_nop 1\n\tv_permlane16_swap_b32_e32 %0, %1" : "+v"(u), "=&v"(ub)); u += ub; }
                    { int ub; asm volatile("v_mov_b32_e32 %1, %0\n\ts_nop 1\n\tv_permlane32_swap_b32_e32 %0, %1" : "+v"(u), "=&v"(ub)); u += ub; }
                    coll = ((lane >> 3) == ((e0 >> 3) + gq)) ? u : coll; }
            }
            const float actr = gtr * gelu_erf((float)coll * uinv) * (1.0f / PV_SCALE);
#pragma unroll 1
            for (int e0 = 0; e0 < 64; e0 += 32) { v2u vr[32];
#pragma unroll
                for (int k = 0; k < 32; ++k) { const int eid = __builtin_amdgcn_readlane(idr, e0 + k); vr[k] = *(const v2u*)(PV + (size_t)eid * 512 + 8 * lane); }
#pragma unroll
                for (int k = 0; k < 32; ++k) { const float act = __builtin_bit_cast(float, __builtin_amdgcn_readlane(__builtin_bit_cast(int, actr), e0 + k));
#pragma unroll
                    for (int d = 0; d < 2; ++d) { const unsigned wv = vr[k][d];
                        acc[4 * d] += __builtin_amdgcn_cvt_scalef32_pk_f32_fp4(wv, 1.0f, 0) * act; acc[4 * d + 1] += __builtin_amdgcn_cvt_scalef32_pk_f32_fp4(wv, 1.0f, 1) * act;
                        acc[4 * d + 2] += __builtin_amdgcn_cvt_scalef32_pk_f32_fp4(wv, 1.0f, 2) * act; acc[4 * d + 3] += __builtin_amdgcn_cvt_scalef32_pk_f32_fp4(wv, 1.0f, 3) * act; } }
            }
        }
#undef DPPI
        if ((DBG_ZERO >> 3) & 1) {
#pragma unroll
            for (int d = 0; d < 8; ++d) acc[d] = (f32x2){0.f, 0.f}; }
        float* xo = a.out + (size_t)m * 1024 + 16 * lane;
        f32x4 x0 = *(const f32x4*)(xo), x1 = *(const f32x4*)(xo + 4), x2 = *(const f32x4*)(xo + 8), x3 = *(const f32x4*)(xo + 12);
        x0 += (f32x4){acc[0].x, acc[0].y, acc[1].x, acc[1].y}; x1 += (f32x4){acc[2].x, acc[2].y, acc[3].x, acc[3].y}; x2 += (f32x4){acc[4].x, acc[4].y, acc[5].x, acc[5].y}; x3 += (f32x4){acc[6].x, acc[6].y, acc[7].x, acc[7].y};
        float ss = (x0.x * x0.x + x0.y * x0.y + x0.z * x0.z + x0.w * x0.w) + (x1.x * x1.x + x1.y * x1.y + x1.z * x1.z + x1.w * x1.w)
                 + (x2.x * x2.x + x2.y * x2.y + x2.z * x2.z + x2.w * x2.w) + (x3.x * x3.x + x3.y * x3.y + x3.z * x3.z + x3.w * x3.w);
        const float rs = rsqrtf(wave_sum(ss) * (1.f / D) + 1e-6f);
        if (dry) continue;
        const float* nw = ((l == LAYERS - 1) ? a.in[I_LNF] : a.in[I_LN1] + (l + 1) * D) + 16 * lane;
        const f32x4 w0 = *(const f32x4*)(nw), w1 = *(const f32x4*)(nw + 4), w2 = *(const f32x4*)(nw + 8), w3 = *(const f32x4*)(nw + 12);
        const f32x4 n0 = x0 * rs * w0, n1 = x1 * rs * w1, n2 = x2 * rs * w2, n3 = x3 * rs * w3;
        if (l == LAYERS - 1) {
            *(f32x4*)(xo) = n0; *(f32x4*)(xo + 4) = n1; *(f32x4*)(xo + 8) = n2; *(f32x4*)(xo + 12) = n3;
        } else {
            *(f32x4*)(xo) = x0; *(f32x4*)(xo + 4) = x1; *(f32x4*)(xo + 8) = x2; *(f32x4*)(xo + 12) = x3;
            v4u p; p.x = pk(n0.x, n0.y); p.y = pk(n0.z, n0.w); p.z = pk(n1.x, n1.y); p.w = pk(n1.z, n1.w); *(v4u*)(zrow) = p;
            p.x = pk(n2.x, n2.y); p.y = pk(n2.z, n2.w); p.z = pk(n3.x, n3.y); p.w = pk(n3.z, n3.w); *(v4u*)(zrow + 8) = p;
        }
    }
    __syncthreads();
}
DI void p_peer(const Args& a, int l, LAS unsigned char* lds, int tid) {
    for (int rep = 0; rep < REP_PEER; ++rep)
    for (int it = blockIdx.x; it < M / 16; it += gridDim.x) { int dflag = (rep + 1 < REP_PEER) ? 1 : 0; asm volatile("" : "+s"(dflag)); peer_item(a, l, it, lds, tid, dflag != 0); }
}

#ifndef MK_PER_PHASE
#define MK_PER_PHASE 0
#endif
#ifndef PH_MASK
#define PH_MASK 0x7FF
#endif
#define PHASE_ON(j) ((((PH_MASK) >> (j)) & 1) != 0)
constexpr int NPH = 1 + 10 * LAYERS;
__global__ void __launch_bounds__(NT, 2) fwd(Args a_unused) {
    typedef const __attribute__((address_space(4))) Args* KArgP;
    KArgP kap = (KArgP)__builtin_amdgcn_kernarg_segment_ptr();
    Args a; __builtin_memcpy(&a, kap, sizeof(Args));
    extern __shared__ __attribute__((aligned(16))) unsigned char lds_raw[];
    LAS unsigned char* lds = (LAS unsigned char*)lds_raw;
    const int tid0 = threadIdx.x;
#define tid tid0
    volatile LAS unsigned* MISC = (volatile LAS unsigned*)(lds + MISC_OFF);
    if (tid < 64) MISC[tid] = 0u;
    __syncthreads();
    unsigned* ctl = (unsigned*)(a.ws + WS_CTL);
    XcdBarrier bar = xcd_barrier_post(ctl + CW_BAR, MISC + 8);
    const int lo = a.ph_lo, hi = a.ph_hi;
#define IN(k) (lo <= (k) && (k) < hi)
#define SEAM(k) do { if (IN(k) && IN((k) + 1)) xcd_barrier(bar); } while (0)
    unsigned char* ws = a.ws;
#undef tid
#define LAUNDER_ARGS Args a; { KArgP p_ = kap; asm volatile("" : "+s"(p_)); __builtin_memcpy(&a, p_, sizeof(Args)); } unsigned char* ws = a.ws; const float* xin = (l == 0) ? a.in[I_X] : a.out
#define LAUNDER_TID int tid = tid0; asm volatile("" : "+v"(tid)); Args a; { KArgP p_ = kap; asm volatile("" : "+s"(p_)); __builtin_memcpy(&a, p_, sizeof(Args)); }
    if (PHASE_ON(10) && IN(0)) { LAUNDER_TID; for (int rep = 0; rep < REP_PRO; ++rep) p_prologue(a, lds, tid);
        p_rms(a.in[I_X], a.in[I_LN1], (bf16*)(ws + WS_XN), tid);
        if (IN(0) && IN(2)) xcd_barrier(bar); }
    for (int l = 0; l < LAYERS; ++l) {
        const int pb = 1 + 10 * l;
        const float* xin = (l == 0) ? a.in[I_X] : a.out;
        if (PHASE_ON(1) && IN(pb + 1)) { LAUNDER_ARGS;
            pg8::Gemm g{(const bf16*)(ws + WS_XN), (const bf16*)(ws + WS_WIN) + (size_t)l * NP * 1024, M, NP, 1024}; pg8::StaticOrder S; S.init(M, NP, gridDim.x, blockIdx.x);
            pg8::EpiBf16P E{(bf16*)(ws + WS_PROJ), NP, KV_TILE_MASK, (bf16*)(ws + WS_KV0), (bf16*)(ws + WS_KV1)};
            for (int rep = 0; rep < REP_WIN; ++rep) pg8::gemm_phase<pg8::EpiBf16P, pg8::StaticOrder, true, true>(lds, g, S, E);
            SEAM(pb + 1); }
        if (PHASE_ON(2) && IN(pb + 2)) { LAUNDER_TID; p_prep(a, l, lds, tid); SEAM(pb + 2); }
        if (PHASE_ON(3) && IN(pb + 3)) { LAUNDER_TID; p_mix(a, l, lds, tid); SEAM(pb + 3); }
        if (PHASE_ON(4) && IN(pb + 4)) { LAUNDER_TID; p_post(a, l, tid); SEAM(pb + 4); }
        if (PHASE_ON(5) && IN(pb + 5)) { LAUNDER_ARGS;
            pg8::StaticOrder S; S.init(M, 1024, gridDim.x, blockIdx.x);
            const bf16* Gp = (const bf16*)(ws + WS_PROJ) + C_GA; bf16* MG = (bf16*)(ws + WS_XN); const bf16* WB = (const bf16*)(ws + WS_WBR) + (size_t)l * 3 * 1024 * 512;
#pragma unroll 1
            for (int br3 = 0; br3 < 3 * REP_MERGE; ++br3) { const int br = br3 % 3;
                pg8::Gemm g{(const bf16*)(ws + WS_OA + (size_t)br * (WS_OB - WS_OA)), WB + (size_t)br * 1024 * 512, M, 1024, 512}; pg8::EpiMerge E{Gp + br * 1024, NP, MG, br, ((DBG_ZERO >> br) & 1) ? 0.f : 1.f};
                pg8::gemm_phase<pg8::EpiMerge, pg8::StaticOrder, true, true>(lds, g, S, E); }
            SEAM(pb + 5); }
        if (PHASE_ON(6) && IN(pb + 6)) { LAUNDER_ARGS;
            pg8::Gemm g{(const bf16*)(ws + WS_XN), (const bf16*)(ws + WS_WOUT) + (size_t)l * 1024 * 1024, M, 1024, 1024}; pg8::StaticOrder S; S.init(M, 1024, gridDim.x, blockIdx.x);
            pg8::EpiResid E{xin, a.out};
            pg8::gemm_phase<pg8::EpiResid, pg8::StaticOrder, true, true>(lds, g, S, E);
            SEAM(pb + 6); }
        if (PHASE_ON(7) && IN(pb + 7)) { LAUNDER_TID; for (int rep = 0; rep < REP_NORM2; ++rep) p_norm2(a, l, tid); SEAM(pb + 7); }
        if (PHASE_ON(8) && IN(pb + 8)) { LAUNDER_ARGS;
            pg8::Gemm g{(const bf16*)(ws + WS_XN), (const bf16*)(ws + WS_WQ) + (size_t)l * 2048 * 1024, M, 2048, 1024}; pg8::StaticOrder S; S.init(M, 2048, gridDim.x, blockIdx.x);
            pg8::EpiBf16P E{(bf16*)(ws + WS_PQ), 2048, 0u, nullptr, nullptr};
            for (int rep = 0; rep < REP_PQ; ++rep) pg8::gemm_phase<pg8::EpiBf16P, pg8::StaticOrder, true, true>(lds, g, S, E);
            SEAM(pb + 8); }
        if (PHASE_ON(9) && IN(pb + 9)) { LAUNDER_TID; p_peer(a, l, lds, tid); if (l + 1 < LAYERS) { if (IN(pb + 9) && IN(pb + 11)) xcd_barrier(bar); } }
    }
#undef IN
#undef SEAM
}

extern "C" void kernel_launch(void* const* d_in, const int* in_sizes, int n_in, void* d_out, int out_size, void* d_ws, size_t ws_size, hipStream_t stream) {
    static int grid = 0;
    if (grid == 0) {
        if (n_in != 32 || in_sizes[0] != M * D || out_size != M * D || ws_size < WS_END) { fprintf(stderr, "kernel_launch: unexpected problem shape / workspace (%d inputs, ws %zu)\n", n_in, ws_size); grid = -1; return; }
        int dev = 0, cus = 0, per_cu = 0;
        if (hipGetDevice(&dev) != hipSuccess || hipDeviceGetAttribute(&cus, hipDeviceAttributeMultiprocessorCount, dev) != hipSuccess) { grid = -1; return; }
        if (hipFuncSetAttribute((const void*)fwd, hipFuncAttributeMaxDynamicSharedMemorySize, LDS_BYTES) != hipSuccess) { fprintf(stderr, "kernel_launch: hipFuncSetAttribute failed\n"); grid = -1; return; }
        if (hipOccupancyMaxActiveBlocksPerMultiprocessor(&per_cu, (const void*)fwd, NT, LDS_BYTES) != hipSuccess || per_cu < 1) { fprintf(stderr, "kernel_launch: occupancy query says %d\n", per_cu); (void)hipGetLastError(); }
        grid = cus;
    }
    if (grid < 0) return;
    (void)hipMemsetAsync((char*)d_ws + WS_CTL, 0, CTL_ZERO_BYTES, stream);
    Args a{};
    for (int i = 0; i < 32; ++i) a.in[i] = (const float*)d_in[i];
    a.out = (float*)d_out; a.ws = (unsigned char*)d_ws;
#if MK_PER_PHASE
    for (int p = 0; p < NPH; ++p) { if (p == 1 || p == 11) continue; a.ph_lo = p; a.ph_hi = p + 1; hipLaunchKernelGGL(fwd, dim3(grid), dim3(NT), LDS_BYTES, stream, a); }
#else
    a.ph_lo = 0; a.ph_hi = NPH;
    hipLaunchKernelGGL(fwd, dim3(grid), dim3(NT), LDS_BYTES, stream, a);
#endif
}
```

```cpp
#include <hip/hip_runtime.h>
#include <cstdio>
#include <cstdint>
#define DI __device__ __forceinline__
#define GAS __attribute__((address_space(1)))
#define LAS __attribute__((address_space(3)))
typedef unsigned short bf16;
typedef unsigned v4u __attribute__((ext_vector_type(4)));
typedef unsigned v2u __attribute__((ext_vector_type(2)));
typedef float f32x2 __attribute__((ext_vector_type(2)));
typedef float f32x4 __attribute__((ext_vector_type(4)));
typedef float f32x16 __attribute__((ext_vector_type(16)));
typedef short bf16x8 __attribute__((ext_vector_type(8)));
typedef short s16x4 __attribute__((ext_vector_type(4)));
typedef __bf16 bfx2 __attribute__((ext_vector_type(2)));
struct U3 { unsigned a, b, c; };

namespace pg8 {
#define PG8_LAS __attribute__((address_space(3)))
typedef unsigned short bf16_t;
typedef short bf16x8 __attribute__((ext_vector_type(8)));
typedef float f32x4 __attribute__((ext_vector_type(4)));
typedef unsigned u32x4 __attribute__((ext_vector_type(4)));
constexpr int BM = 256, BK = 64, HALF = 128, HTB = HALF * BK * 2  , STAGE_BYTES = 8 * HTB, NXCD = 8, WGM = 8;

__host__ __device__ __forceinline__ int lds_byte(int r, int c) { const int st = (r >> 4) * 2 + (c >> 5), rr = r & 15, cc = c & 31, ob = rr * 64 + cc * 2; return st * 1024 + (ob ^ (((ob >> 9) & 1) << 5)); }
__host__ __device__ __forceinline__ void stage_rc(int b, int& R, int& C) { const int st = b / 1024, sb = b % 1024, swz = sb ^ (((sb >> 9) & 1) << 5); R = (st >> 1) * 16 + swz / 64; C = (st & 1) * 32 + (swz % 64) / 2; }
__host__ __device__ __forceinline__ int perm32(int rho) { const int n = rho >> 4, i = rho & 15; return 8 * (i >> 2) + 4 * n + (i & 3); }

struct Unit { int pm, pn; };
struct Gemm { const bf16_t* A; const bf16_t* Bt; int M, N, K; };

struct StaticOrder {
    int nM, nN, nwg, G, c;
    __host__ __device__ void init(int M, int N, int G_, int c_) { nM = M / BM; nN = N / BM; nwg = nM * nN; G = G_; c = c_; }
    __host__ __device__ bool next(int i, Unit& u) const {
        const long L = (long)i * G + c; if (L >= nwg) return false;
        int wgid = (int)L; { const int q = nwg / NXCD, r = nwg % NXCD, xcd = wgid % NXCD, off = wgid / NXCD; wgid = (xcd < r ? xcd * (q + 1) : r * (q + 1) + (xcd - r) * q) + off; }
        const int nig = WGM * nN, gid = wgid / nig, fm = gid * WGM, gsz = (nM - fm) < WGM ? (nM - fm) : WGM;
        u.pm = fm + ((wgid % nig) % gsz); u.pn = (wgid % nig) / gsz; return true;
    }
    __device__ __forceinline__ void a_ready(const Unit&) const {}
    __device__ __forceinline__ void done(const Unit&) const {}
};

__device__ __forceinline__ unsigned cvt_pk_bf16(float lo, float hi) { unsigned r; asm volatile("v_cvt_pk_bf16_f32 %0, %1, %2" : "=v"(r) : "v"(lo), "v"(hi)); return r; }
typedef float f32x2 __attribute__((ext_vector_type(2)));
__device__ __forceinline__ f32x2 gelu_pk(f32x2 v) {
    const f32x2 av = __builtin_elementwise_abs(v), d = av * 0.2316418882f + 1.0f;
    f32x2 t; t.x = __builtin_amdgcn_rcpf(d.x); t.y = __builtin_amdgcn_rcpf(d.y);
    f32x2 q = t * 0.5307027145f + (-0.7265760135f); q = q * t + 0.7107068705f; q = q * t + (-0.142248368f); q = q * t + 0.127414796f; q = q * t;
    const f32x2 s = (v * v) * (-0.72134752044f);
    f32x2 e; e.x = __builtin_amdgcn_exp2f(s.x); e.y = __builtin_amdgcn_exp2f(s.y);
    const f32x2 m = v * (q * e), r = v - m;
    f32x2 o; o.x = v.x < 0.f ? m.x : r.x; o.y = v.y < 0.f ? m.y : r.y; return o;
}

__device__ __forceinline__ float sigm(float x) { return __builtin_amdgcn_rcpf(1.0f + __expf(-x)); }
struct EpiBf16P {
    static constexpr bool PERM = true, AFTER_DRAIN = false;
    bf16_t* O; int ldc; unsigned kvmask; bf16_t* KV0; bf16_t* KV1;
    __device__ __forceinline__ void operator()(const f32x4 (&acc)[2][2][4][2], const Unit& u, int wr, int wc, int fr, int fq) const {
        const int row0 = u.pm * BM + wr * 64 + fr; int col0 = u.pn * BM + wc * 32 + 8 * fq, ld = ldc; bf16_t* base = O;
        if ((kvmask >> u.pn) & 1u) { const int slot = __builtin_popcount(kvmask & ((1u << u.pn) - 1u)); base = (slot < 2 ? KV0 : KV1) + (size_t)(slot & 1) * 16384 * 256; ld = 256; col0 = wc * 32 + 8 * fq; }
#pragma unroll
        for (int ai = 0; ai < 2; ++ai)
#pragma unroll
            for (int m = 0; m < 4; ++m) { bf16_t* rowp = base + (size_t)(row0 + ai * HALF + m * 16) * ld + col0;
#pragma unroll
                for (int bj = 0; bj < 2; ++bj) { const f32x4 v0 = acc[ai][bj][m][0], v1 = acc[ai][bj][m][1];
                    u32x4 w; w.x = cvt_pk_bf16(v0[0], v0[1]); w.y = cvt_pk_bf16(v0[2], v0[3]); w.z = cvt_pk_bf16(v1[0], v1[1]); w.w = cvt_pk_bf16(v1[2], v1[3]);
                    *(u32x4*)(rowp + bj * HALF) = w; } }
    }
};
struct EpiMerge {
    static constexpr bool PERM = true, AFTER_DRAIN = false;
    const bf16_t* G; int ldg; bf16_t* O; int accum; float bscale;
    __device__ __forceinline__ void operator()(const f32x4 (&acc)[2][2][4][2], const Unit& u, int wr, int wc, int fr, int fq) const {
        const int row0 = u.pm * BM + wr * 64 + fr, col0 = u.pn * BM + wc * 32 + 8 * fq;
#pragma unroll
        for (int ai = 0; ai < 2; ++ai)
#pragma unroll
            for (int m = 0; m < 4; ++m) { int rowi = row0 + ai * HALF + m * 16; asm volatile("" : "+v"(rowi)); const size_t row = (size_t)rowi;
#pragma unroll
                for (int bj = 0; bj < 2; ++bj) {
                    const u32x4 g = *(const u32x4*)(G + row * ldg + col0 + bj * HALF);
                    u32x4 p = (u32x4){0u, 0u, 0u, 0u}; if (accum) p = *(const u32x4*)(O + row * 1024 + col0 + bj * HALF);
                    float o[8];
#pragma unroll
                    for (int e = 0; e < 4; ++e) {
                        const float g0 = __uint_as_float(g[e] << 16), g1 = __uint_as_float(g[e] & 0xffff0000u);
                        const float p0 = __uint_as_float(p[e] << 16), p1 = __uint_as_float(p[e] & 0xffff0000u);
                        const float a0 = acc[ai][bj][m][e >> 1][(e & 1) * 2], a1 = acc[ai][bj][m][e >> 1][(e & 1) * 2 + 1];
                        o[2 * e] = p0 + sigm(g0) * a0 * bscale; o[2 * e + 1] = p1 + sigm(g1) * a1 * bscale; }
                    u32x4 w; w.x = cvt_pk_bf16(o[0], o[1]); w.y = cvt_pk_bf16(o[2], o[3]); w.z = cvt_pk_bf16(o[4], o[5]); w.w = cvt_pk_bf16(o[6], o[7]);
                    *(u32x4*)(O + row * 1024 + col0 + bj * HALF) = w; }
                asm volatile("" ::: "memory"); }
    }
};
struct EpiResid {
    static constexpr bool PERM = false, AFTER_DRAIN = false;
    const float* X; float* O;
    __device__ __forceinline__ void operator()(const f32x4 (&acc)[2][2][4][2], const Unit& u, int wr, int wc, int fr, int fq) const {
        const int row0 = u.pm * BM + wr * 64 + fr, col0 = u.pn * BM + wc * 32 + 4 * fq;
#pragma unroll
        for (int ai = 0; ai < 2; ++ai) { f32x4 xv[4][2][2];
#pragma unroll
            for (int m = 0; m < 4; ++m) { const size_t off = (size_t)(row0 + ai * HALF + m * 16) * 1024 + col0;
#pragma unroll
                for (int bj = 0; bj < 2; ++bj)
#pragma unroll
                    for (int n = 0; n < 2; ++n) xv[m][bj][n] = *(const f32x4*)(X + off + bj * HALF + n * 16); }
            __builtin_amdgcn_sched_barrier(0);
#pragma unroll
            for (int m = 0; m < 4; ++m) { const size_t off = (size_t)(row0 + ai * HALF + m * 16) * 1024 + col0;
#pragma unroll
                for (int bj = 0; bj < 2; ++bj)
#pragma unroll
                    for (int n = 0; n < 2; ++n) *(f32x4*)(O + off + bj * HALF + n * 16) = xv[m][bj][n] + acc[ai][bj][m][n]; }
            __builtin_amdgcn_sched_barrier(0); }
    }
};
template <class Epi, class Sched, bool ALIGN_EPI = false, bool SP2 = false>
__device__ __forceinline__ void gemm_phase(PG8_LAS unsigned char* lds, const Gemm g, const Sched& S, const Epi& E) {
    int tid_ = threadIdx.x; asm volatile("" : "+v"(tid_));
    const int tid = tid_, wid = __builtin_amdgcn_readfirstlane(tid >> 6), lane = tid & 63, wr = wid >> 2, wc = wid & 3, fr = lane & 15, fq = lane >> 4;
    const int K = g.K, nt = K / BK;
    unsigned voffA[2], voffB[2];
#pragma unroll
    for (int i = 0; i < 2; ++i) { int R, C; stage_rc(tid * 16 + i * 8192, R, C); const int Rb = Epi::PERM ? ((R & ~31) + perm32(R & 31)) : R;
        voffA[i] = (unsigned)(R * K + C) * 2u; voffB[i] = (unsigned)(Rb * K + C) * 2u; }
    const size_t kstep = (size_t)(BK * 2);
    const size_t hstep = (size_t)HALF * K * 2;
    const size_t tstep = 2 * hstep;
    const unsigned ldsw = (unsigned)wid * 1024u;
    const int aoff = lds_byte(wr * 64 + fr, fq * 8), boff = lds_byte(wc * 32 + fr, fq * 8);
#define PG8_SA(b, h) (((b) * 2 + (h)) * HTB)
#define PG8_SB(b, h) ((4 + (b) * 2 + (h)) * HTB)
#define PG8_STAGE(bufoff, gbase, voff) do { _Pragma("unroll") for (int _i = 0; _i < 2; ++_i) \
        __builtin_amdgcn_global_load_lds((const unsigned*)((const char*)(gbase) + (voff)[_i]), (PG8_LAS unsigned*)(lds + (bufoff) + ldsw + _i * 8192), 16, 0, 0); } while (0)
#define PG8_LDA(dst, b, h) do { _Pragma("unroll") for (int m = 0; m < 4; ++m) _Pragma("unroll") for (int k = 0; k < 2; ++k) dst[m][k] = *(const PG8_LAS bf16x8*)(lds + PG8_SA(b, h) + aoff + m * 2048 + k * 1024); } while (0)
#define PG8_LDB(dst, b, h) do { _Pragma("unroll") for (int n = 0; n < 2; ++n) _Pragma("unroll") for (int k = 0; k < 2; ++k) dst[n][k] = *(const PG8_LAS bf16x8*)(lds + PG8_SB(b, h) + boff + n * 2048 + k * 1024); } while (0)
#define PG8_MMA(ai, bj, At, Bt) do { __builtin_amdgcn_s_setprio(1); _Pragma("unroll") for (int m = 0; m < 4; ++m) _Pragma("unroll") for (int n = 0; n < 2; ++n) _Pragma("unroll") for (int k = 0; k < 2; ++k) \
        acc[ai][bj][m][n] = __builtin_amdgcn_mfma_f32_16x16x32_bf16(Bt[n][k], At[m][k], acc[ai][bj][m][n], 0, 0, 0); __builtin_amdgcn_s_setprio(0); } while (0)
#define PG8_WAIT_V(n) asm volatile("s_waitcnt vmcnt(" #n ")" ::: "memory")
#define PG8_WAIT_L(n) asm volatile("s_waitcnt lgkmcnt(" #n ")" ::: "memory")
#define PG8_BAR __builtin_amdgcn_s_barrier()
#define PG8_SCHED __builtin_amdgcn_sched_barrier(0)
    Unit cur, nxt; int ui = 0;
    if (!S.next(0, cur)) return;
    f32x4 acc[2][2][4][2];
#pragma unroll
    for (int a = 0; a < 2; ++a)
#pragma unroll
        for (int b = 0; b < 2; ++b)
#pragma unroll
            for (int m = 0; m < 4; ++m)
#pragma unroll
                for (int n = 0; n < 2; ++n) acc[a][b][m][n] = (f32x4){0.f, 0.f, 0.f, 0.f};
    bf16x8 At[4][2], B0[2][2], B1[2][2];
    const char* cA = (const char*)g.A + (size_t)cur.pm * tstep; const char* cB = (const char*)g.Bt + (size_t)cur.pn * tstep;
    S.a_ready(cur);
    if constexpr (SP2) {
        PG8_STAGE(PG8_SB(0, 0), cB, voffB); PG8_STAGE(PG8_SB(0, 1), cB + hstep, voffB); PG8_STAGE(PG8_SA(0, 0), cA, voffA); PG8_STAGE(PG8_SA(0, 1), cA + hstep, voffA);
        if (wr == 1) PG8_BAR;
        PG8_WAIT_V(2); PG8_BAR;
        PG8_STAGE(PG8_SB(1, 0), cB + kstep, voffB); PG8_STAGE(PG8_SA(1, 0), cA + kstep, voffA); PG8_STAGE(PG8_SB(1, 1), cB + hstep + kstep, voffB);
        PG8_WAIT_V(6); PG8_BAR;
    } else {
        PG8_STAGE(PG8_SB(0, 0), cB, voffB); PG8_STAGE(PG8_SA(0, 0), cA, voffA); PG8_STAGE(PG8_SB(0, 1), cB + hstep, voffB); PG8_STAGE(PG8_SA(0, 1), cA + hstep, voffA);
        if (wr == 1) PG8_BAR;
        PG8_WAIT_V(4); PG8_BAR;
        PG8_STAGE(PG8_SB(1, 0), cB + kstep, voffB); PG8_STAGE(PG8_SA(1, 0), cA + kstep, voffA); PG8_STAGE(PG8_SB(1, 1), cB + hstep + kstep, voffB);
        PG8_WAIT_V(6); PG8_BAR;
    }
    for (;;) {
        const bool has_next = S.next(ui + 1, nxt);
        const char* nA = has_next ? (const char*)g.A + (size_t)nxt.pm * tstep : cA; const char* nB = has_next ? (const char*)g.Bt + (size_t)nxt.pn * tstep : cB;
        for (int t = 0; t < nt; t += 2) {
            const bool last = (t == nt - 2);
            const char* a1 = cA + (size_t)(t + 1) * kstep;
            const char* a2 = last ? nA : cA + (size_t)(t + 2) * kstep; const char* b2 = last ? nB : cB + (size_t)(t + 2) * kstep;
            const char* a3 = a2 + kstep; const char* b3 = b2 + kstep;
            if (last && has_next) S.a_ready(nxt);
            if constexpr (SP2) {
            PG8_LDB(B0, 0, 0); PG8_LDB(B1, 0, 1); PG8_SCHED; PG8_LDA(At, 0, 0); PG8_STAGE(PG8_SA(1, 1), a1 + hstep, voffA);
            PG8_WAIT_V(8); PG8_WAIT_L(0); PG8_BAR; PG8_MMA(0, 0, At, B0); PG8_MMA(0, 1, At, B1); PG8_BAR; PG8_SCHED;
            PG8_LDA(At, 0, 1); PG8_STAGE(PG8_SB(0, 0), b2, voffB); PG8_STAGE(PG8_SB(0, 1), b2 + hstep, voffB); PG8_STAGE(PG8_SA(0, 0), a2, voffA);
            PG8_WAIT_V(8); PG8_WAIT_L(0); PG8_BAR; PG8_MMA(1, 0, At, B0); PG8_MMA(1, 1, At, B1); PG8_BAR; PG8_SCHED;
            PG8_LDB(B0, 1, 0); PG8_LDB(B1, 1, 1); PG8_SCHED; PG8_LDA(At, 1, 0); PG8_STAGE(PG8_SA(0, 1), a2 + hstep, voffA);
            PG8_WAIT_V(8); PG8_WAIT_L(0); PG8_BAR; PG8_MMA(0, 0, At, B0); PG8_MMA(0, 1, At, B1); PG8_BAR; PG8_SCHED;
            PG8_LDA(At, 1, 1); PG8_STAGE(PG8_SB(1, 0), b3, voffB); PG8_STAGE(PG8_SB(1, 1), b3 + hstep, voffB); PG8_STAGE(PG8_SA(1, 0), a3, voffA);
            PG8_WAIT_V(8); PG8_WAIT_L(0); PG8_BAR; PG8_MMA(1, 0, At, B0); PG8_MMA(1, 1, At, B1); PG8_BAR; PG8_SCHED;
            } else {
            PG8_LDB(B0, 0, 0); PG8_SCHED; PG8_LDA(At, 0, 0); PG8_STAGE(PG8_SA(1, 1), a1 + hstep, voffA);
            PG8_WAIT_L(8); PG8_BAR; PG8_WAIT_L(0); PG8_MMA(0, 0, At, B0); PG8_BAR; PG8_SCHED;
            PG8_LDB(B1, 0, 1); PG8_STAGE(PG8_SB(0, 0), b2, voffB);
            PG8_BAR; PG8_WAIT_L(0); PG8_MMA(0, 1, At, B1); PG8_BAR;
            PG8_LDA(At, 0, 1); PG8_STAGE(PG8_SA(0, 0), a2, voffA);
            PG8_BAR; PG8_WAIT_L(0); PG8_MMA(1, 0, At, B0); PG8_BAR; PG8_SCHED;
            PG8_STAGE(PG8_SB(0, 1), b2 + hstep, voffB);
            PG8_WAIT_V(6); PG8_BAR; PG8_MMA(1, 1, At, B1); PG8_BAR;
            PG8_LDB(B0, 1, 0); PG8_SCHED; PG8_LDA(At, 1, 0); PG8_STAGE(PG8_SA(0, 1), a2 + hstep, voffA);
            PG8_WAIT_L(8); PG8_BAR; PG8_WAIT_L(0); PG8_MMA(0, 0, At, B0); PG8_BAR; PG8_SCHED;
            PG8_LDB(B1, 1, 1); PG8_STAGE(PG8_SB(1, 0), b3, voffB);
            PG8_BAR; PG8_WAIT_L(0); PG8_MMA(0, 1, At, B1); PG8_BAR;
            PG8_LDA(At, 1, 1); PG8_STAGE(PG8_SA(1, 0), a3, voffA);
            PG8_BAR; PG8_WAIT_L(0); PG8_MMA(1, 0, At, B0); PG8_BAR; PG8_SCHED;
            PG8_STAGE(PG8_SB(1, 1), b3 + hstep, voffB);
            PG8_WAIT_V(6); PG8_BAR; PG8_MMA(1, 1, At, B1); PG8_BAR;
            }
        }
        if constexpr (ALIGN_EPI) { if (wr == 0) PG8_BAR; }
        if constexpr (!Epi::AFTER_DRAIN) { E(acc, cur, wr, wc, fr, fq); S.done(cur); }
        if (!has_next) break;
#pragma unroll
        for (int a = 0; a < 2; ++a)
#pragma unroll
            for (int b = 0; b < 2; ++b)
#pragma unroll
                for (int m = 0; m < 4; ++m)
#pragma unroll
                    for (int n = 0; n < 2; ++n) acc[a][b][m][n] = (f32x4){0.f, 0.f, 0.f, 0.f};
        cur = nxt; cA = nA; cB = nB; ++ui;
        if constexpr (ALIGN_EPI) { if (wr == 1) PG8_BAR; }
    }
    PG8_WAIT_V(0);
    if constexpr (!ALIGN_EPI) { if (wr == 0) PG8_BAR; }
    PG8_BAR;
    if constexpr (Epi::AFTER_DRAIN) { E.fused(acc, cur, wr, wc, fr, fq, lds, wid, lane); S.done(cur); }
#undef PG8_SA
#undef PG8_SB
#undef PG8_STAGE
#undef PG8_LDA
#undef PG8_LDB
#undef PG8_MMA
#undef PG8_WAIT_V
#undef PG8_WAIT_L
#undef PG8_BAR
#undef PG8_SCHED
}
}

#ifndef REP_PREP
#define REP_PREP 1
#endif
#ifndef REP_SCAN
#define REP_SCAN 1
#endif
#ifndef REP_NSA
#define REP_NSA 1
#endif
#ifndef REP_SWA
#define REP_SWA 1
#endif
#ifndef REP_PRO
#define REP_PRO 1
#endif
#ifndef REP_NORM2
#define REP_NORM2 1
#endif
#ifndef REP_WIN
#define REP_WIN 1
#endif
#ifndef REP_MERGE
#define REP_MERGE 1
#endif
#ifndef REP_PQ
#define REP_PQ 1
#endif
#ifndef REP_PEER
#define REP_PEER 1
#endif
#ifndef PROBE_DELAY_SCAN_US
#define PROBE_DELAY_SCAN_US 0
#endif
#ifndef PROBE_DELAY_ATTN_US
#define PROBE_DELAY_ATTN_US 0
#endif
#define DBG_ZERO 0
constexpr int NWAVES = 8, NT = 512;
constexpr int BATCH = 2, SEQ = 8192, D = 1024, M = BATCH * SEQ, LAYERS = 2;
constexpr int NP = 7168;
constexpr int C_R = 0, C_K = 512, C_V = 1024, C_W = 1536, C_A = 1600, C_G = 1664;
constexpr int C_NQ = 1792, C_NKC = 2304, C_NVC = 2432, C_NKS = 2560, C_NVS = 2688, C_NKW = 2816, C_NVW = 2944, C_NG = 3072;
constexpr int PAD_A = 3096, PAD_B = 3328;
constexpr int C_SQ = 3328, C_SK = 3840, C_SV = 3968, C_GA = 4096;
constexpr float PU_SCALE = 64.f, PV_SCALE = 11.f;
constexpr float LOG2E = 1.4426950408889634f;
constexpr float NEG_INF = -__builtin_huge_valf();

constexpr size_t MiB = 1u << 20, KiB = 1u << 10;
constexpr size_t WS_CTL = 0, CTL_ZERO_BYTES = 1 * MiB;
constexpr size_t WS_WIN = 1 * MiB;
constexpr size_t WS_WBR = 29 * MiB;
constexpr size_t WS_WOUT = 35 * MiB;
constexpr size_t WS_WQ = 39 * MiB;
constexpr size_t WS_SK = 47 * MiB;
constexpr size_t WS_CW1 = 48 * MiB;
constexpr size_t WS_CW2 = 52 * MiB;
constexpr size_t WS_RW = 52 * MiB + 256 * KiB;
constexpr size_t WS_PROJ = 54 * MiB;
constexpr size_t WS_XN = 278 * MiB;
constexpr size_t WS_OA = 310 * MiB, WS_OB = 326 * MiB, WS_OC = 342 * MiB;
constexpr size_t WS_REC = 358 * MiB;
constexpr size_t WS_G = 472 * MiB;
constexpr size_t WS_BON = 470 * MiB;
constexpr size_t WS_KCMP = 471 * MiB, WS_VCMP = 471 * MiB + 256 * KiB;
constexpr size_t WS_PU = 358 * MiB, WS_PV = 374 * MiB;
constexpr size_t WS_PQ = WS_PROJ;
constexpr size_t WS_SLIST = WS_PROJ + 64 * MiB;
constexpr size_t WS_KV0 = 454 * MiB, WS_KV1 = 490 * MiB;
constexpr unsigned KV_TILE_MASK = (1u << 9) | (1u << 10) | (1u << 11) | (1u << 15);
constexpr size_t WS_END = 506 * MiB;
constexpr int CW_BAR = 4096;

constexpr int LDS_BYTES = 155648;
constexpr int MISC_OFF = LDS_BYTES - 256;

DI float bflo(unsigned u) { return __uint_as_float(u << 16); }
DI float bfhi(unsigned u) { return __uint_as_float(u & 0xffff0000u); }
DI void spin_us(int us) { const unsigned long long t0_ = wall_clock64(); while (wall_clock64() - t0_ < (unsigned long long)us * 100ull) __builtin_amdgcn_s_sleep(8); }
DI unsigned pk(float a, float b) { f32x2 v = {a, b}; return __builtin_bit_cast(unsigned, __builtin_convertvector(v, bfx2)); }
DI float sigm(float x) { return __builtin_amdgcn_rcpf(1.0f + __expf(-x)); }
DI float gelu_erf(float x) { return 0.5f * x * (1.0f + erff(x * 0.70710678118654752f)); }
DI float dpp_f(float v, const int ctrl_unused) { return v; }
#define DPPQ(v, ctrl) __builtin_bit_cast(float, __builtin_amdgcn_update_dpp(0, __builtin_bit_cast(int, (v)), (ctrl), 0xF, 0xF, true))
#define DPP_ADD(v, ctrl) ((v) + __builtin_bit_cast(float, __builtin_amdgcn_update_dpp(0, __builtin_bit_cast(int, (v)), (ctrl), 0xF, 0xF, true)))
DI float row16_sum(float v) {
    v = DPP_ADD(v, 0xB1); v = DPP_ADD(v, 0x4E); v = DPP_ADD(v, 0x141); v = DPP_ADD(v, 0x140); return v; }
DI float oct_sum(float v) {
    v = DPP_ADD(v, 0xB1); v = DPP_ADD(v, 0x4E); v = DPP_ADD(v, 0x141); return v; }
DI float wave_sum(float v) {
    v = row16_sum(v);
    const float a = __builtin_bit_cast(float, __builtin_amdgcn_readlane(__builtin_bit_cast(int, v), 0));
    const float b = __builtin_bit_cast(float, __builtin_amdgcn_readlane(__builtin_bit_cast(int, v), 16));
    const float c = __builtin_bit_cast(float, __builtin_amdgcn_readlane(__builtin_bit_cast(int, v), 32));
    const float d = __builtin_bit_cast(float, __builtin_amdgcn_readlane(__builtin_bit_cast(int, v), 48));
    return (a + b) + (c + d); }
DI bf16x8 pack8(const float (&z)[8]) { v4u p; p.x = pk(z[0], z[1]); p.y = pk(z[2], z[3]); p.z = pk(z[4], z[5]); p.w = pk(z[6], z[7]); return __builtin_bit_cast(bf16x8, p); }
DI void unpack8(v4u u, float (&z)[8]) {
#pragma unroll
    for (int e = 0; e < 4; ++e) { z[2 * e] = bflo(u[e]); z[2 * e + 1] = bfhi(u[e]); } }
#define MFMA16(a, b, c) __builtin_amdgcn_mfma_f32_16x16x32_bf16((a), (b), (c), 0, 0, 0)
#define MFMA32(a, b, c) __builtin_amdgcn_mfma_f32_32x32x16_bf16((a), (b), (c), 0, 0, 0)
DI int crow(int reg, int hh) { return (reg & 3) + 8 * (reg >> 2) + 4 * hh; }

struct Args { const float* in[32]; float* out; unsigned char* ws; int ph_lo, ph_hi; };
enum { I_X = 0, I_LN1, I_LN2, I_LNF, I_REL, I_WIN, I_MU, I_W0, I_W2, I_A0, I_A2, I_G2, I_KK, I_KA, I_RK, I_LNW, I_LNB, I_PEK, I_PEV, I_CKW1, I_CKW2, I_CVW1, I_CVW2,
       I_SINK, I_WBA, I_WBB, I_WBC, I_WOUT, I_PWQ, I_PSK, I_PU, I_PV };
__device__ const unsigned char T5_BK[128] = {0, 1, 2, 3, 4, 5, 6, 7, 8, 9, 10, 11, 12, 13, 14, 15, 16, 16, 16, 17, 17, 18, 18, 18, 19, 19, 19, 20, 20, 20, 20, 21, 21, 21, 21, 22, 22, 22, 22, 22, 23, 23, 23, 23, 23, 23, 24, 24, 24, 24, 24, 24, 25, 25, 25, 25, 25, 25, 25, 26, 26, 26, 26, 26, 26, 26, 26, 27, 27, 27, 27, 27, 27, 27, 27, 27, 27, 28, 28, 28, 28, 28, 28, 28, 28, 28, 28, 29, 29, 29, 29, 29, 29, 29, 29, 29, 29, 29, 29, 30, 30, 30, 30, 30, 30, 30, 30, 30, 30, 30, 30, 30, 30, 31, 31, 31, 31, 31, 31, 31, 31, 31, 31, 31, 31, 31, 31, 31};

#define XB_TMO      128
#define XB_XCNT(j)  (256  + 64 * (j))
#define XB_XSUB(j)  (1280 + 64 * (j))
#define XB_XGEN(j)  (2304 + 64 * (j))
#define XB_TOP      3328
#define XB_TOPGEN   3392
#define XCD_BAR_WORDS 3456
#define XB_SPIN_CAP (1u << 18)

__device__ __forceinline__ unsigned xb_ld(unsigned* p)              { return __hip_atomic_load(p, __ATOMIC_RELAXED, __HIP_MEMORY_SCOPE_AGENT); }
__device__ __forceinline__ unsigned xb_add(unsigned* p, unsigned v) { return __hip_atomic_fetch_add(p, v, __ATOMIC_RELAXED, __HIP_MEMORY_SCOPE_AGENT); }
__device__ __forceinline__ unsigned xb_xcc_id() { return (unsigned)__builtin_amdgcn_s_getreg((3 << 11) | 20) & 0xFu; }
#define XB_SPIN(cond, bar) do { unsigned _sp = 0; while (cond) { __builtin_amdgcn_s_sleep(1); \
    if ((++_sp & 255u) == 0u) { if (xb_ld(&(bar)[XB_TMO])) break; if (_sp > XB_SPIN_CAP) { atomicAdd(&(bar)[XB_TMO], 1u); break; } } } } while (0)

struct XcdBarrier {
    unsigned* bar; unsigned x;
    volatile LAS unsigned* st;
};

__device__ __forceinline__ XcdBarrier xcd_barrier_post(unsigned* bar, volatile LAS unsigned* st) {
    XcdBarrier b; b.bar = bar; b.x = xb_xcc_id(); b.st = st;
    if (threadIdx.x == 0) (void)xb_add(&bar[XB_XCNT(b.x)], 1u);
    return b;
}
__device__ __forceinline__ void xcd_barrier_complete(unsigned* bar, unsigned x, unsigned& nloc, unsigned& nx) {
    const unsigned G = gridDim.x * gridDim.y * gridDim.z;
    unsigned sum, cnt, mine, sp = 0u;
    for (;;) {
        sum = 0u; cnt = 0u; mine = 0u;
#pragma unroll
        for (unsigned j = 0; j < 16; ++j) { const unsigned c = xb_ld(&bar[XB_XCNT(j)]); sum += c; cnt += (c > 0u) ? 1u : 0u; mine = (j == x) ? c : mine; }
        if (sum == G) break;
        __builtin_amdgcn_s_sleep(1);
        if ((++sp & 255u) == 0u) { if (xb_ld(&bar[XB_TMO])) break; if (sp > XB_SPIN_CAP) { atomicAdd(&bar[XB_TMO], 1u); break; } }
    }
    nloc = mine > 0u ? mine : 1u; nx = cnt > 0u ? cnt : 1u;
}

__device__ __forceinline__ void xcd_barrier(const XcdBarrier& b) {
    asm volatile("s_waitcnt vmcnt(0)" ::: "memory");
    __syncthreads();
    if (threadIdx.x == 0) {
        unsigned* bar = b.bar;
        __builtin_amdgcn_s_waitcnt(0);
        unsigned nloc = b.st[0], nx = b.st[1];
        if (nloc == 0u) { xcd_barrier_complete(bar, b.x, nloc, nx); b.st[0] = nloc; b.st[1] = nx; }
        const unsigned old = xb_add(&bar[XB_XSUB(b.x)], 1u);
        const unsigned gen = old / nloc;
        if (old + 1u == (gen + 1u) * nloc) {
            __builtin_amdgcn_fence(__ATOMIC_RELEASE, "agent");
            asm volatile("s_waitcnt vmcnt(0)" ::: "memory");
            const unsigned og = xb_add(&bar[XB_TOP], 1u);
            const unsigned tg = og / nx;
            if (og + 1u == (tg + 1u) * nx) xb_add(&bar[XB_TOPGEN], 1u);
            else XB_SPIN(xb_ld(&bar[XB_TOPGEN]) == tg, bar);
            __builtin_amdgcn_fence(__ATOMIC_ACQUIRE, "agent");
            xb_add(&bar[XB_XGEN(b.x)], 1u);
            asm volatile("s_waitcnt vmcnt(0)" ::: "memory");
        } else {
            XB_SPIN(xb_ld(&bar[XB_XGEN(b.x)]) == gen, bar);
            __builtin_amdgcn_fence(__ATOMIC_ACQUIRE, "agent");
            asm volatile("s_waitcnt vmcnt(0)" ::: "memory");
        }
    }
    __syncthreads();
}

DI void tr_item(const float* W, int K, int Nsrc, bf16* WT, int pa, int pb, LAS float* scr, int item, int nblk, int lane) {
    const int kb = item / nblk, nb = item % nblk, k0 = 64 * kb, n0 = 64 * nb;
    const int nq = lane & 15, r = n0 + 4 * nq;
    const int sc = r < pa ? r : (r < pb ? -1 : r - (pb - pa));
    const float* wp = W + (size_t)(k0 + (lane >> 4)) * Nsrc + (sc >= 0 ? sc : 0);
    f32x4 v[16];
#pragma unroll
    for (int i = 0; i < 16; ++i) v[i] = *(const f32x4*)(wp + (size_t)(4 * i) * Nsrc);
    __builtin_amdgcn_sched_barrier(0);
#pragma unroll
    for (int i = 0; i < 16; ++i) { if (sc < 0) v[i] = (f32x4){0.f, 0.f, 0.f, 0.f}; *(LAS f32x4*)(scr + (4 * i + (lane >> 4)) * 68 + 4 * nq) = v[i]; }
    asm volatile("s_waitcnt lgkmcnt(0)" ::: "memory");
    const int c = lane & 7;
#pragma unroll
    for (int j = 0; j < 8; ++j) { const int n = (lane >> 3) + 8 * j; const LAS float* s = scr + (8 * c) * 68 + n;
        v4u o; o.x = pk(s[0 * 68], s[1 * 68]); o.y = pk(s[2 * 68], s[3 * 68]); o.z = pk(s[4 * 68], s[5 * 68]); o.w = pk(s[6 * 68], s[7 * 68]);
        *(v4u*)(WT + (size_t)(n0 + n) * K + k0 + 8 * c) = o; }
    asm volatile("s_waitcnt lgkmcnt(0)" ::: "memory");
}
#define TR_MAT(W, K, Nsrc, Ndst, WT, pa, pb) do { const int nblk_ = (Ndst) / 64, nit_ = ((K) / 64) * nblk_; int st_ = gw - base_; if (st_ < 0) st_ += NGW; \
    for (int it_ = st_; it_ < nit_; it_ += NGW) tr_item((W), (K), (Nsrc), (WT), (pa), (pb), scr, it_, nblk_, lane); base_ = (base_ + nit_) % NGW; } while (0)
DI void cvt_copy(const float* src, bf16* dst, size_t n, size_t gtid, size_t gthreads) {
    for (size_t i = gtid * 8; i < n; i += gthreads * 8) {
        const f32x4 a = *(const f32x4*)(src + i), b = *(const f32x4*)(src + i + 4);
        v4u o; o.x = pk(a[0], a[1]); o.y = pk(a[2], a[3]); o.z = pk(b[0], b[1]); o.w = pk(b[2], b[3]);
        *(v4u*)(dst + i) = o; }
}
DI void p_prologue(const Args& a, LAS unsigned char* lds, int tid) {
    const int lane = tid & 63, wave = tid >> 6, gw = blockIdx.x * NWAVES + wave, NGW = gridDim.x * NWAVES;
    LAS float* scr = (LAS float*)(lds + wave * 17408);
    unsigned char* ws = a.ws;
    int base_ = 0;
    for (int l = 0; l < LAYERS; ++l) {
        TR_MAT(a.in[I_WIN] + (size_t)l * 1024 * 6936, 1024, 6936, NP, (bf16*)(ws + WS_WIN) + (size_t)l * NP * 1024, PAD_A, PAD_B);
        TR_MAT(a.in[I_WBA] + (size_t)l * 512 * 1024, 512, 1024, 1024, (bf16*)(ws + WS_WBR) + (size_t)(l * 3 + 0) * 1024 * 512, 1 << 30, 1 << 30);
        TR_MAT(a.in[I_WBB] + (size_t)l * 512 * 1024, 512, 1024, 1024, (bf16*)(ws + WS_WBR) + (size_t)(l * 3 + 1) * 1024 * 512, 1 << 30, 1 << 30);
        TR_MAT(a.in[I_WBC] + (size_t)l * 512 * 1024, 512, 1024, 1024, (bf16*)(ws + WS_WBR) + (size_t)(l * 3 + 2) * 1024 * 512, 1 << 30, 1 << 30);
        TR_MAT(a.in[I_WOUT] + (size_t)l * 1024 * 1024, 1024, 1024, 1024, (bf16*)(ws + WS_WOUT) + (size_t)l * 1024 * 1024, 1 << 30, 1 << 30);
        TR_MAT(a.in[I_PWQ] + (size_t)l * 1024 * 2048, 1024, 2048, 2048, (bf16*)(ws + WS_WQ) + (size_t)l * 2048 * 1024, 1 << 30, 1 << 30);
        TR_MAT(a.in[I_CKW1] + (size_t)l * 2048 * 256, 2048, 256, 256, (bf16*)(ws + WS_CW1) + (size_t)(l * 2 + 0) * 256 * 2048, 1 << 30, 1 << 30);
        TR_MAT(a.in[I_CVW1] + (size_t)l * 2048 * 256, 2048, 256, 256, (bf16*)(ws + WS_CW1) + (size_t)(l * 2 + 1) * 256 * 2048, 1 << 30, 1 << 30);
        TR_MAT(a.in[I_CKW2] + (size_t)l * 256 * 64, 256, 64, 64, (bf16*)(ws + WS_CW2) + (size_t)(l * 2 + 0) * 64 * 256, 1 << 30, 1 << 30);
        TR_MAT(a.in[I_CVW2] + (size_t)l * 256 * 64, 256, 64, 64, (bf16*)(ws + WS_CW2) + (size_t)(l * 2 + 1) * 64 * 256, 1 << 30, 1 << 30);
        bf16* rw = (bf16*)(ws + WS_RW) + (size_t)l * 131072;
        TR_MAT(a.in[I_W2] + (size_t)l * 64 * 512, 64, 512, 512, rw, 1 << 30, 1 << 30);
        TR_MAT(a.in[I_A2] + (size_t)l * 64 * 512, 64, 512, 512, rw + 512 * 64, 1 << 30, 1 << 30);
        TR_MAT(a.in[I_G2] + (size_t)l * 128 * 512, 128, 512, 512, rw + 2 * 512 * 64, 1 << 30, 1 << 30);
    }
    cvt_copy(a.in[I_PSK], (bf16*)(ws + WS_SK), (size_t)LAYERS * 16 * 128 * 128, (size_t)blockIdx.x * NT + tid, (size_t)gridDim.x * NT);
}

DI void rms_row_bf16(const float* xrow, const float* w, bf16* orow, int lane) {
    const f32x4* xr = (const f32x4*)xrow + lane;
    f32x4 v[4]; float s = 0.f;
#pragma unroll
    for (int j = 0; j < 4; ++j) v[j] = xr[64 * j];
    __builtin_amdgcn_sched_barrier(0);
#pragma unroll
    for (int j = 0; j < 4; ++j) s += (v[j].x * v[j].x + v[j].y * v[j].y) + (v[j].z * v[j].z + v[j].w * v[j].w);
    const float rs = rsqrtf(wave_sum(s) * (1.f / D) + 1e-6f);
    f32x4 wv[4];
#pragma unroll
    for (int j = 0; j < 4; ++j) wv[j] = ((const f32x4*)w)[lane + 64 * j];
    __builtin_amdgcn_sched_barrier(0);
#pragma unroll
    for (int j = 0; j < 4; ++j) { const f32x4 o = v[j] * rs * wv[j];
        v2u p; p.x = pk(o.x, o.y); p.y = pk(o.z, o.w); ((v2u*)orow)[lane + 64 * j] = p; }
}
DI void p_rms(const float* x, const float* w, bf16* out, int tid) {
    const int lane = tid & 63, gw = blockIdx.x * NWAVES + (tid >> 6), NGW = gridDim.x * NWAVES;
    for (int m = gw; m < M; m += NGW) rms_row_bf16(x + (size_t)m * D, w, out + (size_t)m * D, lane);
}

DI void load_shift8(const bf16* cur, const bf16* prv, bool hp, const float* mu, float (&z)[8]) {
    const v4u c = *(const v4u*)cur; v4u p = *(const v4u*)(hp ? prv : cur);
    const f32x4 m0 = *(const f32x4*)mu, m1 = *(const f32x4*)(mu + 4);
    if (!hp) p = (v4u){0u, 0u, 0u, 0u};
    float cf[8], pf[8]; unpack8(c, cf); unpack8(p, pf);
#pragma unroll
    for (int e = 0; e < 8; ++e) { const float mm = e < 4 ? m0[e & 3] : m1[e & 3]; z[e] = cf[e] + mm * (pf[e] - cf[e]); }
}
struct Sh4 { v2u c, p; f32x4 m; };
DI void ls4_ld(const bf16* cur, const bf16* prv, bool hp, const float* mu, Sh4& s) { s.c = *(const v2u*)cur; s.p = *(const v2u*)(hp ? prv : cur); s.m = *(const f32x4*)mu; }
DI void ls4_mix(const Sh4& s, bool hp, float (&z)[4]) {
    v2u p = s.p; if (!hp) p = (v2u){0u, 0u};
    const float c0 = bflo(s.c.x), c1 = bfhi(s.c.x), c2 = bflo(s.c.y), c3 = bfhi(s.c.y), p0 = bflo(p.x), p1 = bfhi(p.x), p2 = bflo(p.y), p3 = bfhi(p.y);
    z[0] = c0 + s.m[0] * (p0 - c0); z[1] = c1 + s.m[1] * (p1 - c1); z[2] = c2 + s.m[2] * (p2 - c2); z[3] = c3 + s.m[3] * (p3 - c3);
}
DI void load_shift4(const bf16* cur, const bf16* prv, bool hp, const float* mu, float (&z)[4]) { Sh4 s; ls4_ld(cur, prv, hp, mu, s); ls4_mix(s, hp, z); }
DI void rwkv_prep_item(const Args& a, int l, int item, int lane_in, LAS unsigned char* bfr, LAS float* ms) {
    int lane = lane_in; asm volatile("" : "+v"(lane));
    const int r16_ = lane & 15, q4_ = lane >> 4, m = (item >> 2) * 16 + r16_, tm = r16_ & 3, h_lo = (item & 3) * 2;
    const bool hp = (m & (SEQ - 1)) != 0;
    const bf16* prow = (const bf16*)(a.ws + WS_PROJ) + (size_t)m * NP; const bf16* pprev = prow - NP;
    const float* mu = a.in[I_MU] + l * 1792;
    { int q4 = q4_; asm volatile("" : "+v"(q4));
#pragma unroll
    for (int ks = 0; ks < 2; ++ks) { float z[8]; const int c = ks * 32 + q4 * 8;
        load_shift8(prow + C_W + c, pprev + C_W + c, hp, mu + C_W + c, z);
#pragma unroll
        for (int e = 0; e < 8; ++e) z[e] = tanhf(z[e]);
        *(LAS bf16x8*)(bfr + ks * 8192) = pack8(z); asm volatile("" : "+v"(q4) :: "memory");
        load_shift8(prow + C_A + c, pprev + C_A + c, hp, mu + C_A + c, z); *(LAS bf16x8*)(bfr + (2 + ks) * 8192) = pack8(z); asm volatile("" : "+v"(q4) :: "memory"); }
#pragma unroll
    for (int ks = 0; ks < 4; ++ks) { float z[8]; const int c = ks * 32 + q4 * 8;
        load_shift8(prow + C_G + c, pprev + C_G + c, hp, mu + C_G + c, z);
#pragma unroll
        for (int e = 0; e < 8; ++e) z[e] = sigm(z[e]);
        *(LAS bf16x8*)(bfr + (4 + ks) * 8192) = pack8(z); asm volatile("" : "+v"(q4) :: "memory"); }
    }
    const bf16* W2T = (const bf16*)(a.ws + WS_RW) + (size_t)l * 131072; const bf16* A2T = W2T + 512 * 64; const bf16* G2T = A2T + 512 * 64;
    float* BON = (float*)(a.ws + WS_BON);
#pragma unroll 1
    for (int h_ = h_lo; h_ < h_lo + 2; ++h_) {
        int h = h_, q4 = q4_, r16 = r16_, mv = m; asm volatile("" : "+v"(h), "+v"(q4), "+v"(r16), "+v"(mv));
        const bf16* prow = (const bf16*)(a.ws + WS_PROJ) + (size_t)mv * NP; const bf16* pprev = prow - NP;
        bf16* GB = (bf16*)(a.ws + WS_G);
        float ss = 0.f, bon = 0.f;
        { Sh4 sk[4]; f32x4 kkq[4];
#pragma unroll
          for (int mt = 0; mt < 4; ++mt) { const int ch = h * 64 + mt * 16 + q4 * 4; ls4_ld(prow + C_K + ch, pprev + C_K + ch, hp, mu + C_K + ch, sk[mt]); kkq[mt] = *(const f32x4*)(a.in[I_KK] + l * 512 + ch); }
          __builtin_amdgcn_sched_barrier(0);
#pragma unroll
          for (int mt = 0; mt < 4; ++mt) { float zk1[4]; ls4_mix(sk[mt], hp, zk1);
#pragma unroll
            for (int j = 0; j < 4; ++j) { const float kr = zk1[j] * kkq[mt][j]; ss += kr * kr; } } }
        asm volatile("" : "+v"(h), "+v"(q4), "+v"(r16) :: "memory");
        ss += __shfl_xor(ss, 16); ss += __shfl_xor(ss, 32);
        const float inv = rsqrtf(fmaxf(ss, 1e-12f));
        v4u FQ[2], FR[2], FA[2], FK[2]; float qall[4][4], rall[4][4];
        unsigned char* recb = a.ws + WS_REC + ((size_t)((mv >> 13) * 8 + h) * 2048 + ((mv & (SEQ - 1)) >> 2)) * 3072;
#pragma unroll
        for (int mt = 0; mt < 4; ++mt) {
            f32x4 ag = (f32x4){0.f, 0.f, 0.f, 0.f}; const int row = h * 64 + mt * 16 + r16, ch = h * 64 + mt * 16 + q4 * 4;
            bf16x8 gf[4];
#pragma unroll
            for (int ks = 0; ks < 4; ++ks) gf[ks] = *(const bf16x8*)(G2T + row * 128 + ks * 32 + q4 * 8);
            __builtin_amdgcn_sched_barrier(0);
#pragma unroll
            for (int ks = 0; ks < 4; ++ks) ag = MFMA16(gf[ks], *(const LAS bf16x8*)(bfr + (4 + ks) * 8192), ag);
            v2u gv; gv.x = pk(ag[0], ag[1]); gv.y = pk(ag[2], ag[3]); *(v2u*)(GB + (size_t)mv * 512 + ch) = gv;
            asm volatile("" : "+v"(h), "+v"(q4), "+v"(r16) :: "memory");
        }
#pragma unroll
        for (int mt = 0; mt < 4; ++mt) {
            f32x4 aw = (f32x4){0.f, 0.f, 0.f, 0.f}, aa = aw;
            const int row = h * 64 + mt * 16 + r16;
            const int ch = h * 64 + mt * 16 + q4 * 4; float zr[4], zv[4], zkm[4];
            bf16x8 wf[2], af2[2]; Sh4 sK, sR, sV;
#pragma unroll
            for (int ks = 0; ks < 2; ++ks) { wf[ks] = *(const bf16x8*)(W2T + row * 64 + ks * 32 + q4 * 8); af2[ks] = *(const bf16x8*)(A2T + row * 64 + ks * 32 + q4 * 8); }
            ls4_ld(prow + C_K + ch, pprev + C_K + ch, hp, mu + C_K + ch, sK); ls4_ld(prow + C_R + ch, pprev + C_R + ch, hp, mu + C_R + ch, sR); ls4_ld(prow + C_V + ch, pprev + C_V + ch, hp, mu + C_V + ch, sV);
            const f32x4 w0 = *(const f32x4*)(a.in[I_W0] + l * 512 + ch), a0 = *(const f32x4*)(a.in[I_A0] + l * 512 + ch), k_k = *(const f32x4*)(a.in[I_KK] + l * 512 + ch),
                        k_a = *(const f32x4*)(a.in[I_KA] + l * 512 + ch), r_k = *(const f32x4*)(a.in[I_RK] + l * 512 + ch);
            __builtin_amdgcn_sched_barrier(0);
#pragma unroll
            for (int ks = 0; ks < 2; ++ks) { aw = MFMA16(wf[ks], *(const LAS bf16x8*)(bfr + ks * 8192), aw); aa = MFMA16(af2[ks], *(const LAS bf16x8*)(bfr + (2 + ks) * 8192), aa); }
            ls4_mix(sK, hp, zkm); ls4_mix(sR, hp, zr); ls4_mix(sV, hp, zv);
            float qv[4], rv[4], kav[4], kkv[4], ahv[4], khv[4], w4a[4];
#pragma unroll
            for (int j = 0; j < 4; ++j) {
                const float y = -(w0[j] + aw[j]);
                const float sp = fmaxf(y, 0.f) + __logf(1.0f + __expf(-fabsf(y)));
                const float dec = __expf(-__expf(-sp - 0.5f));
                const float av_ = sigm(a0[j] + aa[j]);
                const float kk = zkm[j] * k_k[j] * inv;
                const float kpr = zkm[j] * (1.0f + (av_ - 1.0f) * k_a[j]);
                bon += zr[j] * kpr * r_k[j];
                float winc = dec;
                { const float t1 = DPPQ(winc, 0x90); winc *= (tm >= 1) ? t1 : 1.0f; const float t2 = DPPQ(winc, 0x44); winc *= (tm >= 2) ? t2 : 1.0f; }
                const float wsh = DPPQ(winc, 0x90), wexc = (tm == 0) ? 1.0f : wsh, w4 = DPPQ(winc, 0xFF), rw = __builtin_amdgcn_rcpf(winc);
                const float ah = kk * av_ * rw, kh = kpr * rw;
                qv[j] = wexc * kk; rv[j] = winc * zr[j]; kav[j] = ah * w4; kkv[j] = kh * w4; w4a[j] = w4;
                *(bf16*)(recb + 2560 + (size_t)(mt * 16 + q4 * 4 + j) * 8 + tm * 2) = (bf16)(pk(zv[j], 0.f) & 0xffffu);
                ahv[j] = ah; khv[j] = kh; qall[mt][j] = qv[j]; rall[mt][j] = rv[j];
            }
            { float ka4[4] = {0.f, 0.f, 0.f, 0.f}, kk4[4] = {0.f, 0.f, 0.f, 0.f};
#pragma unroll
              for (int jj = 0; jj < 4; ++jj) { const float a0_ = DPPQ(kav[jj], 0x00), a1_ = DPPQ(kav[jj], 0x55), a2_ = DPPQ(kav[jj], 0xAA), a3_ = DPPQ(kav[jj], 0xFF);
                  const float k0_ = DPPQ(kkv[jj], 0x00), k1_ = DPPQ(kkv[jj], 0x55), k2_ = DPPQ(kkv[jj], 0xAA), k3_ = DPPQ(kkv[jj], 0xFF); const bool mine = tm == jj;
                  ka4[0] = mine ? a0_ : ka4[0]; ka4[1] = mine ? a1_ : ka4[1]; ka4[2] = mine ? a2_ : ka4[2]; ka4[3] = mine ? a3_ : ka4[3];
                  kk4[0] = mine ? k0_ : kk4[0]; kk4[1] = mine ? k1_ : kk4[1]; kk4[2] = mine ? k2_ : kk4[2]; kk4[3] = mine ? k3_ : kk4[3]; }
              *(v4u*)(recb + 1024 + (size_t)(mt * 16 + q4 * 4 + tm) * 16) = (v4u){pk(ka4[0], ka4[1]), pk(ka4[2], ka4[3]), pk(kk4[0], kk4[1]), pk(kk4[2], kk4[3])};
              if (tm == 0) *(f32x4*)(recb + 2048 + (size_t)(mt * 16 + q4 * 4) * 4) = (f32x4){w4a[0], w4a[1], w4a[2], w4a[3]}; }
            FQ[mt >> 1][(mt & 1) * 2] = pk(qv[0], qv[1]); FQ[mt >> 1][(mt & 1) * 2 + 1] = pk(qv[2], qv[3]); FR[mt >> 1][(mt & 1) * 2] = pk(rv[0], rv[1]); FR[mt >> 1][(mt & 1) * 2 + 1] = pk(rv[2], rv[3]);
            FA[mt >> 1][(mt & 1) * 2] = pk(ahv[0], ahv[1]); FA[mt >> 1][(mt & 1) * 2 + 1] = pk(ahv[2], ahv[3]); FK[mt >> 1][(mt & 1) * 2] = pk(khv[0], khv[1]); FK[mt >> 1][(mt & 1) * 2 + 1] = pk(khv[2], khv[3]);
            asm volatile("" : "+v"(h), "+v"(q4), "+v"(r16) :: "memory");
        }
        bon += __shfl_xor(bon, 16); bon += __shfl_xor(bon, 32);
        if (q4_ == 0) BON[m * 8 + h_] = bon;
        {
            f32x4 dE = (f32x4){0.f, 0.f, 0.f, 0.f}, dF = dE, dG = dE, dH = dE;
#pragma unroll
            for (int ks = 0; ks < 2; ++ks) { const bf16x8 fq = __builtin_bit_cast(bf16x8, FQ[ks]), fr = __builtin_bit_cast(bf16x8, FR[ks]), fa = __builtin_bit_cast(bf16x8, FA[ks]), fk = __builtin_bit_cast(bf16x8, FK[ks]);
                dE = MFMA16(fq, fa, dE); dF = MFMA16(fq, fk, dF); dG = MFMA16(fr, fa, dG); dH = MFMA16(fr, fk, dH); }
            if (q4_ == (r16_ >> 2)) {
#pragma unroll
                for (int jj = 0; jj < 4; ++jj) { LAS float* cp = ms + ((q4_ * 4 + 0) * 4 + jj) * 4 + tm;
                    cp[0] = tm < jj ? dE[jj] : 0.f; cp[16] = tm < jj ? dF[jj] : 0.f; cp[32] = tm <= jj ? dG[jj] : 0.f; cp[48] = tm <= jj ? dH[jj] : 0.f; } }
            asm volatile("s_waitcnt lgkmcnt(0)" ::: "memory");
            const LAS f32x4* mp = (const LAS f32x4*)(ms + (r16_ >> 2) * 64);
            const f32x4 E1 = mp[1], E2 = mp[2], E3 = mp[3], F1 = mp[5], F2 = mp[6], F3 = mp[7], Grow = mp[8 + tm], Hrow = mp[12 + tm];
            asm volatile("s_waitcnt lgkmcnt(0)" ::: "memory");
            const float t10 = -E1[0], t21 = -E2[1], t32 = -E3[2], t20 = -E2[0] + E2[1] * E1[0], t31 = -E3[1] + E3[2] * E2[1], t30 = -E3[0] + E3[1] * E1[0] + E3[2] * E2[0] - E3[2] * E2[1] * E1[0];
            const float m10 = -F1[0], m20 = -(t21 * F1[0] + F2[0]), m21 = -F2[1], m30 = -(t31 * F1[0] + t32 * F2[0] + F3[0]), m31 = -(t32 * F2[1] + F3[1]), m32 = -F3[2];
            const float T0 = tm == 0 ? 1.f : (tm == 1 ? t10 : (tm == 2 ? t20 : t30)), T1 = tm == 0 ? 0.f : (tm == 1 ? 1.f : (tm == 2 ? t21 : t31)), T2 = tm < 2 ? 0.f : (tm == 2 ? 1.f : t32), T3 = tm == 3 ? 1.f : 0.f;
            const float M0 = tm == 0 ? 0.f : (tm == 1 ? m10 : (tm == 2 ? m20 : m30)), M1 = tm < 2 ? 0.f : (tm == 2 ? m21 : m31), M2_ = tm == 3 ? m32 : 0.f;
            const float P0 = Hrow[0] + (Grow[1] * m10 + Grow[2] * m20 + Grow[3] * m30), P1 = Hrow[1] + (Grow[2] * m21 + Grow[3] * m31), P2_ = Hrow[2] + Grow[3] * m32, P3 = Hrow[3];
#pragma unroll
            for (int mt = 0; mt < 4; ++mt) { float qp[4], rp[4];
#pragma unroll
                for (int j = 0; j < 4; ++j) { const float q0 = DPPQ(qall[mt][j], 0x00), q1 = DPPQ(qall[mt][j], 0x55), q2 = DPPQ(qall[mt][j], 0xAA), q3 = DPPQ(qall[mt][j], 0xFF);
                    qp[j] = -((T0 * q0 + T1 * q1) + (T2 * q2 + T3 * q3));
                    const float Q0 = DPPQ(qp[j], 0x00), Q1 = DPPQ(qp[j], 0x55), Q2 = DPPQ(qp[j], 0xAA), Q3 = DPPQ(qp[j], 0xFF);
                    rp[j] = rall[mt][j] + ((Grow[0] * Q0 + Grow[1] * Q1) + (Grow[2] * Q2 + Grow[3] * Q3)); }
                FQ[mt >> 1][(mt & 1) * 2] = pk(qp[0], qp[1]); FQ[mt >> 1][(mt & 1) * 2 + 1] = pk(qp[2], qp[3]); FR[mt >> 1][(mt & 1) * 2] = pk(rp[0], rp[1]); FR[mt >> 1][(mt & 1) * 2 + 1] = pk(rp[2], rp[3]); }
#pragma unroll
            for (int ks = 0; ks < 2; ++ks) { *(v4u*)(recb + (size_t)((ks * 4 + tm) * 4 + q4_) * 16) = FQ[ks]; *(v4u*)(recb + 512 + (size_t)((ks * 4 + tm) * 4 + q4_) * 16) = FR[ks]; }
            if (q4_ == (r16_ >> 2)) { *(v4u*)(recb + 2304 + tm * 16) = (v4u){pk(M0, M1), pk(M2_, 0.f), pk(P0, P1), pk(P2_, P3)};
                if (tm == 0) *(v4u*)(recb + 2368) = (v4u){0u, 0u, 0u, 0u}; }
        }
    }
}
constexpr int HSP = 264;
DI void compress_item(const Args& a, int l, int item, LAS unsigned char* lds, int tid) {
    const int kv = item >> 7, b = (item >> 6) & 1, g = (item >> 5) & 1, cb = item & 31;
    const int lane = tid & 63, w = tid >> 6, r16 = lane & 15, q4 = lane >> 4;
    const bf16* src = (const bf16*)(a.ws + WS_KV0) + (size_t)(b * SEQ) * 256 + (kv ? 128 : 0) + g * 64;
    const float* pe = a.in[kv ? I_PEV : I_PEK] + l * 2048;
    const bf16* W1T = (const bf16*)(a.ws + WS_CW1) + (size_t)(l * 2 + kv) * 256 * 2048;
    const bf16* W2T = (const bf16*)(a.ws + WS_CW2) + (size_t)(l * 2 + kv) * 64 * 256;
    LAS bf16* Hs = (LAS bf16*)lds;
    const int c = cb * 16 + r16;
    f32x4 acc[2] = {(f32x4){0.f, 0.f, 0.f, 0.f}, (f32x4){0.f, 0.f, 0.f, 0.f}};
#pragma unroll 1
    for (int k4 = 0; k4 < 64; k4 += 4) { v4u raw[4]; f32x4 p0[4], p1[4]; bf16x8 wf[4][2];
#pragma unroll
        for (int i = 0; i < 4; ++i) { const int ks = k4 + i, lt = ks >> 1, d0 = (ks & 1) * 32 + q4 * 8;
            int tokn = 16 * c + lt; tokn = tokn < SEQ ? tokn : SEQ - 1;
            raw[i] = *(const v4u*)(src + (size_t)tokn * 256 + d0);
            p0[i] = *(const f32x4*)(pe + lt * 64 + d0); p1[i] = *(const f32x4*)(pe + lt * 64 + d0 + 4);
#pragma unroll
            for (int t = 0; t < 2; ++t) wf[i][t] = *(const bf16x8*)(W1T + (size_t)((2 * w + t) * 16 + r16) * 2048 + ks * 32 + q4 * 8); }
        __builtin_amdgcn_sched_barrier(0);
#pragma unroll
        for (int i = 0; i < 4; ++i) { float z[8]; unpack8(raw[i], z);
#pragma unroll
            for (int e = 0; e < 8; ++e) z[e] += e < 4 ? p0[i][e & 3] : p1[i][e & 3];
            const bf16x8 af = pack8(z);
#pragma unroll
            for (int t = 0; t < 2; ++t) acc[t] = MFMA16(af, wf[i][t], acc[t]); }
        __builtin_amdgcn_sched_barrier(0);
    }
#pragma unroll
    for (int t = 0; t < 2; ++t)
#pragma unroll
        for (int j = 0; j < 4; ++j) Hs[(q4 * 4 + j) * HSP + (2 * w + t) * 16 + r16] = (bf16)(pk(gelu_erf(acc[t][j]), 0.f) & 0xffffu);
    __syncthreads();
    if (w < 4) { f32x4 o = (f32x4){0.f, 0.f, 0.f, 0.f}; bf16x8 w2f[8];
#pragma unroll
        for (int ks = 0; ks < 8; ++ks) w2f[ks] = *(const bf16x8*)(W2T + (w * 16 + r16) * 256 + ks * 32 + q4 * 8);
        __builtin_amdgcn_sched_barrier(0);
#pragma unroll
        for (int ks = 0; ks < 8; ++ks) o = MFMA16(*(const LAS bf16x8*)(Hs + r16 * HSP + ks * 32 + q4 * 8), w2f[ks], o);
        bf16* dst = (bf16*)(a.ws + (kv ? WS_VCMP : WS_KCMP)) + ((size_t)((b * 2 + g) * 512 + cb * 16 + q4 * 4)) * 64 + w * 16 + r16;
#pragma unroll
        for (int j = 0; j < 4; ++j) dst[j * 64] = (bf16)(pk(o[j], 0.f) & 0xffffu);
    }
    __syncthreads();
}
DI void p_prep(const Args& a, int l, LAS unsigned char* lds, int tid) {
    for (int rep = 0; rep < REP_PREP; ++rep) {
    for (int it = blockIdx.x; it < 256; it += gridDim.x) compress_item(a, l, it, lds, tid);
    const int lane = tid & 63, gw = blockIdx.x * NWAVES + (tid >> 6), NGW = gridDim.x * NWAVES;
    LAS unsigned char* bfr = lds + 16384 + tid * 16; asm volatile("" : "+v"(bfr));
    LAS float* ms = (LAS float*)(lds + 81920) + (tid >> 6) * 256;
    for (int it = gw; it < M / 4; it += NGW) rwkv_prep_item(a, l, it, lane, bfr, ms);
    }
}

constexpr int SC_STEPS = 16, SC_SLOT = SC_STEPS * 768, SC_NSLOT = 12, SC_NSEQ = SEQ / SC_STEPS / 2;
constexpr size_t WS_SMID = WS_CTL + 512 * 1024;
#define SC_LOADSET(r, sq) do { _Pragma("unroll") for (int k_ = 0; k_ < 3; ++k_) r[k_] = *(const v4u*)(gp + (size_t)(sq) * SC_SLOT + k_ * 1024); } while (0)
#define SC_STAGE(r, sq) do { const int s_ = (sq); \
    if (s_ >= SC_NSLOT) { for (;;) { const unsigned m_ = min(min(FL[4], FL[5]), min(FL[6], FL[7])); if ((int)__builtin_amdgcn_readfirstlane(m_) >= s_ - (SC_NSLOT - 1)) break; __builtin_amdgcn_s_sleep(2); } } \
    asm volatile("" ::: "memory"); \
    _Pragma("unroll") for (int k_ = 0; k_ < 3; ++k_) *(LAS v4u*)(lp + ringoff + k_ * 1024) = r[k_]; \
    asm volatile("s_waitcnt lgkmcnt(0)" ::: "memory"); \
    if (lane == 0) FL[lw] = (unsigned)(s_ + 1); \
    if (s_ + 4 < SC_NSEQ) SC_LOADSET(r, s_ + 4); \
    ringoff += SC_SLOT; if (ringoff == SC_NSLOT * SC_SLOT) ringoff = 0; } while (0)
DI void scan_block(const Args& a, int job, LAS unsigned char* lds, int tid) {
    const int lane = tid & 63, w = tid >> 6, bh = job & 15, kind = job >> 4, b = bh >> 3, h = bh & 7, tbeg = kind ? SEQ / 2 : 0;
    volatile LAS unsigned* FL = (volatile LAS unsigned*)(lds + MISC_OFF) + 32;
    if (tid < 8) FL[tid] = 0u;
    __syncthreads();
    const unsigned char* src = (const unsigned char*)(a.ws + WS_REC) + ((size_t)(b * 8 + h) * SEQ + tbeg) * 768;
    if (w >= 4) {
        const int lw = w - 4;
        const unsigned char* gp = src + (lw * 192 + lane) * 16; LAS unsigned char* lp = lds + (lw * 192 + lane) * 16;
        v4u r0[3], r1[3], r2[3], r3[3]; int ringoff = 0;
        SC_LOADSET(r0, 0); SC_LOADSET(r1, 1); SC_LOADSET(r2, 2); SC_LOADSET(r3, 3);
#pragma unroll 1
        for (int sq = 0; sq < SC_NSEQ; sq += 4) { SC_STAGE(r0, sq); SC_STAGE(r1, sq + 1); SC_STAGE(r2, sq + 2); SC_STAGE(r3, sq + 3); }
    } else {
        const int r16 = lane & 15, q4 = lane >> 4; const bool lead = q4 == 0;
        bf16* yp = (bf16*)(a.ws + (kind == 2 ? WS_XN : WS_OA)) + (size_t)(b * SEQ + tbeg) * 512 + h * 64 + 16 * w + r16;
        const int oq0 = r16 < 4 ? ((0 * 4 + r16) * 4 + q4) * 16 : 2368, oq1 = r16 < 4 ? ((1 * 4 + r16) * 4 + q4) * 16 : 2368, or0 = r16 < 4 ? 512 + ((0 * 4 + r16) * 4 + q4) * 16 : 2368, or1 = r16 < 4 ? 512 + ((1 * 4 + r16) * 4 + q4) * 16 : 2368;
        const int oa3 = (lead && r16 < 4) ? 2304 + r16 * 16 : 2368, ovv = (lead && kind != 2) ? 2560 + (16 * w + r16) * 8 : 2368, ok0 = lead ? 1024 + r16 * 16 : 2368, ok1 = lead ? 1024 + (16 + r16) * 16 : 2368,
                  ok2 = lead ? 1024 + (32 + r16) * 16 : 2368, ok3 = lead ? 1024 + (48 + r16) * 16 : 2368, ow = 2048 + 16 * q4;
        f32x4 acc[4];
#pragma unroll
        for (int jt = 0; jt < 4; ++jt)
#pragma unroll
            for (int e = 0; e < 4; ++e) acc[jt][e] = (kind == 2 && 16 * w + r16 == 16 * jt + 4 * q4 + e) ? 1.0f : 0.f;
#define SB_DECL(P) v4u P##aq0, P##aq1, P##ar0, P##ar1, P##a3, P##ak0, P##ak1, P##ak2, P##ak3; f32x4 P##w0, P##w1, P##w2, P##w3; v2u P##vv;
#define SB_LOAD(P, RB) do { const LAS unsigned char* rb_ = (RB); \
        P##aq0 = *(const LAS v4u*)(rb_ + oq0); P##aq1 = *(const LAS v4u*)(rb_ + oq1); P##ar0 = *(const LAS v4u*)(rb_ + or0); P##ar1 = *(const LAS v4u*)(rb_ + or1); P##a3 = *(const LAS v4u*)(rb_ + oa3); \
        P##ak0 = *(const LAS v4u*)(rb_ + ok0); P##ak1 = *(const LAS v4u*)(rb_ + ok1); P##ak2 = *(const LAS v4u*)(rb_ + ok2); P##ak3 = *(const LAS v4u*)(rb_ + ok3); \
        P##w0 = *(const LAS f32x4*)(rb_ + ow); P##w1 = *(const LAS f32x4*)(rb_ + ow + 64); P##w2 = *(const LAS f32x4*)(rb_ + ow + 128); P##w3 = *(const LAS f32x4*)(rb_ + ow + 192); \
        P##vv = *(const LAS v2u*)(rb_ + ovv); } while (0)
#define SB_COMPUTE(P, T0) do { \
        v4u b0, b1; \
        b0.x = pk(acc[0][0], acc[0][1]); b0.y = pk(acc[0][2], acc[0][3]); b0.z = pk(acc[1][0], acc[1][1]); b0.w = pk(acc[1][2], acc[1][3]); \
        b1.x = pk(acc[2][0], acc[2][1]); b1.y = pk(acc[2][2], acc[2][3]); b1.z = pk(acc[3][0], acc[3][1]); b1.w = pk(acc[3][2], acc[3][3]); \
        const v4u b3 = (v4u){P##vv.x, P##vv.y, 0u, 0u}, a3a = (v4u){P##a3.x, P##a3.y, 0u, 0u}, a3y = (v4u){P##a3.z, P##a3.w, 0u, 0u}; \
        const f32x4 zf_ = (f32x4){0.f, 0.f, 0.f, 0.f}; \
        f32x4 da = MFMA16(__builtin_bit_cast(bf16x8, a3a), __builtin_bit_cast(bf16x8, b3), zf_), dy = MFMA16(__builtin_bit_cast(bf16x8, a3y), __builtin_bit_cast(bf16x8, b3), zf_);     \
        da = MFMA16(__builtin_bit_cast(bf16x8, P##aq0), __builtin_bit_cast(bf16x8, b0), da); \
        const f32x4 da2 = MFMA16(__builtin_bit_cast(bf16x8, P##aq1), __builtin_bit_cast(bf16x8, b1), zf_);                    \
        dy = MFMA16(__builtin_bit_cast(bf16x8, P##ar0), __builtin_bit_cast(bf16x8, b0), dy); dy = MFMA16(__builtin_bit_cast(bf16x8, P##ar1), __builtin_bit_cast(bf16x8, b1), dy); \
        da = da + da2; \
        acc[0] = acc[0] * P##w0; acc[1] = acc[1] * P##w1; acc[2] = acc[2] * P##w2; acc[3] = acc[3] * P##w3; \
        const v4u bc = (v4u){pk(da[0], da[1]), pk(da[2], da[3]), P##vv.x, P##vv.y};        \
        acc[0] = MFMA16(__builtin_bit_cast(bf16x8, P##ak0), __builtin_bit_cast(bf16x8, bc), acc[0]); acc[1] = MFMA16(__builtin_bit_cast(bf16x8, P##ak1), __builtin_bit_cast(bf16x8, bc), acc[1]); \
        acc[2] = MFMA16(__builtin_bit_cast(bf16x8, P##ak2), __builtin_bit_cast(bf16x8, bc), acc[2]); acc[3] = MFMA16(__builtin_bit_cast(bf16x8, P##ak3), __builtin_bit_cast(bf16x8, bc), acc[3]); \
        if (lead) { bf16* yq = yp + (size_t)(T0) * 512; const unsigned p01 = pk(dy[0], dy[1]), p23 = pk(dy[2], dy[3]); \
            yq[0] = (bf16)(p01 & 0xffffu); yq[512] = (bf16)(p01 >> 16); yq[1024] = (bf16)(p23 & 0xffffu); yq[1536] = (bf16)(p23 >> 16); } } while (0)
#define SB_WAIT(SQ) do { for (;;) { const unsigned m_ = min(min(FL[0], FL[1]), min(FL[2], FL[3])); if ((int)__builtin_amdgcn_readfirstlane(m_) >= (SQ) + 1) break; __builtin_amdgcn_s_sleep(1); } asm volatile("" ::: "memory"); } while (0)
        SB_DECL(A_) SB_DECL(B_)
        int ringoff = 0;
        SB_WAIT(0); SB_LOAD(A_, lds);
#pragma unroll 1
        for (int sq = 0; sq < SC_NSEQ; ++sq) {
            const LAS unsigned char* sb = lds + ringoff; const int t0 = sq * SC_STEPS;
            int nxt = ringoff + SC_SLOT; if (nxt == SC_NSLOT * SC_SLOT) nxt = 0;
            SB_LOAD(B_, sb + 3072); SB_COMPUTE(A_, t0);
            SB_LOAD(A_, sb + 6144); SB_COMPUTE(B_, t0 + 4);
            SB_LOAD(B_, sb + 9216); SB_COMPUTE(A_, t0 + 8);
            if (sq + 1 < SC_NSEQ) { SB_WAIT(sq + 1); SB_LOAD(A_, lds + nxt); }
            SB_COMPUTE(B_, t0 + 12);
            asm volatile("s_waitcnt lgkmcnt(0)" ::: "memory");
            if (lane == 0) FL[4 + w] = (unsigned)(sq + 1);
            ringoff = nxt;
        }
        if (kind == 0) { bf16* sm = (bf16*)(a.ws + WS_SMID) + (size_t)(bh * 64 + 16 * w + r16) * 64 + 4 * q4;
#pragma unroll
            for (int jt = 0; jt < 4; ++jt) { v2u o; o.x = pk(acc[jt][0], acc[jt][1]); o.y = pk(acc[jt][2], acc[jt][3]); *(v2u*)(sm + 16 * jt) = o; } }
    }
    __syncthreads();
}
DI void rwkv_post_row(const Args& a, int l, int m, int lane) {
    const int c = 8 * lane, h = lane >> 3, j0 = c & 63;
    bf16* yrow = (bf16*)(a.ws + WS_OA) + (size_t)m * 512 + c;
    float y[8], g[8]; unpack8(*(const v4u*)yrow, y); unpack8(*(const v4u*)((const bf16*)(a.ws + WS_G) + (size_t)m * 512 + c), g);
    const bf16* vvp = (const bf16*)(a.ws + WS_REC + ((size_t)((m >> 13) * 8 + h) * 2048 + ((m & (SEQ - 1)) >> 2)) * 3072 + 2560) + (size_t)j0 * 4 + (m & 3);
    float vrow[8];
#pragma unroll
    for (int e = 0; e < 8; ++e) vrow[e] = bflo((unsigned)vvp[e * 4]);
    const float bon = ((const float*)(a.ws + WS_BON))[m * 8 + h];
    float sm = 0.f;
#pragma unroll
    for (int e = 0; e < 8; ++e) sm += y[e];
    const float mean = oct_sum(sm) * (1.f / 64.f);
    float sv = 0.f;
#pragma unroll
    for (int e = 0; e < 8; ++e) { y[e] -= mean; sv += y[e] * y[e]; }
    const float rstd = rsqrtf(oct_sum(sv) * (1.f / 64.f) + 64e-5f);
    const f32x4 lw0 = *(const f32x4*)(a.in[I_LNW] + l * 512 + c), lw1 = *(const f32x4*)(a.in[I_LNW] + l * 512 + c + 4);
    const f32x4 lb0 = *(const f32x4*)(a.in[I_LNB] + l * 512 + c), lb1 = *(const f32x4*)(a.in[I_LNB] + l * 512 + c + 4);
    float o[8];
#pragma unroll
    for (int e = 0; e < 8; ++e) { const float lw = e < 4 ? lw0[e & 3] : lw1[e & 3], lb = e < 4 ? lb0[e & 3] : lb1[e & 3];
        const float v = vrow[e];
        o[e] = (y[e] * rstd * lw + lb + bon * v) * g[e]; }
    v4u w; w.x = pk(o[0], o[1]); w.y = pk(o[2], o[3]); w.z = pk(o[4], o[5]); w.w = pk(o[6], o[7]);
    *(v4u*)yrow = w;
}
DI void scan_fixup(const Args& a, int m0, int lane) {
    const int r16 = lane & 15, q4 = lane >> 4, b = m0 >> 13, mt = m0 + (r16 & 7);
    const bf16* U = (const bf16*)(a.ws + WS_XN) + (size_t)mt * 512; bf16* Y = (bf16*)(a.ws + WS_OA) + (size_t)mt * 512;
#pragma unroll 1
    for (int h = 0; h < 8; ++h) {
        const bf16* sm = (const bf16*)(a.ws + WS_SMID) + (size_t)((b * 8 + h) * 64 + r16) * 64 + q4 * 8;
        bf16x8 ub[2], sa[4][2]; v2u yo[4];
#pragma unroll
        for (int ks = 0; ks < 2; ++ks) { ub[ks] = *(const bf16x8*)(U + h * 64 + ks * 32 + q4 * 8);
#pragma unroll
            for (int it = 0; it < 4; ++it) sa[it][ks] = *(const bf16x8*)(sm + (size_t)it * 16 * 64 + ks * 32); }
#pragma unroll
        for (int it = 0; it < 4; ++it) yo[it] = *(const v2u*)(Y + h * 64 + 16 * it + 4 * q4);
        __builtin_amdgcn_sched_barrier(0);
#pragma unroll
        for (int it = 0; it < 4; ++it) { f32x4 d = (f32x4){0.f, 0.f, 0.f, 0.f};
#pragma unroll
            for (int ks = 0; ks < 2; ++ks) d = MFMA16(sa[it][ks], ub[ks], d);
            v2u o; o.x = pk(bflo(yo[it].x) + d[0], bfhi(yo[it].x) + d[1]); o.y = pk(bflo(yo[it].y) + d[2], bfhi(yo[it].y) + d[3]);
            if (r16 < 8) *(v2u*)(Y + h * 64 + 16 * it + 4 * q4) = o; }
    }
}
DI void p_post(const Args& a, int l, int tid) {
    const int lane = tid & 63, gw = blockIdx.x * NWAVES + (tid >> 6), NGW = gridDim.x * NWAVES;
    for (int grp = gw; grp < M / 8; grp += NGW) { const int m0 = grp * 8;
        if ((m0 & (SEQ - 1)) >= SEQ / 2) { scan_fixup(a, m0, lane); __threadfence(); }
#pragma unroll 1
        for (int t = 0; t < 8; ++t) rwkv_post_row(a, l, m0 + t, lane);
    }
}
constexpr int KP = 144, VP = 136;
constexpr int L_KT0 = 0, L_VT0 = 9216, L_KT1 = 17920, L_VT1 = 27136, L_IMP = 35840, L_SELM = 68864, L_UNI = 69888, L_LIST = 69920, L_NLIST = 70432, L_LUT = 70448, L_FARB = 72512, L_Q = 73728;
DI void load_kv_regs(const bf16* Ksrc, size_t kp, const bf16* Vsrc, size_t vp, int row0, int tid, v4u& kr, v4u& vr) {
    const int key = tid >> 3, ch = tid & 7;
    kr = *(const v4u*)(Ksrc + (size_t)(row0 + key) * kp + ch * 8); vr = *(const v4u*)(Vsrc + (size_t)(row0 + key) * vp + ch * 8);
}
DI void store_kv_lds(LAS unsigned char* Kt, LAS unsigned char* Vt, int tid, v4u kr, v4u vr) {
    const int key = tid >> 3, ch = tid & 7;
    *(LAS v4u*)(Kt + key * KP + ch * 16) = kr;
    *(LAS v4u*)(Vt + (ch >> 2) * 4096 + key * 64 + (ch & 3) * 16) = vr;
}
DI void load_q(const bf16* qrow, float qs, int hh, LAS unsigned char* qf) {
_Pragma("unroll")
    for (int ks = 0; ks < 4; ++ks) { float z[8]; unpack8(*(const v4u*)(qrow + ks * 16 + hh * 8), z);
_Pragma("unroll")
        for (int e = 0; e < 8; ++e) z[e] *= qs;
        *(LAS bf16x8*)(qf + ks * 8192) = pack8(z); }
}
DI void qk_tile(const LAS unsigned char* Kt, const LAS unsigned char* qf, int r, int hh, f32x16& s0, f32x16& s1) {
_Pragma("unroll")
    for (int i = 0; i < 16; ++i) { s0[i] = 0.f; s1[i] = 0.f; }
_Pragma("unroll")
    for (int ks = 0; ks < 4; ++ks) {
        const bf16x8 a0 = *(const LAS bf16x8*)(Kt + r * KP + (ks * 16 + hh * 8) * 2), a1 = *(const LAS bf16x8*)(Kt + (32 + r) * KP + (ks * 16 + hh * 8) * 2);
        const bf16x8 qv = *(const LAS bf16x8*)(qf + ks * 8192);
        s0 = MFMA32(a0, qv, s0); s1 = MFMA32(a1, qv, s1); }
}
DI void qk_tile_r(const LAS unsigned char* Kt, const bf16x8 (&qr)[4], int r, int hh, f32x16& s0, f32x16& s1) {
_Pragma("unroll")
    for (int i = 0; i < 16; ++i) { s0[i] = 0.f; s1[i] = 0.f; }
_Pragma("unroll")
    for (int ks = 0; ks < 4; ++ks) {
        const bf16x8 a0 = *(const LAS bf16x8*)(Kt + r * KP + (ks * 16 + hh * 8) * 2), a1 = *(const LAS bf16x8*)(Kt + (32 + r) * KP + (ks * 16 + hh * 8) * 2);
        s0 = MFMA32(a0, qr[ks], s0); s1 = MFMA32(a1, qr[ks], s1); }
}
typedef short v4i16_t __attribute__((ext_vector_type(4)));
DI v2u vtr(const LAS unsigned char* p) { return __builtin_bit_cast(v2u, __builtin_amdgcn_ds_read_tr16_b64_v4i16((LAS v4i16_t*)p)); }
DI void pv_tile(const LAS unsigned char* Vt, const f32x16& p0, const f32x16& p1, int r, int hh, f32x16& o0, f32x16& o1) {
    const LAS unsigned char* vp = Vt + ((r >> 4) & 1) * 32 + (r & 3) * 8 + (4 * hh + ((r & 15) >> 2)) * 64;
_Pragma("unroll")
    for (int kk = 0; kk < 4; ++kk) {
        float z[8];
_Pragma("unroll")
        for (int e = 0; e < 8; ++e) z[e] = (kk < 2) ? p0[8 * (kk & 1) + e] : p1[8 * (kk & 1) + e];
        const bf16x8 pf = pack8(z);
_Pragma("unroll")
        for (int dt = 0; dt < 2; ++dt) {
            const v2u lo = vtr(vp + dt * 4096 + kk * 1024), hi = vtr(vp + dt * 4096 + kk * 1024 + 512);
            const bf16x8 af = __builtin_bit_cast(bf16x8, ((v4u){lo.x, lo.y, hi.x, hi.y}));
            if (dt == 0) o0 = MFMA32(af, pf, o0); else o1 = MFMA32(af, pf, o1); }
    }
}
DI float max3(float a, float b, float c) { float d; asm("v_max3_f32 %0, %1, %2, %3" : "=v"(d) : "v"(a), "v"(b), "v"(c)); return d; }
DI float tile_max(const f32x16& s0, const f32x16& s1) {
    float bm = max3(s0[0], s1[0], s1[0]);
_Pragma("unroll")
    for (int i = 1; i < 16; ++i) bm = max3(bm, s0[i], s1[i]);
    return bm;
}
DI float tile_exp(f32x16& s0, f32x16& s1, float off) {
    const f32x2 off2 = (f32x2){off, off}; f32x2 ps2 = (f32x2){0.f, 0.f};
_Pragma("unroll")
    for (int i = 0; i < 16; i += 2) {
        f32x2 t = (f32x2){s0[i], s0[i + 1]} + off2, u = (f32x2){s1[i], s1[i + 1]} + off2;
        t.x = __builtin_amdgcn_exp2f(t.x); t.y = __builtin_amdgcn_exp2f(t.y); u.x = __builtin_amdgcn_exp2f(u.x); u.y = __builtin_amdgcn_exp2f(u.y);
        s0[i] = t.x; s0[i + 1] = t.y; s1[i] = u.x; s1[i + 1] = u.y; ps2 += t; ps2 += u; }
    return ps2.x + ps2.y;
}
DI void sm_update(f32x16& s0, f32x16& s1, float& m, float& lp, f32x16& o0, f32x16& o1) {
    float bm = tile_max(s0, s1);
    bm = max3(bm, __shfl_xor(bm, 32), NEG_INF);
    const float mn = fmaxf(m, bm), ms = (mn == NEG_INF) ? 0.f : mn;
    const float alpha = __builtin_amdgcn_exp2f(m - ms);
    const float ps = tile_exp(s0, s1, -ms);
    lp = lp * alpha + ps; m = mn;
    if (__builtin_amdgcn_ballot_w64(alpha != 1.0f) != 0ull) {
_Pragma("unroll")
        for (int i = 0; i < 16; ++i) { o0[i] *= alpha; o1[i] *= alpha; } }
}
DI void sm_update_row(f32x16& s0, f32x16& s1, float brow, float& m, float& lp, f32x16& o0, f32x16& o1) {
    float bm = tile_max(s0, s1);
    bm = max3(bm, __shfl_xor(bm, 32), NEG_INF) + brow;
    const float mn = fmaxf(m, bm), ms = (mn == NEG_INF) ? 0.f : mn;
    const float alpha = __builtin_amdgcn_exp2f(m - ms), off = brow - ms;
    const float ps = tile_exp(s0, s1, off);
    lp = lp * alpha + ps; m = mn;
    if (__builtin_amdgcn_ballot_w64(alpha != 1.0f) != 0ull) {
_Pragma("unroll")
        for (int i = 0; i < 16; ++i) { o0[i] *= alpha; o1[i] *= alpha; } }
}
DI void sm_pv(f32x16& s0, f32x16& s1, float brow, float& m, float& lp, f32x16& o0, f32x16& o1, const LAS unsigned char* Vt, int r, int hh) {
    float bm = tile_max(s0, s1);
    bm = max3(bm, __shfl_xor(bm, 32), NEG_INF) + brow;
    const float mn = fmaxf(m, bm), ms = (mn == NEG_INF) ? 0.f : mn;
    const float alpha = __builtin_amdgcn_exp2f(m - ms), off = brow - ms;
    if (__builtin_amdgcn_ballot_w64(alpha != 1.0f) != 0ull) {
_Pragma("unroll")
        for (int i = 0; i < 16; ++i) { o0[i] *= alpha; o1[i] *= alpha; } }
    const LAS unsigned char* vp = Vt + ((r >> 4) & 1) * 32 + (r & 3) * 8 + (4 * hh + ((r & 15) >> 2)) * 64;
    const f32x2 off2 = (f32x2){off, off}; f32x2 ps2 = (f32x2){0.f, 0.f};
_Pragma("unroll")
    for (int kk = 0; kk < 4; ++kk) {
        const v2u lo0 = vtr(vp + kk * 1024), hi0 = vtr(vp + kk * 1024 + 512), lo1 = vtr(vp + 4096 + kk * 1024), hi1 = vtr(vp + 4096 + kk * 1024 + 512);
        v4u pw;
_Pragma("unroll")
        for (int j = 0; j < 4; ++j) { const int i = 8 * (kk & 1) + 2 * j;
            f32x2 t = ((kk < 2) ? (f32x2){s0[i], s0[i + 1]} : (f32x2){s1[i], s1[i + 1]}) + off2;
            t.x = __builtin_amdgcn_exp2f(t.x); t.y = __builtin_amdgcn_exp2f(t.y); ps2 += t; pw[j] = pk(t.x, t.y); }
        const bf16x8 pf = __builtin_bit_cast(bf16x8, pw);
        o0 = MFMA32(__builtin_bit_cast(bf16x8, ((v4u){lo0.x, lo0.y, hi0.x, hi0.y})), pf, o0);
        o1 = MFMA32(__builtin_bit_cast(bf16x8, ((v4u){lo1.x, lo1.y, hi1.x, hi1.y})), pf, o1);
        __builtin_amdgcn_sched_barrier(0);
    }
    lp = lp * alpha + (ps2.x + ps2.y); m = mn;
}
#define KV_LOOP(NBLK, ROW0_OF, KSRC, KPITCH, VSRC, VPITCH, ...) do { const int nb_ = (NBLK); if (nb_ > 0) { v4u kr_, vr_; \
    { const int i_ = 0; load_kv_regs((KSRC), (KPITCH), (VSRC), (VPITCH), (ROW0_OF), tid, kr_, vr_); } \
    store_kv_lds(lds + L_KT0, lds + L_VT0, tid, kr_, vr_); __syncthreads(); \
    for (int ib_ = 0; ib_ < nb_; ++ib_) { \
        if (ib_ + 1 < nb_) { const int i_ = ib_ + 1; load_kv_regs((KSRC), (KPITCH), (VSRC), (VPITCH), (ROW0_OF), tid, kr_, vr_); } \
        { const int i_ = ib_; const LAS unsigned char* Kt = lds + ((ib_ & 1) ? L_KT1 : L_KT0); const LAS unsigned char* Vt = lds + ((ib_ & 1) ? L_VT1 : L_VT0); __VA_ARGS__ } \
        if (ib_ + 1 < nb_) store_kv_lds(lds + ((ib_ & 1) ? L_KT0 : L_KT1), lds + ((ib_ & 1) ? L_VT0 : L_VT1), tid, kr_, vr_); \
        __syncthreads(); } } } while (0)

DI void store_o(bf16* orow, const f32x16& v0, const f32x16& v1, int hh) {
_Pragma("unroll")
    for (int g4 = 0; g4 < 4; ++g4) {
        v2u w; w.x = pk(v0[4 * g4], v0[4 * g4 + 1]); w.y = pk(v0[4 * g4 + 2], v0[4 * g4 + 3]); *(v2u*)(orow + 8 * g4 + 4 * hh) = w;
        w.x = pk(v1[4 * g4], v1[4 * g4 + 1]); w.y = pk(v1[4 * g4 + 2], v1[4 * g4 + 3]); *(v2u*)(orow + 32 + 8 * g4 + 4 * hh) = w; }
}

DI void add_o(bf16* orow, const f32x16& v0, const f32x16& v1, int hh) {
_Pragma("unroll")
    for (int g4 = 0; g4 < 4; ++g4) {
        v2u* p0 = (v2u*)(orow + 8 * g4 + 4 * hh); v2u* p1 = (v2u*)(orow + 32 + 8 * g4 + 4 * hh); const v2u a0 = *p0, a1 = *p1; v2u w;
        w.x = pk(bflo(a0.x) + v0[4 * g4], bfhi(a0.x) + v0[4 * g4 + 1]); w.y = pk(bflo(a0.y) + v0[4 * g4 + 2], bfhi(a0.y) + v0[4 * g4 + 3]); *p0 = w;
        w.x = pk(bflo(a1.x) + v1[4 * g4], bfhi(a1.x) + v1[4 * g4 + 1]); w.y = pk(bflo(a1.y) + v1[4 * g4 + 2], bfhi(a1.y) + v1[4 * g4 + 3]); *p1 = w; }
}
DI void nsa_tile(const Args& a, int l, int b, int g, int qt, LAS unsigned char* lds, int tid) {
    const int lane = tid & 63, w = tid >> 6, r = lane & 31, hh = lane >> 5, head = w >> 1, ql = 32 * (w & 1) + r;
    const int t0 = qt * 64, cur = qt, tq = t0 + ql, mq = b * SEQ + tq;
    const bf16* PROJ = (const bf16*)(a.ws + WS_PROJ);
    LAS unsigned* IMP = (LAS unsigned*)(lds + L_IMP); LAS unsigned* SELM = (LAS unsigned*)(lds + L_SELM); LAS unsigned* UNI = (LAS unsigned*)(lds + L_UNI);
    LAS int* LIST = (LAS int*)(lds + L_LIST); LAS int* NLIST = (LAS int*)(lds + L_NLIST); LAS float* LUT = (LAS float*)(lds + L_LUT); LAS float* FARB = (LAS float*)(lds + L_FARB);
    { const int hh_ = tid >> 7, dist = tid & 127; LUT[hh_ * 129 + dist] = a.in[I_REL][(int)T5_BK[dist] * 16 + g * 4 + hh_] * LOG2E;
      if (tid < 4) { const float fb = a.in[I_REL][31 * 16 + g * 4 + tid] * LOG2E; FARB[tid] = fb; LUT[tid * 129 + 128] = fb; } }
    for (int i = tid; i < 64 * 129; i += NT) IMP[i] = 0u;
    if (tid < 4) UNI[tid] = 0u;
    LAS unsigned char* qf = lds + L_Q + tid * 16; asm volatile("" : "+v"(qf));
    load_q(PROJ + (size_t)mq * NP + C_NQ + (g * 4 + head) * 64, 0.125f * LOG2E, hh, qf);
    bf16* orow = (bf16*)(a.ws + WS_OB) + (size_t)mq * 512 + (g * 4 + head) * 64;
    float gc, gs, gw_;
    { const bf16* gp = PROJ + (size_t)mq * NP + C_NG + (g * 4 + head) * 3; gc = sigm(bflo((unsigned)gp[0])); gs = sigm(bflo((unsigned)gp[1])); gw_ = sigm(bflo((unsigned)gp[2])); }
    f32x16 o0, o1, s0, s1;
    __syncthreads();
    const bf16* Kc = (const bf16*)(a.ws + WS_KCMP) + (size_t)((b * 2 + g) * 512) * 64; const bf16* Vc = (const bf16*)(a.ws + WS_VCMP) + (size_t)((b * 2 + g) * 512) * 64;
    int ncv = 4 * cur + 3; ncv = ncv < 511 ? ncv : 511;
    const int ncb = (ncv + 63) >> 6;
    float m = NEG_INF, lp = 0.f;
    KV_LOOP(ncb, i_ * 64, Kc, 64, Vc, 64, {
        qk_tile(Kt, qf, r, hh, s0, s1);
_Pragma("unroll")
        for (int i = 0; i < 16; ++i) { const int c0 = i_ * 64 + crow(i, hh), c1 = c0 + 32;
            s0[i] = (16 * c0 + 31 <= tq && c0 < 511) ? s0[i] : NEG_INF; s1[i] = (16 * c1 + 31 <= tq && c1 < 511) ? s1[i] : NEG_INF; }
_Pragma("unroll")
        for (int i = 0; i < 16; ++i) { o0[i] = 0.f; o1[i] = 0.f; }
        sm_update(s0, s1, m, lp, o0, o1);
    });
    {
        const float lt = lp + __shfl_xor(lp, 32), inv = lt > 0.f ? 1.0f / lt : 0.f, ms = (m == NEG_INF) ? 0.f : m;
_Pragma("unroll")
        for (int i = 0; i < 16; ++i) { o0[i] = 0.f; o1[i] = 0.f; }
        KV_LOOP(ncb, i_ * 64, Kc, 64, Vc, 64, {
            qk_tile(Kt, qf, r, hh, s0, s1);
_Pragma("unroll")
            for (int i = 0; i < 16; ++i) { const int c0 = i_ * 64 + crow(i, hh), c1 = c0 + 32;
                s0[i] = (16 * c0 + 31 <= tq && c0 < 511) ? __builtin_amdgcn_exp2f(s0[i] - ms) * inv : 0.f; s1[i] = (16 * c1 + 31 <= tq && c1 < 511) ? __builtin_amdgcn_exp2f(s1[i] - ms) * inv : 0.f; }
_Pragma("unroll")
            for (int g4 = 0; g4 < 4; ++g4) {
                const int n0 = i_ * 16 + 2 * g4 + hh, n1 = n0 + 8;
                const float G0 = (s0[4 * g4] + s0[4 * g4 + 1]) + (s0[4 * g4 + 2] + s0[4 * g4 + 3]), G1 = (s1[4 * g4] + s1[4 * g4 + 1]) + (s1[4 * g4 + 2] + s1[4 * g4 + 3]);
                __hip_atomic_fetch_add(IMP + ql * 129 + n0, (unsigned)(G0 * 1048576.f + 0.5f), __ATOMIC_RELAXED, __HIP_MEMORY_SCOPE_WORKGROUP);
                __hip_atomic_fetch_add(IMP + ql * 129 + n0 + 1, (unsigned)(s0[4 * g4 + 3] * 1048576.f + 0.5f), __ATOMIC_RELAXED, __HIP_MEMORY_SCOPE_WORKGROUP);
                __hip_atomic_fetch_add(IMP + ql * 129 + n1, (unsigned)(G1 * 1048576.f + 0.5f), __ATOMIC_RELAXED, __HIP_MEMORY_SCOPE_WORKGROUP);
                __hip_atomic_fetch_add(IMP + ql * 129 + n1 + 1, (unsigned)(s1[4 * g4 + 3] * 1048576.f + 0.5f), __ATOMIC_RELAXED, __HIP_MEMORY_SCOPE_WORKGROUP); }
            pv_tile(Vt, s0, s1, r, hh, o0, o1);
        });
_Pragma("unroll")
        for (int i = 0; i < 16; ++i) { o0[i] *= gc; o1[i] *= gc; }
        store_o(orow, o0, o1, hh);
    }
    __syncthreads();
    {
        const int nforced = cur == 0 ? 1 : (cur == 1 ? 2 : 3), need = 16 - nforced, cnt = cur + 1 - nforced;
        for (int qq = 0; qq < 8; ++qq) { const int q = 8 * w + qq;
            const int n0 = lane, n1 = lane + 64;
            const bool f0 = (n0 == 0) || (n0 == cur) || (n0 == cur - 1), f1 = (n1 == cur) || (n1 == cur - 1);
            const bool v0 = n0 <= cur, v1 = n1 <= cur;
            unsigned i0 = IMP[q * 129 + n0], i1 = IMP[q * 129 + n1]; i0 = i0 < 0x1FFFFFEu ? i0 : 0x1FFFFFEu; i1 = i1 < 0x1FFFFFEu ? i1 : 0x1FFFFFEu;
            const unsigned k0 = (v0 && !f0) ? ((i0 << 7) | (unsigned)(127 - n0)) + 1u : 0u, k1 = (v1 && !f1) ? ((i1 << 7) | (unsigned)(127 - n1)) + 1u : 0u;
            unsigned T = 1u;
            if (cnt > need) { T = 0u;
                for (int bit = 31; bit >= 0; --bit) { const unsigned cand = T | (1u << bit);
                    const int c = __popcll(__ballot(k0 >= cand)) + __popcll(__ballot(k1 >= cand));
                    if (c >= need) T = cand; } }
            const bool sel0 = (k0 >= T && k0 != 0u) || (f0 && v0), sel1 = (k1 >= T && k1 != 0u) || (f1 && v1);
            const unsigned long long b0 = __ballot(sel0), b1 = __ballot(sel1);
            if (lane == 0) { SELM[q * 4] = (unsigned)b0; SELM[q * 4 + 1] = (unsigned)(b0 >> 32); SELM[q * 4 + 2] = (unsigned)b1; SELM[q * 4 + 3] = (unsigned)(b1 >> 32);
                __hip_atomic_fetch_or(UNI + 0, (unsigned)b0, __ATOMIC_RELAXED, __HIP_MEMORY_SCOPE_WORKGROUP); __hip_atomic_fetch_or(UNI + 1, (unsigned)(b0 >> 32), __ATOMIC_RELAXED, __HIP_MEMORY_SCOPE_WORKGROUP);
                __hip_atomic_fetch_or(UNI + 2, (unsigned)b1, __ATOMIC_RELAXED, __HIP_MEMORY_SCOPE_WORKGROUP); __hip_atomic_fetch_or(UNI + 3, (unsigned)(b1 >> 32), __ATOMIC_RELAXED, __HIP_MEMORY_SCOPE_WORKGROUP); }
        }
    }
    __syncthreads();
    if (w == 0) {
        const unsigned long long u0 = (unsigned long long)UNI[0] | ((unsigned long long)UNI[1] << 32), u1 = (unsigned long long)UNI[2] | ((unsigned long long)UNI[3] << 32);
        const unsigned long long lowm = (1ull << lane) - 1ull;
        if ((u0 >> lane) & 1ull) LIST[__popcll(u0 & lowm)] = lane;
        if ((u1 >> lane) & 1ull) LIST[__popcll(u0) + __popcll(u1 & lowm)] = 64 + lane;
        if (lane == 0) NLIST[0] = __popcll(u0) + __popcll(u1);
    }
    __syncthreads();
    const float farb = FARB[head];
    asm volatile("s_waitcnt vmcnt(0)" ::: "memory");
    __syncthreads();
    {
        const int tl2 = 8 * w + (r & 7), head2 = r >> 3, tq2 = t0 + tl2, mq2 = b * SEQ + tq2;
        { const bf16* qrow = PROJ + (size_t)mq2 * NP + C_NQ + (g * 4 + head2) * 64;
_Pragma("unroll")
          for (int ks = 0; ks < 4; ++ks) { float z[8]; unpack8(*(const v4u*)(qrow + ks * 16 + hh * 8), z);
_Pragma("unroll")
              for (int e = 0; e < 8; ++e) z[e] *= 0.125f * LOG2E;
              *(LAS bf16x8*)(qf + 32768 + ks * 8192) = pack8(z); } }
        const unsigned sw0 = SELM[tl2 * 4], sw1 = SELM[tl2 * 4 + 1], sw2 = SELM[tl2 * 4 + 2], sw3 = SELM[tl2 * 4 + 3];
        unsigned u0 = 0u, u1 = 0u, u2 = 0u, u3 = 0u;
_Pragma("unroll")
        for (int k = 0; k < 8; ++k) { u0 |= (unsigned)__builtin_amdgcn_readlane((int)sw0, k); u1 |= (unsigned)__builtin_amdgcn_readlane((int)sw1, k);
                                      u2 |= (unsigned)__builtin_amdgcn_readlane((int)sw2, k); u3 |= (unsigned)__builtin_amdgcn_readlane((int)sw3, k); }
        const unsigned long long ulo = (unsigned long long)u0 | ((unsigned long long)u1 << 32), uhi = (unsigned long long)u2 | ((unsigned long long)u3 << 32);
        const float farb2 = FARB[head2];
        const float gs2 = sigm(bflo((unsigned)(PROJ + (size_t)mq2 * NP + C_NG + (g * 4 + head2) * 3)[1]));
        const bf16* Ks = (const bf16*)(a.ws + WS_KV0) + (size_t)(M + b * SEQ) * 256 + g * 64; const bf16* Vs = Ks + 128;
        const int nl = NLIST[0];
        m = NEG_INF; lp = 0.f;
_Pragma("unroll")
        for (int i = 0; i < 16; ++i) { o0[i] = 0.f; o1[i] = 0.f; }
        KV_LOOP(nl, LIST[i_] * 64, Ks, 256, Vs, 256, {
            const int n = LIST[i_], kv0 = n * 64;
            const bool mine = n < 64 ? ((ulo >> n) & 1ull) : ((uhi >> (n - 64)) & 1ull);
            if (mine) {
_Pragma("unroll")
                for (int i = 0; i < 16; ++i) { s0[i] = 0.f; s1[i] = 0.f; }
_Pragma("unroll")
                for (int ks = 0; ks < 4; ++ks) { const bf16x8 qv = *(const LAS bf16x8*)(qf + 32768 + ks * 8192);
                    const bf16x8 a0 = *(const LAS bf16x8*)(Kt + r * KP + (ks * 16 + hh * 8) * 2), a1 = *(const LAS bf16x8*)(Kt + (32 + r) * KP + (ks * 16 + hh * 8) * 2);
                    s0 = MFMA32(a0, qv, s0); s1 = MFMA32(a1, qv, s1); }
                const unsigned swd = n < 32 ? sw0 : (n < 64 ? sw1 : (n < 96 ? sw2 : sw3));
                const bool selq = (swd >> (n & 31)) & 1u;
                float brow = selq ? farb2 : NEG_INF;
                if ((cur - n) < 3) { brow = 0.f;
_Pragma("unroll")
                    for (int i = 0; i < 16; ++i) { const int d0 = tq2 - (kv0 + crow(i, hh)), d1 = d0 - 32;
                        const float b0 = LUT[head2 * 129 + (int)min((unsigned)d0, 128u)], b1 = LUT[head2 * 129 + (int)min((unsigned)d1, 128u)];
                        s0[i] = (selq && d0 >= 0) ? s0[i] + b0 : NEG_INF; s1[i] = (selq && d1 >= 0) ? s1[i] + b1 : NEG_INF;
                        if ((i & 3) == 3) asm volatile("" ::: "memory"); }
                }
                sm_pv(s0, s1, brow, m, lp, o0, o1, Vt, r, hh);
            }
        });
        const float lt = lp + __shfl_xor(lp, 32), sc = lt > 0.f ? gs2 / lt : 0.f;
_Pragma("unroll")
        for (int i = 0; i < 16; ++i) { o0[i] *= sc; o1[i] *= sc; }
        add_o((bf16*)(a.ws + WS_OB) + (size_t)mq2 * 512 + (g * 4 + head2) * 64, o0, o1, hh);
    }
    asm volatile("s_waitcnt vmcnt(0)" ::: "memory");
    __syncthreads();
    {
        const int nlo = cur >= 8 ? cur - 8 : 0;
        const bf16* Kw = (const bf16*)(a.ws + WS_KV1) + (size_t)(b * SEQ) * 256 + g * 64; const bf16* Vw = Kw + 128;
        m = NEG_INF; lp = 0.f;
_Pragma("unroll")
        for (int i = 0; i < 16; ++i) { o0[i] = 0.f; o1[i] = 0.f; }
        KV_LOOP(cur - nlo + 1, (nlo + i_) * 64, Kw, 256, Vw, 256, {
            const int kv0 = (nlo + i_) * 64, dn = cur - (nlo + i_);
            qk_tile(Kt, qf, r, hh, s0, s1);
            float brow = farb;
            if (dn < 3 || dn > 7) { brow = 0.f;
_Pragma("unroll")
                for (int i = 0; i < 16; ++i) { const int d0 = tq - (kv0 + crow(i, hh)), d1 = d0 - 32;
                    const float b0 = LUT[head * 129 + (int)min((unsigned)d0, 128u)], b1 = LUT[head * 129 + (int)min((unsigned)d1, 128u)];
                    s0[i] = (d0 >= 0 && d0 < 512) ? s0[i] + b0 : NEG_INF; s1[i] = (d1 >= 0 && d1 < 512) ? s1[i] + b1 : NEG_INF;
                    if ((i & 3) == 3) asm volatile("" ::: "memory"); }
            }
            sm_pv(s0, s1, brow, m, lp, o0, o1, Vt, r, hh);
        });
        const float lt = lp + __shfl_xor(lp, 32), sc = lt > 0.f ? gw_ / lt : 0.f;
_Pragma("unroll")
        for (int i = 0; i < 16; ++i) { o0[i] *= sc; o1[i] *= sc; }
        add_o(orow, o0, o1, hh);
    }
    __syncthreads();
}
DI void swa_tile(const Args& a, int l, int b, int g, int qt, LAS unsigned char* lds, int tid) {
    const int lane = tid & 63, w = tid >> 6, r = lane & 31, hh = lane >> 5, head = w >> 1, ql = 32 * (w & 1) + r;
    const int t0 = qt * 64, cur = qt, tq = t0 + ql, mq = b * SEQ + tq;
    const bf16* PROJ = (const bf16*)(a.ws + WS_PROJ);
    LAS float* LUT = (LAS float*)(lds + L_LUT);
    { const int hh_ = tid >> 7, dist = tid & 127; LUT[hh_ * 129 + dist] = a.in[I_REL][(int)T5_BK[dist] * 16 + 8 + g * 4 + hh_] * LOG2E; if (tid < 4) LUT[tid * 129 + 128] = 0.f; }
    LAS unsigned char* qf = lds + L_Q + tid * 16; asm volatile("" : "+v"(qf));
    load_q(PROJ + (size_t)mq * NP + C_SQ + (g * 4 + head) * 64, 0.125f * LOG2E, hh, qf);
    const float sink = a.in[I_SINK][l * 8 + g * 4 + head] * LOG2E;
    f32x16 o0, o1, s0, s1;
_Pragma("unroll")
    for (int i = 0; i < 16; ++i) { o0[i] = 0.f; o1[i] = 0.f; }
    float m = sink, lp = hh == 0 ? 1.0f : 0.f;
    __syncthreads();
    const int nlo = cur >= 2 ? cur - 2 : 0;
    const bf16* Kw = (const bf16*)(a.ws + WS_KV1) + (size_t)(M + b * SEQ) * 256 + g * 64; const bf16* Vw = Kw + 128;
    KV_LOOP(cur - nlo + 1, (nlo + i_) * 64, Kw, 256, Vw, 256, {
        const int kv0 = (nlo + i_) * 64;
        qk_tile(Kt, qf, r, hh, s0, s1);
_Pragma("unroll")
        for (int i = 0; i < 16; ++i) { const int d0 = tq - (kv0 + crow(i, hh)), d1 = d0 - 32;
            s0[i] = (d0 >= 0 && d0 < 128) ? s0[i] + LUT[head * 129 + (int)min((unsigned)d0, 128u)] : NEG_INF; s1[i] = (d1 >= 0 && d1 < 128) ? s1[i] + LUT[head * 129 + (int)min((unsigned)d1, 128u)] : NEG_INF; }
        sm_pv(s0, s1, 0.f, m, lp, o0, o1, Vt, r, hh);
    });
    const float lt = lp + __shfl_xor(lp, 32), sc = 1.0f / lt;
_Pragma("unroll")
    for (int i = 0; i < 16; ++i) { o0[i] *= sc; o1[i] *= sc; }
    store_o((bf16*)(a.ws + WS_OC) + (size_t)mq * 512 + (g * 4 + head) * 64, o0, o1, hh);
    __syncthreads();
}
constexpr int CW_Q = 8192;
DI void p_mix(const Args& a, int l, LAS unsigned char* lds, int tid) {
    unsigned* qhead = (unsigned*)(a.ws + WS_CTL) + CW_Q + 64 * l;
    volatile LAS int* QI = (volatile LAS int*)(lds + MISC_OFF) + 16;
#if PROBE_DELAY_SCAN_US
    if (blockIdx.x < 48) spin_us(PROBE_DELAY_SCAN_US);
#endif
#if PROBE_DELAY_ATTN_US
    if (blockIdx.x >= 48) spin_us(PROBE_DELAY_ATTN_US);
#endif
    for (int rep = 0; rep < REP_SCAN; ++rep)
    for (int it = blockIdx.x; it < 48; it += gridDim.x) scan_block(a, it, lds, tid);
    for (;;) {
        if (tid == 0) QI[0] = (int)__hip_atomic_fetch_add(qhead, 1u, __ATOMIC_RELAXED, __HIP_MEMORY_SCOPE_AGENT);
        __syncthreads();
        const int idx = QI[0];
        __syncthreads();
        if (idx >= 1024) break;
        if (idx < 512) { const int qt = 127 - (idx >> 2), bg = idx & 3; nsa_tile(a, l, bg >> 1, bg & 1, qt, lds, tid); }
        else { const int j = idx - 512, bg = j >> 7, qt = j & 127; swa_tile(a, l, bg >> 1, bg & 1, qt, lds, tid); }
    }
}

DI void cvt_fp8(const float* src, unsigned char* dst, size_t n, float sc, size_t gtid, size_t gthreads) {
    for (size_t i = gtid * 16; i < n; i += gthreads * 16) { v4u o;
#pragma unroll
        for (int c = 0; c < 4; ++c) { const f32x4 v = *(const f32x4*)(src + i + 4 * c) * sc; int w = 0; w = __builtin_amdgcn_cvt_pk_fp8_f32(v.x, v.y, w, false); w = __builtin_amdgcn_cvt_pk_fp8_f32(v.z, v.w, w, true); o[c] = (unsigned)w; }
        *(v4u*)(dst + i) = o; }
}
DI void cvt_fp4(const float* src, unsigned char* dst, size_t n, float sc, size_t gtid, size_t gthreads) {
    for (size_t i = gtid * 16; i < n; i += gthreads * 16) { v2u o;
#pragma unroll
        for (int d = 0; d < 2; ++d) { unsigned w = 0u;
#pragma unroll
            for (int c = 0; c < 2; ++c) { const f32x4 v = *(const f32x4*)(src + i + 8 * d + 4 * c) * sc;
                if (c == 0) { w = __builtin_amdgcn_cvt_scalef32_pk_fp4_f32(w, v.x, v.y, 1.0f, 0); w = __builtin_amdgcn_cvt_scalef32_pk_fp4_f32(w, v.z, v.w, 1.0f, 1); }
                else        { w = __builtin_amdgcn_cvt_scalef32_pk_fp4_f32(w, v.x, v.y, 1.0f, 2); w = __builtin_amdgcn_cvt_scalef32_pk_fp4_f32(w, v.z, v.w, 1.0f, 3); } }
            o[d] = w; }
        *(v2u*)(dst + i / 2) = o; }
}
constexpr float PU_I4 = 96.f;
DI void cvt_i4(const float* src, unsigned char* dst, size_t n, float sc, size_t gtid, size_t gthreads) {
    for (size_t i = gtid * 16; i < n; i += gthreads * 64) { f32x4 v[4][4];
#pragma unroll
        for (int u = 0; u < 4; ++u)
#pragma unroll
            for (int c = 0; c < 4; ++c) v[u][c] = *(const f32x4*)(src + i + (size_t)u * gthreads * 16 + 4 * c);
        __builtin_amdgcn_sched_barrier(0);
#pragma unroll
        for (int u = 0; u < 4; ++u) { v2u o;
#pragma unroll
            for (int d = 0; d < 2; ++d) { unsigned w = 0u;
#pragma unroll
                for (int e = 0; e < 8; ++e) { const float x = v[u][2 * d + (e >> 2)][e & 3] * sc; int qi = (int)__builtin_rintf(x); qi = qi < -8 ? -8 : (qi > 7 ? 7 : qi); w |= ((unsigned)qi & 15u) << (4 * e); }
                o[d] = w; }
            *(v2u*)(dst + (i + (size_t)u * gthreads * 16) / 2) = o; }
        __builtin_amdgcn_sched_barrier(0); }
}
DI void p_norm2(const Args& a, int l, int tid) {
    p_rms(a.out, a.in[I_LN2] + l * D, (bf16*)(a.ws + WS_XN), tid);
    const size_t gtid = (size_t)blockIdx.x * NT + tid, gth = (size_t)gridDim.x * NT;
    cvt_i4(a.in[I_PU] + (size_t)l * 16384 * 1024, a.ws + WS_PU, (size_t)16384 * 1024, PU_I4, gtid, gth);
    cvt_fp4(a.in[I_PV] + (size_t)l * 16384 * 1024, a.ws + WS_PV, (size_t)16384 * 1024, PV_SCALE, gtid, gth);
}
constexpr int P_SC = 0, P_TOP = 132096, P_EXP = 0, P_GATE = 8192;
DI void peer_item(const Args& a, int l, int item, LAS unsigned char* lds, int tid, bool dry) {
    const int lane = tid & 63, w = tid >> 6, r16 = lane & 15, q4 = lane >> 4, m0 = item * 16;
    LAS float* SC = (LAS float*)(lds + P_SC); LAS float* TOP = (LAS float*)(lds + P_TOP); LAS int* EXPI = (LAS int*)(lds + P_EXP); LAS float* GATE = (LAS float*)(lds + P_GATE);
    const bf16* PQ = (const bf16*)(a.ws + WS_PQ); const bf16* SK = (const bf16*)(a.ws + WS_SK) + (size_t)l * 16 * 128 * 128;
#pragma unroll 1
    for (int hpi = 0; hpi < 2; ++hpi) { const int hp = 2 * w + hpi;
        bf16x8 af[4], bq[4][8];
        const bf16* ap = PQ + (size_t)(m0 + r16) * 2048 + hp * 128 + q4 * 8; const bf16* bp = SK + (size_t)(hp * 128 + r16) * 128 + q4 * 8;
#pragma unroll
        for (int ks = 0; ks < 4; ++ks) { af[ks] = *(const bf16x8*)(ap + ks * 32);
#pragma unroll
            for (int nt = 0; nt < 8; ++nt) bq[ks][nt] = *(const bf16x8*)(bp + (size_t)nt * 16 * 128 + ks * 32); }
        __builtin_amdgcn_sched_barrier(0);
        f32x4 acc[8];
#pragma unroll
        for (int nt = 0; nt < 8; ++nt) acc[nt] = (f32x4){0.f, 0.f, 0.f, 0.f};
#pragma unroll
        for (int ks = 0; ks < 4; ++ks)
#pragma unroll
            for (int nt = 0; nt < 8; ++nt) acc[nt] = MFMA16(af[ks], bq[ks][nt], acc[nt]);
#pragma unroll
        for (int nt = 0; nt < 8; ++nt)
#pragma unroll
            for (int j = 0; j < 4; ++j) SC[((q4 * 4 + j) * 16 + hp) * 129 + nt * 16 + r16] = acc[nt][j];
        __builtin_amdgcn_sched_barrier(0);
    }
    __syncthreads();
    if (tid < 256) { float T[16], Gv[16];
#define PK_LOAD16(A, g) _Pragma("unroll") for (int i_ = 0; i_ < 16; ++i_) A[i_] = __uint_as_float((__float_as_uint(SC[tid * 129 + (g) * 16 + i_]) & ~0x7Fu) | (unsigned)((g) * 16 + i_))
#define PK_CE(A, i_, l_) do { const float hi_ = fmaxf(A[i_], A[l_]), lo_ = fminf(A[i_], A[l_]); A[i_] = hi_; A[l_] = lo_; } while (0)
#define PK_SORT16(A) _Pragma("unroll") for (int k_ = 2; k_ <= 16; k_ <<= 1) _Pragma("unroll") for (int j_ = k_ >> 1; j_ > 0; j_ >>= 1) _Pragma("unroll") for (int i_ = 0; i_ < 16; ++i_) { const int l_ = i_ ^ j_; \
            if (l_ > i_) { if (((i_ & k_) == 0) || k_ == 16) PK_CE(A, i_, l_); else PK_CE(A, l_, i_); } }
#define PK_MERGE16(A) _Pragma("unroll") for (int j_ = 8; j_ > 0; j_ >>= 1) _Pragma("unroll") for (int i_ = 0; i_ < 16; ++i_) { const int l_ = i_ ^ j_; if (l_ > i_) PK_CE(A, i_, l_); }
        PK_LOAD16(T, 0); PK_SORT16(T);
#pragma unroll 1
        for (int g = 1; g < 8; ++g) { PK_LOAD16(Gv, g); PK_SORT16(Gv);
#pragma unroll
            for (int i_ = 0; i_ < 16; ++i_) T[i_] = fmaxf(T[i_], Gv[15 - i_]);
            PK_MERGE16(T); }
#pragma unroll
        for (int k = 0; k < 16; ++k) TOP[tid * 17 + k] = T[k]; }
    __syncthreads();
    if (tid < 128) { const int tok = tid >> 3, h = tid & 7; const LAS float* T1 = TOP + ((tok * 16 + 2 * h) * 17), *T2 = TOP + ((tok * 16 + 2 * h + 1) * 17);
        float s1[16], s2[16], L[16];
#pragma unroll
        for (int k = 0; k < 16; ++k) { s1[k] = T1[k]; s2[k] = T2[k]; L[k] = NEG_INF; }
#pragma unroll
        for (int aa = 0; aa < 16; ++aa)
#pragma unroll
            for (int bb = 0; bb < 16; ++bb) if ((aa + 1) * (bb + 1) <= 16) {
                float x = __uint_as_float((__float_as_uint(s1[aa] + s2[bb]) & ~0xFFu) | (unsigned)(aa * 16 + bb));
#pragma unroll
                for (int k = 0; k < 16; ++k) { const float hi = fmaxf(L[k], x); x = fminf(L[k], x); L[k] = hi; } }
        float e[16], se = 0.f;
#pragma unroll
        for (int k = 0; k < 16; ++k) { e[k] = __expf(L[k] - L[0]); se += e[k]; }
        const float inv = 1.0f / se;
#pragma unroll
        for (int k = 0; k < 16; ++k) { const unsigned id = __float_as_uint(L[k]) & 0xFFu; const int i1 = (int)(__float_as_uint(T1[id >> 4]) & 0x7Fu), i2 = (int)(__float_as_uint(T2[id & 15u]) & 0x7Fu);
            EXPI[tok * 128 + h * 16 + k] = i1 * 128 + i2; GATE[tok * 128 + h * 16 + k] = e[k] * inv; }
    }
    __syncthreads();
    const unsigned char* PU = a.ws + WS_PU; const unsigned char* PV = a.ws + WS_PV;
#pragma unroll 1
    for (int ti = 0; ti < 2; ++ti) { const int tt = 2 * w + ti, m = m0 + tt;
        bf16* zrow = (bf16*)(a.ws + WS_XN) + (size_t)m * 1024 + 16 * lane;
        unsigned zh[2], zl[2]; float uinv;
        { float zf[16]; { float t8[8]; unpack8(*(const v4u*)zrow, t8);
#pragma unroll
            for (int c = 0; c < 8; ++c) zf[c] = t8[c];
            unpack8(*(const v4u*)(zrow + 8), t8);
#pragma unroll
            for (int c = 0; c < 8; ++c) zf[8 + c] = t8[c]; }
          float am = 0.f;
#pragma unroll
          for (int c = 0; c < 16; ++c) am = fmaxf(am, fabsf(zf[c]));
          am = fmaxf(am, __shfl_xor(am, 1)); am = fmaxf(am, __shfl_xor(am, 2)); am = fmaxf(am, __shfl_xor(am, 4)); am = fmaxf(am, __shfl_xor(am, 8)); am = fmaxf(am, __shfl_xor(am, 16)); am = fmaxf(am, __shfl_xor(am, 32));
          am = fmaxf(am, 1e-20f);
          const float sz = 119.0f / am; uinv = am * (1.0f / (119.0f * PU_I4));
#pragma unroll
          for (int d = 0; d < 2; ++d) { unsigned wh = 0u, wl = 0u;
#pragma unroll
            for (int e = 0; e < 8; ++e) { const int z8 = (int)__builtin_rintf(zf[8 * d + e] * sz); const int lo = ((z8 + 8) & 15) - 8, hi = (z8 - lo) >> 4;
                wh |= ((unsigned)hi & 15u) << (4 * e); wl |= ((unsigned)lo & 15u) << (4 * e); }
            zh[d] = wh; zl[d] = wl; } }
        f32x2 acc[8];
#pragma unroll
        for (int d = 0; d < 8; ++d) acc[d] = (f32x2){0.f, 0.f};
#pragma unroll 1
        for (int e0 = 0; e0 < 128; e0 += 16) {
            v2u ur[16], vr[16];
#pragma unroll
            for (int k = 0; k < 16; ++k) { const int eid = __builtin_amdgcn_readfirstlane(EXPI[tt * 128 + e0 + k]);
                ur[k] = *(const v2u*)(PU + (size_t)eid * 512 + 8 * lane); vr[k] = *(const v2u*)(PV + (size_t)eid * 512 + 8 * lane); }
#pragma unroll
            for (int gq = 0; gq < 2; ++gq) {
            int x8[8];
#pragma unroll
            for (int k = 0; k < 8; ++k) { const int w0 = (int)ur[8 * gq + k][0], w1 = (int)ur[8 * gq + k][1];
                int hi = __builtin_amdgcn_sdot8(w0, (int)zh[0], 0, false); hi = __builtin_amdgcn_sdot8(w1, (int)zh[1], hi, false);
                int lo = __builtin_amdgcn_sdot8(w0, (int)zl[0], 0, false); lo = __builtin_amdgcn_sdot8(w1, (int)zl[1], lo, false);
                x8[k] = (hi << 4) + lo; }
#define DPPI(v, ctrl) __builtin_amdgcn_update_dpp(0, (v), (ctrl), 0xF, 0xF, true)
            float actv;
            { int y4[4], z2[2], u;
#pragma unroll
              for (int k = 0; k < 4; ++k) { const bool o = lane & 1; const int keep = o ? x8[2 * k + 1] : x8[2 * k], send = o ? x8[2 * k] : x8[2 * k + 1]; y4[k] = keep + DPPI(send, 0xB1); }
#pragma unroll
              for (int k = 0; k < 2; ++k) { const bool o = lane & 2; const int keep = o ? y4[2 * k + 1] : y4[2 * k], send = o ? y4[2 * k] : y4[2 * k + 1]; z2[k] = keep + DPPI(send, 0x4E); }
              { const bool o = lane & 4; const int keep = o ? z2[1] : z2[0], send = o ? z2[0] : z2[1]; const int fr_hi = DPPI(send, 0x104), fr_lo = DPPI(send, 0x114); u = keep + (o ? fr_lo : fr_hi); }
              u += DPPI(u, 0x128);
              { int ub; asm volatile("v_mov_b32_e32 %1, %0\n\ts_nop 1\n\tv_permlane16_swap_b32_e32 %0, %1" : "+v"(u), "=&v"(ub)); u += ub; }
              { int ub; asm volatile("v_mov_b32_e32 %1, %0\n\ts_nop 1\n\tv_permlane32_swap_b32_e32 %0, %1" : "+v"(u), "=&v"(ub)); u += ub; }
              actv = GATE[tt * 128 + e0 + 8 * gq + (lane & 7)] * gelu_erf((float)u * uinv) * (1.0f / PV_SCALE); }
#undef DPPI
#pragma unroll
            for (int k = 0; k < 8; ++k) { const float act = __builtin_bit_cast(float, __builtin_amdgcn_readlane(__builtin_bit_cast(int, actv), k));
#pragma unroll
                for (int d = 0; d < 2; ++d) { const unsigned wv = vr[8 * gq + k][d];
                    acc[4 * d] += __builtin_amdgcn_cvt_scalef32_pk_f32_fp4(wv, 1.0f, 0) * act; acc[4 * d + 1] += __builtin_amdgcn_cvt_scalef32_pk_f32_fp4(wv, 1.0f, 1) * act;
                    acc[4 * d + 2] += __builtin_amdgcn_cvt_scalef32_pk_f32_fp4(wv, 1.0f, 2) * act; acc[4 * d + 3] += __builtin_amdgcn_cvt_scalef32_pk_f32_fp4(wv, 1.0f, 3) * act; } }
            }
        }
        if ((DBG_ZERO >> 3) & 1) {
#pragma unroll
            for (int d = 0; d < 8; ++d) acc[d] = (f32x2){0.f, 0.f}; }
        float* xo = a.out + (size_t)m * 1024 + 16 * lane;
        f32x4 x0 = *(const f32x4*)(xo), x1 = *(const f32x4*)(xo + 4), x2 = *(const f32x4*)(xo + 8), x3 = *(const f32x4*)(xo + 12);
        x0 += (f32x4){acc[0].x, acc[0].y, acc[1].x, acc[1].y}; x1 += (f32x4){acc[2].x, acc[2].y, acc[3].x, acc[3].y}; x2 += (f32x4){acc[4].x, acc[4].y, acc[5].x, acc[5].y}; x3 += (f32x4){acc[6].x, acc[6].y, acc[7].x, acc[7].y};
        float ss = (x0.x * x0.x + x0.y * x0.y + x0.z * x0.z + x0.w * x0.w) + (x1.x * x1.x + x1.y * x1.y + x1.z * x1.z + x1.w * x1.w)
                 + (x2.x * x2.x + x2.y * x2.y + x2.z * x2.z + x2.w * x2.w) + (x3.x * x3.x + x3.y * x3.y + x3.z * x3.z + x3.w * x3.w);
        const float rs = rsqrtf(wave_sum(ss) * (1.f / D) + 1e-6f);
        if (dry) continue;
        const float* nw = ((l == LAYERS - 1) ? a.in[I_LNF] : a.in[I_LN1] + (l + 1) * D) + 16 * lane;
        const f32x4 w0 = *(const f32x4*)(nw), w1 = *(const f32x4*)(nw + 4), w2 = *(const f32x4*)(nw + 8), w3 = *(const f32x4*)(nw + 12);
        const f32x4 n0 = x0 * rs * w0, n1 = x1 * rs * w1, n2 = x2 * rs * w2, n3 = x3 * rs * w3;
        if (l == LAYERS - 1) {
            *(f32x4*)(xo) = n0; *(f32x4*)(xo + 4) = n1; *(f32x4*)(xo + 8) = n2; *(f32x4*)(xo + 12) = n3;
        } else {
            *(f32x4*)(xo) = x0; *(f32x4*)(xo + 4) = x1; *(f32x4*)(xo + 8) = x2; *(f32x4*)(xo + 12) = x3;
            v4u p; p.x = pk(n0.x, n0.y); p.y = pk(n0.z, n0.w); p.z = pk(n1.x, n1.y); p.w = pk(n1.z, n1.w); *(v4u*)(zrow) = p;
            p.x = pk(n2.x, n2.y); p.y = pk(n2.z, n2.w); p.z = pk(n3.x, n3.y); p.w = pk(n3.z, n3.w); *(v4u*)(zrow + 8) = p;
        }
    }
    __syncthreads();
}
DI void p_peer(const Args& a, int l, LAS unsigned char* lds, int tid) {
    for (int rep = 0; rep < REP_PEER; ++rep)
    for (int it = blockIdx.x; it < M / 16; it += gridDim.x) { int dflag = (rep + 1 < REP_PEER) ? 1 : 0; asm volatile("" : "+s"(dflag)); peer_item(a, l, it, lds, tid, dflag != 0); }
}

#ifndef MK_PER_PHASE
#define MK_PER_PHASE 0
#endif
#ifndef PH_MASK
#define PH_MASK 0x7FF
#endif
#define PHASE_ON(j) ((((PH_MASK) >> (j)) & 1) != 0)
constexpr int NPH = 1 + 10 * LAYERS;
__global__ void __launch_bounds__(NT, 2) fwd(Args a_unused) {
    typedef const __attribute__((address_space(4))) Args* KArgP;
    KArgP kap = (KArgP)__builtin_amdgcn_kernarg_segment_ptr();
    Args a; __builtin_memcpy(&a, kap, sizeof(Args));
    extern __shared__ __attribute__((aligned(16))) unsigned char lds_raw[];
    LAS unsigned char* lds = (LAS unsigned char*)lds_raw;
    const int tid0 = threadIdx.x;
#define tid tid0
    volatile LAS unsigned* MISC = (volatile LAS unsigned*)(lds + MISC_OFF);
    if (tid < 64) MISC[tid] = 0u;
    __syncthreads();
    unsigned* ctl = (unsigned*)(a.ws + WS_CTL);
    XcdBarrier bar = xcd_barrier_post(ctl + CW_BAR, MISC + 8);
    const int lo = a.ph_lo, hi = a.ph_hi;
#define IN(k) (lo <= (k) && (k) < hi)
#define SEAM(k) do { if (IN(k) && IN((k) + 1)) xcd_barrier(bar); } while (0)
    unsigned char* ws = a.ws;
#undef tid
#define LAUNDER_ARGS Args a; { KArgP p_ = kap; asm volatile("" : "+s"(p_)); __builtin_memcpy(&a, p_, sizeof(Args)); } unsigned char* ws = a.ws; const float* xin = (l == 0) ? a.in[I_X] : a.out
#define LAUNDER_TID int tid = tid0; asm volatile("" : "+v"(tid)); Args a; { KArgP p_ = kap; asm volatile("" : "+s"(p_)); __builtin_memcpy(&a, p_, sizeof(Args)); }
    if (PHASE_ON(10) && IN(0)) { LAUNDER_TID; for (int rep = 0; rep < REP_PRO; ++rep) p_prologue(a, lds, tid);
        p_rms(a.in[I_X], a.in[I_LN1], (bf16*)(ws + WS_XN), tid);
        if (IN(0) && IN(2)) xcd_barrier(bar); }
    for (int l = 0; l < LAYERS; ++l) {
        const int pb = 1 + 10 * l;
        const float* xin = (l == 0) ? a.in[I_X] : a.out;
        if (PHASE_ON(1) && IN(pb + 1)) { LAUNDER_ARGS;
            pg8::Gemm g{(const bf16*)(ws + WS_XN), (const bf16*)(ws + WS_WIN) + (size_t)l * NP * 1024, M, NP, 1024}; pg8::StaticOrder S; S.init(M, NP, gridDim.x, blockIdx.x);
            pg8::EpiBf16P E{(bf16*)(ws + WS_PROJ), NP, KV_TILE_MASK, (bf16*)(ws + WS_KV0), (bf16*)(ws + WS_KV1)};
            for (int rep = 0; rep < REP_WIN; ++rep) pg8::gemm_phase<pg8::EpiBf16P, pg8::StaticOrder, true, true>(lds, g, S, E);
            SEAM(pb + 1); }
        if (PHASE_ON(2) && IN(pb + 2)) { LAUNDER_TID; p_prep(a, l, lds, tid); SEAM(pb + 2); }
        if (PHASE_ON(3) && IN(pb + 3)) { LAUNDER_TID; p_mix(a, l, lds, tid); SEAM(pb + 3); }
        if (PHASE_ON(4) && IN(pb + 4)) { LAUNDER_TID; p_post(a, l, tid); SEAM(pb + 4); }
        if (PHASE_ON(5) && IN(pb + 5)) { LAUNDER_ARGS;
            pg8::StaticOrder S; S.init(M, 1024, gridDim.x, blockIdx.x);
            const bf16* Gp = (const bf16*)(ws + WS_PROJ) + C_GA; bf16* MG = (bf16*)(ws + WS_XN); const bf16* WB = (const bf16*)(ws + WS_WBR) + (size_t)l * 3 * 1024 * 512;
#pragma unroll 1
            for (int br3 = 0; br3 < 3 * REP_MERGE; ++br3) { const int br = br3 % 3;
                pg8::Gemm g{(const bf16*)(ws + WS_OA + (size_t)br * (WS_OB - WS_OA)), WB + (size_t)br * 1024 * 512, M, 1024, 512}; pg8::EpiMerge E{Gp + br * 1024, NP, MG, br, ((DBG_ZERO >> br) & 1) ? 0.f : 1.f};
                pg8::gemm_phase<pg8::EpiMerge, pg8::StaticOrder, true, true>(lds, g, S, E); }
            SEAM(pb + 5); }
        if (PHASE_ON(6) && IN(pb + 6)) { LAUNDER_ARGS;
            pg8::Gemm g{(const bf16*)(ws + WS_XN), (const bf16*)(ws + WS_WOUT) + (size_t)l * 1024 * 1024, M, 1024, 1024}; pg8::StaticOrder S; S.init(M, 1024, gridDim.x, blockIdx.x);
            pg8::EpiResid E{xin, a.out};
            pg8::gemm_phase<pg8::EpiResid, pg8::StaticOrder, true, true>(lds, g, S, E);
            SEAM(pb + 6); }
        if (PHASE_ON(7) && IN(pb + 7)) { LAUNDER_TID; for (int rep = 0; rep < REP_NORM2; ++rep) p_norm2(a, l, tid); SEAM(pb + 7); }
        if (PHASE_ON(8) && IN(pb + 8)) { LAUNDER_ARGS;
            pg8::Gemm g{(const bf16*)(ws + WS_XN), (const bf16*)(ws + WS_WQ) + (size_t)l * 2048 * 1024, M, 2048, 1024}; pg8::StaticOrder S; S.init(M, 2048, gridDim.x, blockIdx.x);
            pg8::EpiBf16P E{(bf16*)(ws + WS_PQ), 2048, 0u, nullptr, nullptr};
            for (int rep = 0; rep < REP_PQ; ++rep) pg8::gemm_phase<pg8::EpiBf16P, pg8::StaticOrder, true, true>(lds, g, S, E);
            SEAM(pb + 8); }
        if (PHASE_ON(9) && IN(pb + 9)) { LAUNDER_TID; p_peer(a, l, lds, tid); if (l + 1 < LAYERS) { if (IN(pb + 9) && IN(pb + 11)) xcd_barrier(bar); } }
    }
#undef IN
#undef SEAM
}

extern "C" void kernel_launch(void* const* d_in, const int* in_sizes, int n_in, void* d_out, int out_size, void* d_ws, size_t ws_size, hipStream_t stream) {
    static int grid = 0;
    if (grid == 0) {
        if (n_in != 32 || in_sizes[0] != M * D || out_size != M * D || ws_size < WS_END) { fprintf(stderr, "kernel_launch: unexpected problem shape / workspace (%d inputs, ws %zu)\n", n_in, ws_size); grid = -1; return; }
        int dev = 0, cus = 0, per_cu = 0;
        if (hipGetDevice(&dev) != hipSuccess || hipDeviceGetAttribute(&cus, hipDeviceAttributeMultiprocessorCount, dev) != hipSuccess) { grid = -1; return; }
        if (hipFuncSetAttribute((const void*)fwd, hipFuncAttributeMaxDynamicSharedMemorySize, LDS_BYTES) != hipSuccess) { fprintf(stderr, "kernel_launch: hipFuncSetAttribute failed\n"); grid = -1; return; }
        if (hipOccupancyMaxActiveBlocksPerMultiprocessor(&per_cu, (const void*)fwd, NT, LDS_BYTES) != hipSuccess || per_cu < 1) { fprintf(stderr, "kernel_launch: occupancy query says %d\n", per_cu); (void)hipGetLastError(); }
        grid = cus;
    }
    if (grid < 0) return;
    (void)hipMemsetAsync((char*)d_ws + WS_CTL, 0, CTL_ZERO_BYTES, stream);
    Args a{};
    for (int i = 0; i < 32; ++i) a.in[i] = (const float*)d_in[i];
    a.out = (float*)d_out; a.ws = (unsigned char*)d_ws;
#if MK_PER_PHASE
    for (int p = 0; p < NPH; ++p) { if (p == 1 || p == 11) continue; a.ph_lo = p; a.ph_hi = p + 1; hipLaunchKernelGGL(fwd, dim3(grid), dim3(NT), LDS_BYTES, stream, a); }
#else
    a.ph_lo = 0; a.ph_hi = NPH;
    hipLaunchKernelGGL(fwd, dim3(grid), dim3(NT), LDS_BYTES, stream, a);
#endif
}
```

```cpp
#include <hip/hip_runtime.h>
#include <cstdio>
#include <cstdint>
#define DI __device__ __forceinline__
#define GAS __attribute__((address_space(1)))
#define LAS __attribute__((address_space(3)))
typedef unsigned short bf16;
typedef unsigned v4u __attribute__((ext_vector_type(4)));
typedef unsigned v2u __attribute__((ext_vector_type(2)));
typedef float f32x2 __attribute__((ext_vector_type(2)));
typedef float f32x4 __attribute__((ext_vector_type(4)));
typedef float f32x16 __attribute__((ext_vector_type(16)));
typedef short bf16x8 __attribute__((ext_vector_type(8)));
typedef short s16x4 __attribute__((ext_vector_type(4)));
typedef __bf16 bfx2 __attribute__((ext_vector_type(2)));
struct U3 { unsigned a, b, c; };

namespace pg8 {
#define PG8_LAS __attribute__((address_space(3)))
typedef unsigned short bf16_t;
typedef short bf16x8 __attribute__((ext_vector_type(8)));
typedef float f32x4 __attribute__((ext_vector_type(4)));
typedef unsigned u32x4 __attribute__((ext_vector_type(4)));
constexpr int BM = 256, BK = 64, HALF = 128, HTB = HALF * BK * 2  , STAGE_BYTES = 8 * HTB, NXCD = 8, WGM = 8;

__host__ __device__ __forceinline__ int lds_byte(int r, int c) { const int st = (r >> 4) * 2 + (c >> 5), rr = r & 15, cc = c & 31, ob = rr * 64 + cc * 2; return st * 1024 + (ob ^ (((ob >> 9) & 1) << 5)); }
__host__ __device__ __forceinline__ void stage_rc(int b, int& R, int& C) { const int st = b / 1024, sb = b % 1024, swz = sb ^ (((sb >> 9) & 1) << 5); R = (st >> 1) * 16 + swz / 64; C = (st & 1) * 32 + (swz % 64) / 2; }
__host__ __device__ __forceinline__ int perm32(int rho) { const int n = rho >> 4, i = rho & 15; return 8 * (i >> 2) + 4 * n + (i & 3); }

struct Unit { int pm, pn; };
struct Gemm { const bf16_t* A; const bf16_t* Bt; int M, N, K; };

struct StaticOrder {
    int nM, nN, nwg, G, c;
    __host__ __device__ void init(int M, int N, int G_, int c_) { nM = M / BM; nN = N / BM; nwg = nM * nN; G = G_; c = c_; }
    __host__ __device__ bool next(int i, Unit& u) const {
        const long L = (long)i * G + c; if (L >= nwg) return false;
        int wgid = (int)L; { const int q = nwg / NXCD, r = nwg % NXCD, xcd = wgid % NXCD, off = wgid / NXCD; wgid = (xcd < r ? xcd * (q + 1) : r * (q + 1) + (xcd - r) * q) + off; }
        const int nig = WGM * nN, gid = wgid / nig, fm = gid * WGM, gsz = (nM - fm) < WGM ? (nM - fm) : WGM;
        u.pm = fm + ((wgid % nig) % gsz); u.pn = (wgid % nig) / gsz; return true;
    }
    __device__ __forceinline__ void a_ready(const Unit&) const {}
    __device__ __forceinline__ void done(const Unit&) const {}
};

__device__ __forceinline__ unsigned cvt_pk_bf16(float lo, float hi) { unsigned r; asm volatile("v_cvt_pk_bf16_f32 %0, %1, %2" : "=v"(r) : "v"(lo), "v"(hi)); return r; }
typedef float f32x2 __attribute__((ext_vector_type(2)));
__device__ __forceinline__ f32x2 gelu_pk(f32x2 v) {
    const f32x2 av = __builtin_elementwise_abs(v), d = av * 0.2316418882f + 1.0f;
    f32x2 t; t.x = __builtin_amdgcn_rcpf(d.x); t.y = __builtin_amdgcn_rcpf(d.y);
    f32x2 q = t * 0.5307027145f + (-0.7265760135f); q = q * t + 0.7107068705f; q = q * t + (-0.142248368f); q = q * t + 0.127414796f; q = q * t;
    const f32x2 s = (v * v) * (-0.72134752044f);
    f32x2 e; e.x = __builtin_amdgcn_exp2f(s.x); e.y = __builtin_amdgcn_exp2f(s.y);
    const f32x2 m = v * (q * e), r = v - m;
    f32x2 o; o.x = v.x < 0.f ? m.x : r.x; o.y = v.y < 0.f ? m.y : r.y; return o;
}

__device__ __forceinline__ float sigm(float x) { return __builtin_amdgcn_rcpf(1.0f + __expf(-x)); }
struct EpiBf16P {
    static constexpr bool PERM = true, AFTER_DRAIN = false;
    bf16_t* O; int ldc; unsigned kvmask; bf16_t* KV0; bf16_t* KV1;
    __device__ __forceinline__ void operator()(const f32x4 (&acc)[2][2][4][2], const Unit& u, int wr, int wc, int fr, int fq) const {
        const int row0 = u.pm * BM + wr * 64 + fr; int col0 = u.pn * BM + wc * 32 + 8 * fq, ld = ldc; bf16_t* base = O;
        if ((kvmask >> u.pn) & 1u) { const int slot = __builtin_popcount(kvmask & ((1u << u.pn) - 1u)); base = (slot < 2 ? KV0 : KV1) + (size_t)(slot & 1) * 16384 * 256; ld = 256; col0 = wc * 32 + 8 * fq; }
#pragma unroll
        for (int ai = 0; ai < 2; ++ai)
#pragma unroll
            for (int m = 0; m < 4; ++m) { bf16_t* rowp = base + (size_t)(row0 + ai * HALF + m * 16) * ld + col0;
#pragma unroll
                for (int bj = 0; bj < 2; ++bj) { const f32x4 v0 = acc[ai][bj][m][0], v1 = acc[ai][bj][m][1];
                    u32x4 w; w.x = cvt_pk_bf16(v0[0], v0[1]); w.y = cvt_pk_bf16(v0[2], v0[3]); w.z = cvt_pk_bf16(v1[0], v1[1]); w.w = cvt_pk_bf16(v1[2], v1[3]);
                    *(u32x4*)(rowp + bj * HALF) = w; } }
    }
};
struct EpiMerge {
    static constexpr bool PERM = true, AFTER_DRAIN = false;
    const bf16_t* G; int ldg; bf16_t* O; int accum; float bscale;
    __device__ __forceinline__ void operator()(const f32x4 (&acc)[2][2][4][2], const Unit& u, int wr, int wc, int fr, int fq) const {
        const int row0 = u.pm * BM + wr * 64 + fr, col0 = u.pn * BM + wc * 32 + 8 * fq;
#pragma unroll
        for (int ai = 0; ai < 2; ++ai)
#pragma unroll
            for (int m = 0; m < 4; ++m) { int rowi = row0 + ai * HALF + m * 16; asm volatile("" : "+v"(rowi)); const size_t row = (size_t)rowi;
#pragma unroll
                for (int bj = 0; bj < 2; ++bj) {
                    const u32x4 g = *(const u32x4*)(G + row * ldg + col0 + bj * HALF);
                    u32x4 p = (u32x4){0u, 0u, 0u, 0u}; if (accum) p = *(const u32x4*)(O + row * 1024 + col0 + bj * HALF);
                    float o[8];
#pragma unroll
                    for (int e = 0; e < 4; ++e) {
                        const float g0 = __uint_as_float(g[e] << 16), g1 = __uint_as_float(g[e] & 0xffff0000u);
                        const float p0 = __uint_as_float(p[e] << 16), p1 = __uint_as_float(p[e] & 0xffff0000u);
                        const float a0 = acc[ai][bj][m][e >> 1][(e & 1) * 2], a1 = acc[ai][bj][m][e >> 1][(e & 1) * 2 + 1];
                        o[2 * e] = p0 + sigm(g0) * a0 * bscale; o[2 * e + 1] = p1 + sigm(g1) * a1 * bscale; }
                    u32x4 w; w.x = cvt_pk_bf16(o[0], o[1]); w.y = cvt_pk_bf16(o[2], o[3]); w.z = cvt_pk_bf16(o[4], o[5]); w.w = cvt_pk_bf16(o[6], o[7]);
                    *(u32x4*)(O + row * 1024 + col0 + bj * HALF) = w; }
                asm volatile("" ::: "memory"); }
    }
};
struct EpiResid {
    static constexpr bool PERM = false, AFTER_DRAIN = false;
    const float* X; float* O;
    __device__ __forceinline__ void operator()(const f32x4 (&acc)[2][2][4][2], const Unit& u, int wr, int wc, int fr, int fq) const {
        const int row0 = u.pm * BM + wr * 64 + fr, col0 = u.pn * BM + wc * 32 + 4 * fq;
#pragma unroll
        for (int ai = 0; ai < 2; ++ai) { f32x4 xv[4][2][2];
#pragma unroll
            for (int m = 0; m < 4; ++m) { const size_t off = (size_t)(row0 + ai * HALF + m * 16) * 1024 + col0;
#pragma unroll
                for (int bj = 0; bj < 2; ++bj)
#pragma unroll
                    for (int n = 0; n < 2; ++n) xv[m][bj][n] = *(const f32x4*)(X + off + bj * HALF + n * 16); }
            __builtin_amdgcn_sched_barrier(0);
#pragma unroll
            for (int m = 0; m < 4; ++m) { const size_t off = (size_t)(row0 + ai * HALF + m * 16) * 1024 + col0;
#pragma unroll
                for (int bj = 0; bj < 2; ++bj)
#pragma unroll
                    for (int n = 0; n < 2; ++n) *(f32x4*)(O + off + bj * HALF + n * 16) = xv[m][bj][n] + acc[ai][bj][m][n]; }
            __builtin_amdgcn_sched_barrier(0); }
    }
};
template <class Epi, class Sched, bool ALIGN_EPI = false, bool SP2 = false>
__device__ __forceinline__ void gemm_phase(PG8_LAS unsigned char* lds, const Gemm g, const Sched& S, const Epi& E) {
    int tid_ = threadIdx.x; asm volatile("" : "+v"(tid_));
    const int tid = tid_, wid = __builtin_amdgcn_readfirstlane(tid >> 6), lane = tid & 63, wr = wid >> 2, wc = wid & 3, fr = lane & 15, fq = lane >> 4;
    const int K = g.K, nt = K / BK;
    unsigned voffA[2], voffB[2];
#pragma unroll
    for (int i = 0; i < 2; ++i) { int R, C; stage_rc(tid * 16 + i * 8192, R, C); const int Rb = Epi::PERM ? ((R & ~31) + perm32(R & 31)) : R;
        voffA[i] = (unsigned)(R * K + C) * 2u; voffB[i] = (unsigned)(Rb * K + C) * 2u; }
    const size_t kstep = (size_t)(BK * 2);
    const size_t hstep = (size_t)HALF * K * 2;
    const size_t tstep = 2 * hstep;
    const unsigned ldsw = (unsigned)wid * 1024u;
    const int aoff = lds_byte(wr * 64 + fr, fq * 8), boff = lds_byte(wc * 32 + fr, fq * 8);
#define PG8_SA(b, h) (((b) * 2 + (h)) * HTB)
#define PG8_SB(b, h) ((4 + (b) * 2 + (h)) * HTB)
#define PG8_STAGE(bufoff, gbase, voff) do { _Pragma("unroll") for (int _i = 0; _i < 2; ++_i) \
        __builtin_amdgcn_global_load_lds((const unsigned*)((const char*)(gbase) + (voff)[_i]), (PG8_LAS unsigned*)(lds + (bufoff) + ldsw + _i * 8192), 16, 0, 0); } while (0)
#define PG8_LDA(dst, b, h) do { _Pragma("unroll") for (int m = 0; m < 4; ++m) _Pragma("unroll") for (int k = 0; k < 2; ++k) dst[m][k] = *(const PG8_LAS bf16x8*)(lds + PG8_SA(b, h) + aoff + m * 2048 + k * 1024); } while (0)
#define PG8_LDB(dst, b, h) do { _Pragma("unroll") for (int n = 0; n < 2; ++n) _Pragma("unroll") for (int k = 0; k < 2; ++k) dst[n][k] = *(const PG8_LAS bf16x8*)(lds + PG8_SB(b, h) + boff + n * 2048 + k * 1024); } while (0)
#define PG8_MMA(ai, bj, At, Bt) do { __builtin_amdgcn_s_setprio(1); _Pragma("unroll") for (int m = 0; m < 4; ++m) _Pragma("unroll") for (int n = 0; n < 2; ++n) _Pragma("unroll") for (int k = 0; k < 2; ++k) \
        acc[ai][bj][m][n] = __builtin_amdgcn_mfma_f32_16x16x32_bf16(Bt[n][k], At[m][k], acc[ai][bj][m][n], 0, 0, 0); __builtin_amdgcn_s_setprio(0); } while (0)
#define PG8_WAIT_V(n) asm volatile("s_waitcnt vmcnt(" #n ")" ::: "memory")
#define PG8_WAIT_L(n) asm volatile("s_waitcnt lgkmcnt(" #n ")" ::: "memory")
#define PG8_BAR __builtin_amdgcn_s_barrier()
#define PG8_SCHED __builtin_amdgcn_sched_barrier(0)
    Unit cur, nxt; int ui = 0;
    if (!S.next(0, cur)) return;
    f32x4 acc[2][2][4][2];
#pragma unroll
    for (int a = 0; a < 2; ++a)
#pragma unroll
        for (int b = 0; b < 2; ++b)
#pragma unroll
            for (int m = 0; m < 4; ++m)
#pragma unroll
                for (int n = 0; n < 2; ++n) acc[a][b][m][n] = (f32x4){0.f, 0.f, 0.f, 0.f};
    bf16x8 At[4][2], B0[2][2], B1[2][2];
    const char* cA = (const char*)g.A + (size_t)cur.pm * tstep; const char* cB = (const char*)g.Bt + (size_t)cur.pn * tstep;
    S.a_ready(cur);
    if constexpr (SP2) {
        PG8_STAGE(PG8_SB(0, 0), cB, voffB); PG8_STAGE(PG8_SB(0, 1), cB + hstep, voffB); PG8_STAGE(PG8_SA(0, 0), cA, voffA); PG8_STAGE(PG8_SA(0, 1), cA + hstep, voffA);
        if (wr == 1) PG8_BAR;
        PG8_WAIT_V(2); PG8_BAR;
        PG8_STAGE(PG8_SB(1, 0), cB + kstep, voffB); PG8_STAGE(PG8_SA(1, 0), cA + kstep, voffA); PG8_STAGE(PG8_SB(1, 1), cB + hstep + kstep, voffB);
        PG8_WAIT_V(6); PG8_BAR;
    } else {
        PG8_STAGE(PG8_SB(0, 0), cB, voffB); PG8_STAGE(PG8_SA(0, 0), cA, voffA); PG8_STAGE(PG8_SB(0, 1), cB + hstep, voffB); PG8_STAGE(PG8_SA(0, 1), cA + hstep, voffA);
        if (wr == 1) PG8_BAR;
        PG8_WAIT_V(4); PG8_BAR;
        PG8_STAGE(PG8_SB(1, 0), cB + kstep, voffB); PG8_STAGE(PG8_SA(1, 0), cA + kstep, voffA); PG8_STAGE(PG8_SB(1, 1), cB + hstep + kstep, voffB);
        PG8_WAIT_V(6); PG8_BAR;
    }
    for (;;) {
        const bool has_next = S.next(ui + 1, nxt);
        const char* nA = has_next ? (const char*)g.A + (size_t)nxt.pm * tstep : cA; const char* nB = has_next ? (const char*)g.Bt + (size_t)nxt.pn * tstep : cB;
        for (int t = 0; t < nt; t += 2) {
            const bool last = (t == nt - 2);
            const char* a1 = cA + (size_t)(t + 1) * kstep;
            const char* a2 = last ? nA : cA + (size_t)(t + 2) * kstep; const char* b2 = last ? nB : cB + (size_t)(t + 2) * kstep;
            const char* a3 = a2 + kstep; const char* b3 = b2 + kstep;
            if (last && has_next) S.a_ready(nxt);
            if constexpr (SP2) {
            PG8_LDB(B0, 0, 0); PG8_LDB(B1, 0, 1); PG8_SCHED; PG8_LDA(At, 0, 0); PG8_STAGE(PG8_SA(1, 1), a1 + hstep, voffA);
            PG8_WAIT_V(8); PG8_WAIT_L(0); PG8_BAR; PG8_MMA(0, 0, At, B0); PG8_MMA(0, 1, At, B1); PG8_BAR; PG8_SCHED;
            PG8_LDA(At, 0, 1); PG8_STAGE(PG8_SB(0, 0), b2, voffB); PG8_STAGE(PG8_SB(0, 1), b2 + hstep, voffB); PG8_STAGE(PG8_SA(0, 0), a2, voffA);
            PG8_WAIT_V(8); PG8_WAIT_L(0); PG8_BAR; PG8_MMA(1, 0, At, B0); PG8_MMA(1, 1, At, B1); PG8_BAR; PG8_SCHED;
            PG8_LDB(B0, 1, 0); PG8_LDB(B1, 1, 1); PG8_SCHED; PG8_LDA(At, 1, 0); PG8_STAGE(PG8_SA(0, 1), a2 + hstep, voffA);
            PG8_WAIT_V(8); PG8_WAIT_L(0); PG8_BAR; PG8_MMA(0, 0, At, B0); PG8_MMA(0, 1, At, B1); PG8_BAR; PG8_SCHED;
            PG8_LDA(At, 1, 1); PG8_STAGE(PG8_SB(1, 0), b3, voffB); PG8_STAGE(PG8_SB(1, 1), b3 + hstep, voffB); PG8_STAGE(PG8_SA(1, 0), a3, voffA);
            PG8_WAIT_V(8); PG8_WAIT_L(0); PG8_BAR; PG8_MMA(1, 0, At, B0); PG8_MMA(1, 1, At, B1); PG8_BAR; PG8_SCHED;
            } else {
            PG8_LDB(B0, 0, 0); PG8_SCHED; PG8_LDA(At, 0, 0); PG8_STAGE(PG8_SA(1, 1), a1 + hstep, voffA);
            PG8_WAIT_L(8); PG8_BAR; PG8_WAIT_L(0); PG8_MMA(0, 0, At, B0); PG8_BAR; PG8_SCHED;
            PG8_LDB(B1, 0, 1); PG8_STAGE(PG8_SB(0, 0), b2, voffB);
            PG8_BAR; PG8_WAIT_L(0); PG8_MMA(0, 1, At, B1); PG8_BAR;
            PG8_LDA(At, 0, 1); PG8_STAGE(PG8_SA(0, 0), a2, voffA);
            PG8_BAR; PG8_WAIT_L(0); PG8_MMA(1, 0, At, B0); PG8_BAR; PG8_SCHED;
            PG8_STAGE(PG8_SB(0, 1), b2 + hstep, voffB);
            PG8_WAIT_V(6); PG8_BAR; PG8_MMA(1, 1, At, B1); PG8_BAR;
            PG8_LDB(B0, 1, 0); PG8_SCHED; PG8_LDA(At, 1, 0); PG8_STAGE(PG8_SA(0, 1), a2 + hstep, voffA);
            PG8_WAIT_L(8); PG8_BAR; PG8_WAIT_L(0); PG8_MMA(0, 0, At, B0); PG8_BAR; PG8_SCHED;
            PG8_LDB(B1, 1, 1); PG8_STAGE(PG8_SB(1, 0), b3, voffB);
            PG8_BAR; PG8_WAIT_L(0); PG8_MMA(0, 1, At, B1); PG8_BAR;
            PG8_LDA(At, 1, 1); PG8_STAGE(PG8_SA(1, 0), a3, voffA);
            PG8_BAR; PG8_WAIT_L(0); PG8_MMA(1, 0, At, B0); PG8_BAR; PG8_SCHED;
            PG8_STAGE(PG8_SB(1, 1), b3 + hstep, voffB);
            PG8_WAIT_V(6); PG8_BAR; PG8_MMA(1, 1, At, B1); PG8_BAR;
            }
        }
        if constexpr (ALIGN_EPI) { if (wr == 0) PG8_BAR; }
        if constexpr (!Epi::AFTER_DRAIN) { E(acc, cur, wr, wc, fr, fq); S.done(cur); }
        if (!has_next) break;
#pragma unroll
        for (int a = 0; a < 2; ++a)
#pragma unroll
            for (int b = 0; b < 2; ++b)
#pragma unroll
                for (int m = 0; m < 4; ++m)
#pragma unroll
                    for (int n = 0; n < 2; ++n) acc[a][b][m][n] = (f32x4){0.f, 0.f, 0.f, 0.f};
        cur = nxt; cA = nA; cB = nB; ++ui;
        if constexpr (ALIGN_EPI) { if (wr == 1) PG8_BAR; }
    }
    PG8_WAIT_V(0);
    if constexpr (!ALIGN_EPI) { if (wr == 0) PG8_BAR; }
    PG8_BAR;
    if constexpr (Epi::AFTER_DRAIN) { E.fused(acc, cur, wr, wc, fr, fq, lds, wid, lane); S.done(cur); }
#undef PG8_SA
#undef PG8_SB
#undef PG8_STAGE
#undef PG8_LDA
#undef PG8_LDB
#undef PG8_MMA
#undef PG8_WAIT_V
#undef PG8_WAIT_L
#undef PG8_BAR
#undef PG8_SCHED
}
}

#ifndef REP_PREP
#define REP_PREP 1
#endif
#ifndef REP_SCAN
#define REP_SCAN 1
#endif
#ifndef REP_NSA
#define REP_NSA 1
#endif
#ifndef REP_SWA
#define REP_SWA 1
#endif
#ifndef REP_PRO
#define REP_PRO 1
#endif
#ifndef REP_NORM2
#define REP_NORM2 1
#endif
#ifndef REP_WIN
#define REP_WIN 1
#endif
#ifndef REP_MERGE
#define REP_MERGE 1
#endif
#ifndef REP_PQ
#define REP_PQ 1
#endif
#ifndef REP_PEER
#define REP_PEER 1
#endif
#ifndef REP_PREP_C
#define REP_PREP_C 1
#endif
#ifndef REP_PREP_R
#define REP_PREP_R 1
#endif
#ifndef PROBE_CVT
#define PROBE_CVT 0
#endif
#ifndef GEMM_STAGGER_NS
#define GEMM_STAGGER_NS 0
#endif
#ifndef PROBE_DELAY_SCAN_US
#define PROBE_DELAY_SCAN_US 0
#endif
#ifndef PROBE_DELAY_ATTN_US
#define PROBE_DELAY_ATTN_US 0
#endif
#define DBG_ZERO 0
constexpr int NWAVES = 8, NT = 512;
constexpr int BATCH = 2, SEQ = 8192, D = 1024, M = BATCH * SEQ, LAYERS = 2;
constexpr int NP = 7168;
constexpr int C_R = 0, C_K = 512, C_V = 1024, C_W = 1536, C_A = 1600, C_G = 1664;
constexpr int C_NQ = 1792, C_NKC = 2304, C_NVC = 2432, C_NKS = 2560, C_NVS = 2688, C_NKW = 2816, C_NVW = 2944, C_NG = 3072;
constexpr int PAD_A = 3096, PAD_B = 3328;
constexpr int C_SQ = 3328, C_SK = 3840, C_SV = 3968, C_GA = 4096;
constexpr float PU_SCALE = 64.f, PV_SCALE = 11.f;
constexpr float LOG2E = 1.4426950408889634f;
constexpr float NEG_INF = -__builtin_huge_valf();

constexpr size_t MiB = 1u << 20, KiB = 1u << 10;
constexpr size_t WS_CTL = 0, CTL_ZERO_BYTES = 1 * MiB;
constexpr size_t WS_WIN = 1 * MiB;
constexpr size_t WS_WBR = 29 * MiB;
constexpr size_t WS_WOUT = 35 * MiB;
constexpr size_t WS_WQ = 39 * MiB;
constexpr size_t WS_SK = 47 * MiB;
constexpr size_t WS_CW1 = 48 * MiB;
constexpr size_t WS_CW2 = 52 * MiB;
constexpr size_t WS_RW = 52 * MiB + 256 * KiB;
constexpr size_t WS_PROJ = 54 * MiB;
constexpr size_t WS_XN = 278 * MiB;
constexpr size_t WS_OA = 310 * MiB, WS_OB = 326 * MiB, WS_OC = 342 * MiB;
constexpr size_t WS_REC = 358 * MiB;
constexpr size_t WS_G = 472 * MiB;
constexpr size_t WS_BON = 470 * MiB;
constexpr size_t WS_KCMP = 471 * MiB, WS_VCMP = 471 * MiB + 256 * KiB;
constexpr size_t WS_PU = 358 * MiB, WS_PV = 374 * MiB;
constexpr size_t WS_PQ = WS_PROJ;
constexpr size_t WS_SLIST = WS_PROJ + 64 * MiB;
constexpr size_t WS_KV0 = 454 * MiB, WS_KV1 = 490 * MiB;
constexpr unsigned KV_TILE_MASK = (1u << 9) | (1u << 10) | (1u << 11) | (1u << 15);
constexpr size_t WS_END = 506 * MiB;
constexpr int CW_BAR = 4096;
constexpr int CW_RT = 12288;

constexpr int LDS_BYTES = 155648;
constexpr int MISC_OFF = LDS_BYTES - 256;

DI float bflo(unsigned u) { return __uint_as_float(u << 16); }
DI float bfhi(unsigned u) { return __uint_as_float(u & 0xffff0000u); }
DI void spin_ns(int ns) { const unsigned long long t0_ = wall_clock64(); while ((wall_clock64() - t0_) * 10ull < (unsigned long long)ns) __builtin_amdgcn_s_sleep(2); }
DI void spin_us(int us) { const unsigned long long t0_ = wall_clock64(); while (wall_clock64() - t0_ < (unsigned long long)us * 100ull) __builtin_amdgcn_s_sleep(8); }
DI unsigned pk(float a, float b) { f32x2 v = {a, b}; return __builtin_bit_cast(unsigned, __builtin_convertvector(v, bfx2)); }
DI float sigm(float x) { return __builtin_amdgcn_rcpf(1.0f + __expf(-x)); }
DI float gelu_erf(float x) { return 0.5f * x * (1.0f + erff(x * 0.70710678118654752f)); }
DI float dpp_f(float v, const int ctrl_unused) { return v; }
#define DPPQ(v, ctrl) __builtin_bit_cast(float, __builtin_amdgcn_update_dpp(0, __builtin_bit_cast(int, (v)), (ctrl), 0xF, 0xF, true))
#define DPP_ADD(v, ctrl) ((v) + __builtin_bit_cast(float, __builtin_amdgcn_update_dpp(0, __builtin_bit_cast(int, (v)), (ctrl), 0xF, 0xF, true)))
DI float row16_sum(float v) {
    v = DPP_ADD(v, 0xB1); v = DPP_ADD(v, 0x4E); v = DPP_ADD(v, 0x141); v = DPP_ADD(v, 0x140); return v; }
DI float oct_sum(float v) {
    v = DPP_ADD(v, 0xB1); v = DPP_ADD(v, 0x4E); v = DPP_ADD(v, 0x141); return v; }
DI float wave_sum(float v) {
    v = row16_sum(v);
    const float a = __builtin_bit_cast(float, __builtin_amdgcn_readlane(__builtin_bit_cast(int, v), 0));
    const float b = __builtin_bit_cast(float, __builtin_amdgcn_readlane(__builtin_bit_cast(int, v), 16));
    const float c = __builtin_bit_cast(float, __builtin_amdgcn_readlane(__builtin_bit_cast(int, v), 32));
    const float d = __builtin_bit_cast(float, __builtin_amdgcn_readlane(__builtin_bit_cast(int, v), 48));
    return (a + b) + (c + d); }
DI float wave_max(float v) {
    v = fmaxf(v, DPPQ(v, 0xB1)); v = fmaxf(v, DPPQ(v, 0x4E)); v = fmaxf(v, DPPQ(v, 0x141)); v = fmaxf(v, DPPQ(v, 0x140));
    const float a = __builtin_bit_cast(float, __builtin_amdgcn_readlane(__builtin_bit_cast(int, v), 0));
    const float b = __builtin_bit_cast(float, __builtin_amdgcn_readlane(__builtin_bit_cast(int, v), 16));
    const float c = __builtin_bit_cast(float, __builtin_amdgcn_readlane(__builtin_bit_cast(int, v), 32));
    const float d = __builtin_bit_cast(float, __builtin_amdgcn_readlane(__builtin_bit_cast(int, v), 48));
    return fmaxf(fmaxf(a, b), fmaxf(c, d)); }
DI bf16x8 pack8(const float (&z)[8]) { v4u p; p.x = pk(z[0], z[1]); p.y = pk(z[2], z[3]); p.z = pk(z[4], z[5]); p.w = pk(z[6], z[7]); return __builtin_bit_cast(bf16x8, p); }
DI void unpack8(v4u u, float (&z)[8]) {
#pragma unroll
    for (int e = 0; e < 4; ++e) { z[2 * e] = bflo(u[e]); z[2 * e + 1] = bfhi(u[e]); } }
#define MFMA16(a, b, c) __builtin_amdgcn_mfma_f32_16x16x32_bf16((a), (b), (c), 0, 0, 0)
#define MFMA32(a, b, c) __builtin_amdgcn_mfma_f32_32x32x16_bf16((a), (b), (c), 0, 0, 0)
DI int crow(int reg, int hh) { return (reg & 3) + 8 * (reg >> 2) + 4 * hh; }

struct Args { const float* in[32]; float* out; unsigned char* ws; int ph_lo, ph_hi; };
enum { I_X = 0, I_LN1, I_LN2, I_LNF, I_REL, I_WIN, I_MU, I_W0, I_W2, I_A0, I_A2, I_G2, I_KK, I_KA, I_RK, I_LNW, I_LNB, I_PEK, I_PEV, I_CKW1, I_CKW2, I_CVW1, I_CVW2,
       I_SINK, I_WBA, I_WBB, I_WBC, I_WOUT, I_PWQ, I_PSK, I_PU, I_PV };
__device__ const unsigned char T5_BK[128] = {0, 1, 2, 3, 4, 5, 6, 7, 8, 9, 10, 11, 12, 13, 14, 15, 16, 16, 16, 17, 17, 18, 18, 18, 19, 19, 19, 20, 20, 20, 20, 21, 21, 21, 21, 22, 22, 22, 22, 22, 23, 23, 23, 23, 23, 23, 24, 24, 24, 24, 24, 24, 25, 25, 25, 25, 25, 25, 25, 26, 26, 26, 26, 26, 26, 26, 26, 27, 27, 27, 27, 27, 27, 27, 27, 27, 27, 28, 28, 28, 28, 28, 28, 28, 28, 28, 28, 29, 29, 29, 29, 29, 29, 29, 29, 29, 29, 29, 29, 30, 30, 30, 30, 30, 30, 30, 30, 30, 30, 30, 30, 30, 30, 31, 31, 31, 31, 31, 31, 31, 31, 31, 31, 31, 31, 31, 31, 31};

#define XB_TMO      128
#define XB_XCNT(j)  (256  + 64 * (j))
#define XB_XSUB(j)  (1280 + 64 * (j))
#define XB_XGEN(j)  (2304 + 64 * (j))
#define XB_TOP      3328
#define XB_TOPGEN   3392
#define XCD_BAR_WORDS 3456
#define XB_SPIN_CAP (1u << 18)

__device__ __forceinline__ unsigned xb_ld(unsigned* p)              { return __hip_atomic_load(p, __ATOMIC_RELAXED, __HIP_MEMORY_SCOPE_AGENT); }
__device__ __forceinline__ unsigned xb_add(unsigned* p, unsigned v) { return __hip_atomic_fetch_add(p, v, __ATOMIC_RELAXED, __HIP_MEMORY_SCOPE_AGENT); }
__device__ __forceinline__ unsigned xb_xcc_id() { return (unsigned)__builtin_amdgcn_s_getreg((3 << 11) | 20) & 0xFu; }
#define XB_SPIN(cond, bar) do { unsigned _sp = 0; while (cond) { __builtin_amdgcn_s_sleep(1); \
    if ((++_sp & 255u) == 0u) { if (xb_ld(&(bar)[XB_TMO])) break; if (_sp > XB_SPIN_CAP) { atomicAdd(&(bar)[XB_TMO], 1u); break; } } } } while (0)

struct XcdBarrier {
    unsigned* bar; unsigned x;
    volatile LAS unsigned* st;
};

__device__ __forceinline__ XcdBarrier xcd_barrier_post(unsigned* bar, volatile LAS unsigned* st) {
    XcdBarrier b; b.bar = bar; b.x = xb_xcc_id(); b.st = st;
    if (threadIdx.x == 0) (void)xb_add(&bar[XB_XCNT(b.x)], 1u);
    return b;
}
__device__ __forceinline__ void xcd_barrier_complete(unsigned* bar, unsigned x, unsigned& nloc, unsigned& nx) {
    const unsigned G = gridDim.x * gridDim.y * gridDim.z;
    unsigned sum, cnt, mine, sp = 0u;
    for (;;) {
        sum = 0u; cnt = 0u; mine = 0u;
#pragma unroll
        for (unsigned j = 0; j < 16; ++j) { const unsigned c = xb_ld(&bar[XB_XCNT(j)]); sum += c; cnt += (c > 0u) ? 1u : 0u; mine = (j == x) ? c : mine; }
        if (sum == G) break;
        __builtin_amdgcn_s_sleep(1);
        if ((++sp & 255u) == 0u) { if (xb_ld(&bar[XB_TMO])) break; if (sp > XB_SPIN_CAP) { atomicAdd(&bar[XB_TMO], 1u); break; } }
    }
    nloc = mine > 0u ? mine : 1u; nx = cnt > 0u ? cnt : 1u;
}

__device__ __forceinline__ void xcd_barrier(const XcdBarrier& b) {
    asm volatile("s_waitcnt vmcnt(0)" ::: "memory");
    __syncthreads();
    if (threadIdx.x == 0) {
        unsigned* bar = b.bar;
        __builtin_amdgcn_s_waitcnt(0);
        unsigned nloc = b.st[0], nx = b.st[1];
        if (nloc == 0u) { xcd_barrier_complete(bar, b.x, nloc, nx); b.st[0] = nloc; b.st[1] = nx; }
        const unsigned old = xb_add(&bar[XB_XSUB(b.x)], 1u);
        const unsigned gen = old / nloc;
        if (old + 1u == (gen + 1u) * nloc) {
            __builtin_amdgcn_fence(__ATOMIC_RELEASE, "agent");
            asm volatile("s_waitcnt vmcnt(0)" ::: "memory");
            const unsigned og = xb_add(&bar[XB_TOP], 1u);
            const unsigned tg = og / nx;
            if (og + 1u == (tg + 1u) * nx) xb_add(&bar[XB_TOPGEN], 1u);
            else XB_SPIN(xb_ld(&bar[XB_TOPGEN]) == tg, bar);
            __builtin_amdgcn_fence(__ATOMIC_ACQUIRE, "agent");
            xb_add(&bar[XB_XGEN(b.x)], 1u);
            asm volatile("s_waitcnt vmcnt(0)" ::: "memory");
        } else {
            XB_SPIN(xb_ld(&bar[XB_XGEN(b.x)]) == gen, bar);
            __builtin_amdgcn_fence(__ATOMIC_ACQUIRE, "agent");
            asm volatile("s_waitcnt vmcnt(0)" ::: "memory");
        }
    }
    __syncthreads();
}

DI void tr_item(const float* W, int K, int Nsrc, bf16* WT, int pa, int pb, LAS float* scr, int item, int nblk, int lane) {
    const int kb = item / nblk, nb = item % nblk, k0 = 64 * kb, n0 = 64 * nb;
    const int nq = lane & 15, r = n0 + 4 * nq;
    const int sc = r < pa ? r : (r < pb ? -1 : r - (pb - pa));
    const float* wp = W + (size_t)(k0 + (lane >> 4)) * Nsrc + (sc >= 0 ? sc : 0);
    f32x4 v[16];
#pragma unroll
    for (int i = 0; i < 16; ++i) v[i] = *(const f32x4*)(wp + (size_t)(4 * i) * Nsrc);
    __builtin_amdgcn_sched_barrier(0);
#pragma unroll
    for (int i = 0; i < 16; ++i) { if (sc < 0) v[i] = (f32x4){0.f, 0.f, 0.f, 0.f}; *(LAS f32x4*)(scr + (4 * i + (lane >> 4)) * 68 + 4 * nq) = v[i]; }
    asm volatile("s_waitcnt lgkmcnt(0)" ::: "memory");
    const int c = lane & 7;
#pragma unroll
    for (int j = 0; j < 8; ++j) { const int n = (lane >> 3) + 8 * j; const LAS float* s = scr + (8 * c) * 68 + n;
        v4u o; o.x = pk(s[0 * 68], s[1 * 68]); o.y = pk(s[2 * 68], s[3 * 68]); o.z = pk(s[4 * 68], s[5 * 68]); o.w = pk(s[6 * 68], s[7 * 68]);
        *(v4u*)(WT + (size_t)(n0 + n) * K + k0 + 8 * c) = o; }
    asm volatile("s_waitcnt lgkmcnt(0)" ::: "memory");
}
#define TR_MAT(W, K, Nsrc, Ndst, WT, pa, pb) do { const int nblk_ = (Ndst) / 64, nit_ = ((K) / 64) * nblk_; int st_ = gw - base_; if (st_ < 0) st_ += NGW; \
    for (int it_ = st_; it_ < nit_; it_ += NGW) tr_item((W), (K), (Nsrc), (WT), (pa), (pb), scr, it_, nblk_, lane); base_ = (base_ + nit_) % NGW; } while (0)
DI void cvt_copy(const float* src, bf16* dst, size_t n, size_t gtid, size_t gthreads) {
    for (size_t i = gtid * 8; i < n; i += gthreads * 8) {
        const f32x4 a = *(const f32x4*)(src + i), b = *(const f32x4*)(src + i + 4);
        v4u o; o.x = pk(a[0], a[1]); o.y = pk(a[2], a[3]); o.z = pk(b[0], b[1]); o.w = pk(b[2], b[3]);
        *(v4u*)(dst + i) = o; }
}
DI void p_prologue(const Args& a, LAS unsigned char* lds, int tid, int l_lo, int l_hi, bool do_sk) {
    const int lane = tid & 63, wave = tid >> 6, gw = blockIdx.x * NWAVES + wave, NGW = gridDim.x * NWAVES;
    LAS float* scr = (LAS float*)(lds + wave * 17408);
    unsigned char* ws = a.ws;
    int base_ = 0;
    for (int l = l_lo; l < l_hi; ++l) {
        TR_MAT(a.in[I_WIN] + (size_t)l * 1024 * 6936, 1024, 6936, NP, (bf16*)(ws + WS_WIN) + (size_t)l * NP * 1024, PAD_A, PAD_B);
        TR_MAT(a.in[I_WBA] + (size_t)l * 512 * 1024, 512, 1024, 1024, (bf16*)(ws + WS_WBR) + (size_t)(l * 3 + 0) * 1024 * 512, 1 << 30, 1 << 30);
        TR_MAT(a.in[I_WBB] + (size_t)l * 512 * 1024, 512, 1024, 1024, (bf16*)(ws + WS_WBR) + (size_t)(l * 3 + 1) * 1024 * 512, 1 << 30, 1 << 30);
        TR_MAT(a.in[I_WBC] + (size_t)l * 512 * 1024, 512, 1024, 1024, (bf16*)(ws + WS_WBR) + (size_t)(l * 3 + 2) * 1024 * 512, 1 << 30, 1 << 30);
        TR_MAT(a.in[I_WOUT] + (size_t)l * 1024 * 1024, 1024, 1024, 1024, (bf16*)(ws + WS_WOUT) + (size_t)l * 1024 * 1024, 1 << 30, 1 << 30);
        TR_MAT(a.in[I_PWQ] + (size_t)l * 1024 * 2048, 1024, 2048, 2048, (bf16*)(ws + WS_WQ) + (size_t)l * 2048 * 1024, 1 << 30, 1 << 30);
        TR_MAT(a.in[I_CKW1] + (size_t)l * 2048 * 256, 2048, 256, 256, (bf16*)(ws + WS_CW1) + (size_t)(l * 2 + 0) * 256 * 2048, 1 << 30, 1 << 30);
        TR_MAT(a.in[I_CVW1] + (size_t)l * 2048 * 256, 2048, 256, 256, (bf16*)(ws + WS_CW1) + (size_t)(l * 2 + 1) * 256 * 2048, 1 << 30, 1 << 30);
        TR_MAT(a.in[I_CKW2] + (size_t)l * 256 * 64, 256, 64, 64, (bf16*)(ws + WS_CW2) + (size_t)(l * 2 + 0) * 64 * 256, 1 << 30, 1 << 30);
        TR_MAT(a.in[I_CVW2] + (size_t)l * 256 * 64, 256, 64, 64, (bf16*)(ws + WS_CW2) + (size_t)(l * 2 + 1) * 64 * 256, 1 << 30, 1 << 30);
        bf16* rw = (bf16*)(ws + WS_RW) + (size_t)l * 131072;
        TR_MAT(a.in[I_W2] + (size_t)l * 64 * 512, 64, 512, 512, rw, 1 << 30, 1 << 30);
        TR_MAT(a.in[I_A2] + (size_t)l * 64 * 512, 64, 512, 512, rw + 512 * 64, 1 << 30, 1 << 30);
        TR_MAT(a.in[I_G2] + (size_t)l * 128 * 512, 128, 512, 512, rw + 2 * 512 * 64, 1 << 30, 1 << 30);
    }
    if (do_sk) cvt_copy(a.in[I_PSK], (bf16*)(ws + WS_SK), (size_t)LAYERS * 16 * 128 * 128, (size_t)blockIdx.x * NT + tid, (size_t)gridDim.x * NT);
}

DI void rms_row_bf16(const float* xrow, const float* w, bf16* orow, int lane) {
    const f32x4* xr = (const f32x4*)xrow + lane;
    f32x4 v[4]; float s = 0.f;
#pragma unroll
    for (int j = 0; j < 4; ++j) v[j] = xr[64 * j];
    __builtin_amdgcn_sched_barrier(0);
#pragma unroll
    for (int j = 0; j < 4; ++j) s += (v[j].x * v[j].x + v[j].y * v[j].y) + (v[j].z * v[j].z + v[j].w * v[j].w);
    const float rs = rsqrtf(wave_sum(s) * (1.f / D) + 1e-6f);
    f32x4 wv[4];
#pragma unroll
    for (int j = 0; j < 4; ++j) wv[j] = ((const f32x4*)w)[lane + 64 * j];
    __builtin_amdgcn_sched_barrier(0);
#pragma unroll
    for (int j = 0; j < 4; ++j) { const f32x4 o = v[j] * rs * wv[j];
        v2u p; p.x = pk(o.x, o.y); p.y = pk(o.z, o.w); ((v2u*)orow)[lane + 64 * j] = p; }
}
DI void p_rms(const float* x, const float* w, bf16* out, int tid) {
    const int lane = tid & 63, gw = blockIdx.x * NWAVES + (tid >> 6), NGW = gridDim.x * NWAVES;
    for (int m = gw; m < M; m += NGW) rms_row_bf16(x + (size_t)m * D, w, out + (size_t)m * D, lane);
}

DI void load_shift8(const bf16* cur, const bf16* prv, bool hp, const float* mu, float (&z)[8]) {
    const v4u c = *(const v4u*)cur; v4u p = *(const v4u*)(hp ? prv : cur);
    const f32x4 m0 = *(const f32x4*)mu, m1 = *(const f32x4*)(mu + 4);
    if (!hp) p = (v4u){0u, 0u, 0u, 0u};
    float cf[8], pf[8]; unpack8(c, cf); unpack8(p, pf);
#pragma unroll
    for (int e = 0; e < 8; ++e) { const float mm = e < 4 ? m0[e & 3] : m1[e & 3]; z[e] = cf[e] + mm * (pf[e] - cf[e]); }
}
struct Sh8 { v4u c, p; f32x4 m0, m1; };
DI void ls8_ld(const bf16* cur, const bf16* prv, bool hp, const float* mu, Sh8& s) { s.c = *(const v4u*)cur; s.p = *(const v4u*)(hp ? prv : cur); s.m0 = *(const f32x4*)mu; s.m1 = *(const f32x4*)(mu + 4); }
DI void ls8_mix(const Sh8& s, bool hp, float (&z)[8]) {
    v4u p = s.p; if (!hp) p = (v4u){0u, 0u, 0u, 0u};
    float cf[8], pf[8]; unpack8(s.c, cf); unpack8(p, pf);
#pragma unroll
    for (int e = 0; e < 8; ++e) { const float mm = e < 4 ? s.m0[e & 3] : s.m1[e & 3]; z[e] = cf[e] + mm * (pf[e] - cf[e]); }
}
struct Sh4 { v2u c, p; f32x4 m; };
DI void ls4_ld(const bf16* cur, const bf16* prv, bool hp, const float* mu, Sh4& s) { s.c = *(const v2u*)cur; s.p = *(const v2u*)(hp ? prv : cur); s.m = *(const f32x4*)mu; }
DI void ls4_mix(const Sh4& s, bool hp, float (&z)[4]) {
    v2u p = s.p; if (!hp) p = (v2u){0u, 0u};
    const float c0 = bflo(s.c.x), c1 = bfhi(s.c.x), c2 = bflo(s.c.y), c3 = bfhi(s.c.y), p0 = bflo(p.x), p1 = bfhi(p.x), p2 = bflo(p.y), p3 = bfhi(p.y);
    z[0] = c0 + s.m[0] * (p0 - c0); z[1] = c1 + s.m[1] * (p1 - c1); z[2] = c2 + s.m[2] * (p2 - c2); z[3] = c3 + s.m[3] * (p3 - c3);
}
DI void load_shift4(const bf16* cur, const bf16* prv, bool hp, const float* mu, float (&z)[4]) { Sh4 s; ls4_ld(cur, prv, hp, mu, s); ls4_mix(s, hp, z); }
DI void rwkv_prep_item(const Args& a, int l, int item, int lane_in, LAS unsigned char* bfr, LAS float* ms) {
    int lane = lane_in; asm volatile("" : "+v"(lane));
    const int r16_ = lane & 15, q4_ = lane >> 4, m = (item >> 2) * 16 + r16_, tm = r16_ & 3, h_lo = (item & 3) * 2;
    const bool hp = (m & (SEQ - 1)) != 0;
    const bf16* prow = (const bf16*)(a.ws + WS_PROJ) + (size_t)m * NP; const bf16* pprev = prow - NP;
    const float* mu = a.in[I_MU] + l * 1792;
    { int q4 = q4_; asm volatile("" : "+v"(q4));
    { Sh8 s[4];
#pragma unroll
      for (int ks = 0; ks < 2; ++ks) { const int c = ks * 32 + q4 * 8; ls8_ld(prow + C_W + c, pprev + C_W + c, hp, mu + C_W + c, s[ks]); ls8_ld(prow + C_A + c, pprev + C_A + c, hp, mu + C_A + c, s[2 + ks]); }
      __builtin_amdgcn_sched_barrier(0);
#pragma unroll
      for (int ks = 0; ks < 2; ++ks) { float z[8]; ls8_mix(s[ks], hp, z);
#pragma unroll
          for (int e = 0; e < 8; ++e) z[e] = tanhf(z[e]);
          *(LAS bf16x8*)(bfr + ks * 8192) = pack8(z);
          ls8_mix(s[2 + ks], hp, z); *(LAS bf16x8*)(bfr + (2 + ks) * 8192) = pack8(z); }
      asm volatile("" : "+v"(q4) :: "memory"); }
    { Sh8 s[4];
#pragma unroll
      for (int ks = 0; ks < 4; ++ks) { const int c = ks * 32 + q4 * 8; ls8_ld(prow + C_G + c, pprev + C_G + c, hp, mu + C_G + c, s[ks]); }
      __builtin_amdgcn_sched_barrier(0);
#pragma unroll
      for (int ks = 0; ks < 4; ++ks) { float z[8]; ls8_mix(s[ks], hp, z);
#pragma unroll
          for (int e = 0; e < 8; ++e) z[e] = sigm(z[e]);
          *(LAS bf16x8*)(bfr + (4 + ks) * 8192) = pack8(z); }
      asm volatile("" : "+v"(q4) :: "memory"); }
    }
    const bf16* W2T = (const bf16*)(a.ws + WS_RW) + (size_t)l * 131072; const bf16* A2T = W2T + 512 * 64; const bf16* G2T = A2T + 512 * 64;
    float* BON = (float*)(a.ws + WS_BON);
#pragma unroll 1
    for (int h_ = h_lo; h_ < h_lo + 2; ++h_) {
        int h = h_, q4 = q4_, r16 = r16_, mv = m; asm volatile("" : "+v"(h), "+v"(q4), "+v"(r16), "+v"(mv));
        const bf16* prow = (const bf16*)(a.ws + WS_PROJ) + (size_t)mv * NP; const bf16* pprev = prow - NP;
        bf16* GB = (bf16*)(a.ws + WS_G);
        float ss = 0.f, bon = 0.f;
        { Sh4 sk[4]; f32x4 kkq[4];
#pragma unroll
          for (int mt = 0; mt < 4; ++mt) { const int ch = h * 64 + mt * 16 + q4 * 4; ls4_ld(prow + C_K + ch, pprev + C_K + ch, hp, mu + C_K + ch, sk[mt]); kkq[mt] = *(const f32x4*)(a.in[I_KK] + l * 512 + ch); }
          __builtin_amdgcn_sched_barrier(0);
#pragma unroll
          for (int mt = 0; mt < 4; ++mt) { float zk1[4]; ls4_mix(sk[mt], hp, zk1);
#pragma unroll
            for (int j = 0; j < 4; ++j) { const float kr = zk1[j] * kkq[mt][j]; ss += kr * kr; } } }
        asm volatile("" : "+v"(h), "+v"(q4), "+v"(r16) :: "memory");
        ss += __shfl_xor(ss, 16); ss += __shfl_xor(ss, 32);
        const float inv = rsqrtf(fmaxf(ss, 1e-12f));
        v4u FQ[2], FR[2], FA[2], FK[2]; float qall[4][4], rall[4][4];
        unsigned char* recb = a.ws + WS_REC + ((size_t)((mv >> 13) * 8 + h) * 2048 + ((mv & (SEQ - 1)) >> 2)) * 3072;
        { bf16x8 gf[4][4];
#pragma unroll
          for (int mt = 0; mt < 4; ++mt)
#pragma unroll
              for (int ks = 0; ks < 4; ++ks) gf[mt][ks] = *(const bf16x8*)(G2T + (h * 64 + mt * 16 + r16) * 128 + ks * 32 + q4 * 8);
          __builtin_amdgcn_sched_barrier(0);
#pragma unroll
          for (int mt = 0; mt < 4; ++mt) { f32x4 ag = (f32x4){0.f, 0.f, 0.f, 0.f}; const int ch = h * 64 + mt * 16 + q4 * 4;
#pragma unroll
              for (int ks = 0; ks < 4; ++ks) ag = MFMA16(gf[mt][ks], *(const LAS bf16x8*)(bfr + (4 + ks) * 8192), ag);
              v2u gv; gv.x = pk(ag[0], ag[1]); gv.y = pk(ag[2], ag[3]); *(v2u*)(GB + (size_t)mv * 512 + ch) = gv; }
          asm volatile("" : "+v"(h), "+v"(q4), "+v"(r16) :: "memory"); }
#pragma unroll
        for (int mt = 0; mt < 4; ++mt) {
            f32x4 aw = (f32x4){0.f, 0.f, 0.f, 0.f}, aa = aw;
            const int row = h * 64 + mt * 16 + r16;
            const int ch = h * 64 + mt * 16 + q4 * 4; float zr[4], zv[4], zkm[4];
            bf16x8 wf[2], af2[2]; Sh4 sK, sR, sV;
#pragma unroll
            for (int ks = 0; ks < 2; ++ks) { wf[ks] = *(const bf16x8*)(W2T + row * 64 + ks * 32 + q4 * 8); af2[ks] = *(const bf16x8*)(A2T + row * 64 + ks * 32 + q4 * 8); }
            ls4_ld(prow + C_K + ch, pprev + C_K + ch, hp, mu + C_K + ch, sK); ls4_ld(prow + C_R + ch, pprev + C_R + ch, hp, mu + C_R + ch, sR); ls4_ld(prow + C_V + ch, pprev + C_V + ch, hp, mu + C_V + ch, sV);
            const f32x4 w0 = *(const f32x4*)(a.in[I_W0] + l * 512 + ch), a0 = *(const f32x4*)(a.in[I_A0] + l * 512 + ch), k_k = *(const f32x4*)(a.in[I_KK] + l * 512 + ch),
                        k_a = *(const f32x4*)(a.in[I_KA] + l * 512 + ch), r_k = *(const f32x4*)(a.in[I_RK] + l * 512 + ch);
            __builtin_amdgcn_sched_barrier(0);
#pragma unroll
            for (int ks = 0; ks < 2; ++ks) { aw = MFMA16(wf[ks], *(const LAS bf16x8*)(bfr + ks * 8192), aw); aa = MFMA16(af2[ks], *(const LAS bf16x8*)(bfr + (2 + ks) * 8192), aa); }
            ls4_mix(sK, hp, zkm); ls4_mix(sR, hp, zr); ls4_mix(sV, hp, zv);
            float qv[4], rv[4], kav[4], kkv[4], ahv[4], khv[4], w4a[4];
#pragma unroll
            for (int j = 0; j < 4; ++j) {
                const float y = -(w0[j] + aw[j]);
                const float sp = fmaxf(y, 0.f) + __logf(1.0f + __expf(-fabsf(y)));
                const float dec = __expf(-__expf(-sp - 0.5f));
                const float av_ = sigm(a0[j] + aa[j]);
                const float kk = zkm[j] * k_k[j] * inv;
                const float kpr = zkm[j] * (1.0f + (av_ - 1.0f) * k_a[j]);
                bon += zr[j] * kpr * r_k[j];
                float winc = dec;
                { const float t1 = DPPQ(winc, 0x90); winc *= (tm >= 1) ? t1 : 1.0f; const float t2 = DPPQ(winc, 0x44); winc *= (tm >= 2) ? t2 : 1.0f; }
                const float wsh = DPPQ(winc, 0x90), wexc = (tm == 0) ? 1.0f : wsh, w4 = DPPQ(winc, 0xFF), rw = __builtin_amdgcn_rcpf(winc);
                const float ah = kk * av_ * rw, kh = kpr * rw;
                qv[j] = wexc * kk; rv[j] = winc * zr[j]; kav[j] = ah * w4; kkv[j] = kh * w4; w4a[j] = w4;
                *(bf16*)(recb + 2560 + (size_t)(mt * 16 + q4 * 4 + j) * 8 + tm * 2) = (bf16)(pk(zv[j], 0.f) & 0xffffu);
                ahv[j] = ah; khv[j] = kh; qall[mt][j] = qv[j]; rall[mt][j] = rv[j];
            }
            { float ka4[4] = {0.f, 0.f, 0.f, 0.f}, kk4[4] = {0.f, 0.f, 0.f, 0.f};
#pragma unroll
              for (int jj = 0; jj < 4; ++jj) { const float a0_ = DPPQ(kav[jj], 0x00), a1_ = DPPQ(kav[jj], 0x55), a2_ = DPPQ(kav[jj], 0xAA), a3_ = DPPQ(kav[jj], 0xFF);
                  const float k0_ = DPPQ(kkv[jj], 0x00), k1_ = DPPQ(kkv[jj], 0x55), k2_ = DPPQ(kkv[jj], 0xAA), k3_ = DPPQ(kkv[jj], 0xFF); const bool mine = tm == jj;
                  ka4[0] = mine ? a0_ : ka4[0]; ka4[1] = mine ? a1_ : ka4[1]; ka4[2] = mine ? a2_ : ka4[2]; ka4[3] = mine ? a3_ : ka4[3];
                  kk4[0] = mine ? k0_ : kk4[0]; kk4[1] = mine ? k1_ : kk4[1]; kk4[2] = mine ? k2_ : kk4[2]; kk4[3] = mine ? k3_ : kk4[3]; }
              *(v4u*)(recb + 1024 + (size_t)(mt * 16 + q4 * 4 + tm) * 16) = (v4u){pk(ka4[0], ka4[1]), pk(ka4[2], ka4[3]), pk(kk4[0], kk4[1]), pk(kk4[2], kk4[3])};
              if (tm == 0) *(f32x4*)(recb + 2048 + (size_t)(mt * 16 + q4 * 4) * 4) = (f32x4){w4a[0], w4a[1], w4a[2], w4a[3]}; }
            FQ[mt >> 1][(mt & 1) * 2] = pk(qv[0], qv[1]); FQ[mt >> 1][(mt & 1) * 2 + 1] = pk(qv[2], qv[3]); FR[mt >> 1][(mt & 1) * 2] = pk(rv[0], rv[1]); FR[mt >> 1][(mt & 1) * 2 + 1] = pk(rv[2], rv[3]);
            FA[mt >> 1][(mt & 1) * 2] = pk(ahv[0], ahv[1]); FA[mt >> 1][(mt & 1) * 2 + 1] = pk(ahv[2], ahv[3]); FK[mt >> 1][(mt & 1) * 2] = pk(khv[0], khv[1]); FK[mt >> 1][(mt & 1) * 2 + 1] = pk(khv[2], khv[3]);
            asm volatile("" : "+v"(h), "+v"(q4), "+v"(r16) :: "memory");
        }
        bon += __shfl_xor(bon, 16); bon += __shfl_xor(bon, 32);
        if (q4_ == 0) BON[m * 8 + h_] = bon;
        {
            f32x4 dE = (f32x4){0.f, 0.f, 0.f, 0.f}, dF = dE, dG = dE, dH = dE;
#pragma unroll
            for (int ks = 0; ks < 2; ++ks) { const bf16x8 fq = __builtin_bit_cast(bf16x8, FQ[ks]), fr = __builtin_bit_cast(bf16x8, FR[ks]), fa = __builtin_bit_cast(bf16x8, FA[ks]), fk = __builtin_bit_cast(bf16x8, FK[ks]);
                dE = MFMA16(fq, fa, dE); dF = MFMA16(fq, fk, dF); dG = MFMA16(fr, fa, dG); dH = MFMA16(fr, fk, dH); }
            if (q4_ == (r16_ >> 2)) {
#pragma unroll
                for (int jj = 0; jj < 4; ++jj) { LAS float* cp = ms + ((q4_ * 4 + 0) * 4 + jj) * 4 + tm;
                    cp[0] = tm < jj ? dE[jj] : 0.f; cp[16] = tm < jj ? dF[jj] : 0.f; cp[32] = tm <= jj ? dG[jj] : 0.f; cp[48] = tm <= jj ? dH[jj] : 0.f; } }
            asm volatile("s_waitcnt lgkmcnt(0)" ::: "memory");
            const LAS f32x4* mp = (const LAS f32x4*)(ms + (r16_ >> 2) * 64);
            const f32x4 E1 = mp[1], E2 = mp[2], E3 = mp[3], F1 = mp[5], F2 = mp[6], F3 = mp[7], Grow = mp[8 + tm], Hrow = mp[12 + tm];
            asm volatile("s_waitcnt lgkmcnt(0)" ::: "memory");
            const float t10 = -E1[0], t21 = -E2[1], t32 = -E3[2], t20 = -E2[0] + E2[1] * E1[0], t31 = -E3[1] + E3[2] * E2[1], t30 = -E3[0] + E3[1] * E1[0] + E3[2] * E2[0] - E3[2] * E2[1] * E1[0];
            const float m10 = -F1[0], m20 = -(t21 * F1[0] + F2[0]), m21 = -F2[1], m30 = -(t31 * F1[0] + t32 * F2[0] + F3[0]), m31 = -(t32 * F2[1] + F3[1]), m32 = -F3[2];
            const float T0 = tm == 0 ? 1.f : (tm == 1 ? t10 : (tm == 2 ? t20 : t30)), T1 = tm == 0 ? 0.f : (tm == 1 ? 1.f : (tm == 2 ? t21 : t31)), T2 = tm < 2 ? 0.f : (tm == 2 ? 1.f : t32), T3 = tm == 3 ? 1.f : 0.f;
            const float M0 = tm == 0 ? 0.f : (tm == 1 ? m10 : (tm == 2 ? m20 : m30)), M1 = tm < 2 ? 0.f : (tm == 2 ? m21 : m31), M2_ = tm == 3 ? m32 : 0.f;
            const float P0 = Hrow[0] + (Grow[1] * m10 + Grow[2] * m20 + Grow[3] * m30), P1 = Hrow[1] + (Grow[2] * m21 + Grow[3] * m31), P2_ = Hrow[2] + Grow[3] * m32, P3 = Hrow[3];
#pragma unroll
            for (int mt = 0; mt < 4; ++mt) { float qp[4], rp[4];
#pragma unroll
                for (int j = 0; j < 4; ++j) { const float q0 = DPPQ(qall[mt][j], 0x00), q1 = DPPQ(qall[mt][j], 0x55), q2 = DPPQ(qall[mt][j], 0xAA), q3 = DPPQ(qall[mt][j], 0xFF);
                    qp[j] = -((T0 * q0 + T1 * q1) + (T2 * q2 + T3 * q3));
                    const float Q0 = DPPQ(qp[j], 0x00), Q1 = DPPQ(qp[j], 0x55), Q2 = DPPQ(qp[j], 0xAA), Q3 = DPPQ(qp[j], 0xFF);
                    rp[j] = rall[mt][j] + ((Grow[0] * Q0 + Grow[1] * Q1) + (Grow[2] * Q2 + Grow[3] * Q3)); }
                FQ[mt >> 1][(mt & 1) * 2] = pk(qp[0], qp[1]); FQ[mt >> 1][(mt & 1) * 2 + 1] = pk(qp[2], qp[3]); FR[mt >> 1][(mt & 1) * 2] = pk(rp[0], rp[1]); FR[mt >> 1][(mt & 1) * 2 + 1] = pk(rp[2], rp[3]); }
#pragma unroll
            for (int ks = 0; ks < 2; ++ks) { *(v4u*)(recb + (size_t)((ks * 4 + tm) * 4 + q4_) * 16) = FQ[ks]; *(v4u*)(recb + 512 + (size_t)((ks * 4 + tm) * 4 + q4_) * 16) = FR[ks]; }
            if (q4_ == (r16_ >> 2)) { *(v4u*)(recb + 2304 + tm * 16) = (v4u){pk(M0, M1), pk(M2_, 0.f), pk(P0, P1), pk(P2_, P3)};
                if (tm == 0) { unsigned zz_ = 0u; asm volatile("" : "+v"(zz_)); *(v4u*)(recb + 2368) = (v4u){zz_, zz_, zz_, zz_}; } }
        }
    }
}
constexpr int HSP = 264;
DI void compress_item(const Args& a, int l, int item, LAS unsigned char* lds, int tid) {
    const int kv = item >> 7, b = (item >> 6) & 1, g = (item >> 5) & 1, cb = item & 31;
    const int lane = tid & 63, w = tid >> 6, r16 = lane & 15, q4 = lane >> 4;
    const bf16* src = (const bf16*)(a.ws + WS_KV0) + (size_t)(b * SEQ) * 256 + (kv ? 128 : 0) + g * 64;
    const float* pe = a.in[kv ? I_PEV : I_PEK] + l * 2048;
    const bf16* W1T = (const bf16*)(a.ws + WS_CW1) + (size_t)(l * 2 + kv) * 256 * 2048;
    const bf16* W2T = (const bf16*)(a.ws + WS_CW2) + (size_t)(l * 2 + kv) * 64 * 256;
    constexpr int ZP = 4112;
    LAS unsigned char* Zs = lds; LAS bf16* Hs = (LAS bf16*)(lds + 16 * ZP + 256);
    { v4u raw[8]; f32x4 p0[8], p1[8];
#pragma unroll
      for (int i = 0; i < 8; ++i) { const int ch = tid + 512 * i, rr = ch >> 8, ck = ch & 255, lt = ck >> 3, d0 = (ck & 7) * 8;
          int tokn = 16 * (cb * 16 + rr) + lt; tokn = tokn < SEQ ? tokn : SEQ - 1;
          raw[i] = *(const v4u*)(src + (size_t)tokn * 256 + d0); p0[i] = *(const f32x4*)(pe + lt * 64 + d0); p1[i] = *(const f32x4*)(pe + lt * 64 + d0 + 4); }
      __builtin_amdgcn_sched_barrier(0);
#pragma unroll
      for (int i = 0; i < 8; ++i) { const int ch = tid + 512 * i, rr = ch >> 8, ck = ch & 255; float z[8]; unpack8(raw[i], z);
#pragma unroll
          for (int e = 0; e < 8; ++e) z[e] += e < 4 ? p0[i][e & 3] : p1[i][e & 3];
          *(LAS bf16x8*)(Zs + rr * ZP + ck * 16) = pack8(z); } }
    __syncthreads();
    f32x4 acc[2] = {(f32x4){0.f, 0.f, 0.f, 0.f}, (f32x4){0.f, 0.f, 0.f, 0.f}};
#define CG_LOAD(S, K4) do { _Pragma("unroll") for (int i = 0; i < 4; ++i) { const int ks = (K4) + i; \
            _Pragma("unroll") for (int t = 0; t < 2; ++t) S##wf[i][t] = *(const bf16x8*)(W1T + (size_t)((2 * w + t) * 16 + r16) * 2048 + ks * 32 + q4 * 8); } \
        __builtin_amdgcn_sched_barrier(0); } while (0)
#define CG_COMP(S, K4) do { _Pragma("unroll") for (int i = 0; i < 4; ++i) { const bf16x8 af = *(const LAS bf16x8*)(Zs + r16 * ZP + ((K4) + i) * 64 + q4 * 16); \
            _Pragma("unroll") for (int t = 0; t < 2; ++t) acc[t] = MFMA16(af, S##wf[i][t], acc[t]); } \
        __builtin_amdgcn_sched_barrier(0); } while (0)
    bf16x8 Awf[4][2], Bwf[4][2];
    CG_LOAD(A, 0);
#pragma unroll 1
    for (int k8 = 0; k8 < 64; k8 += 8) {
        CG_LOAD(B, k8 + 4); CG_COMP(A, k8);
        if (k8 + 8 < 64) CG_LOAD(A, k8 + 8);
        CG_COMP(B, k8 + 4);
    }
#undef CG_LOAD
#undef CG_COMP
#pragma unroll
    for (int t = 0; t < 2; ++t)
#pragma unroll
        for (int j = 0; j < 4; ++j) Hs[(q4 * 4 + j) * HSP + (2 * w + t) * 16 + r16] = (bf16)(pk(gelu_erf(acc[t][j]), 0.f) & 0xffffu);
    __syncthreads();
    if (w < 4) { f32x4 o = (f32x4){0.f, 0.f, 0.f, 0.f}; bf16x8 w2f[8];
#pragma unroll
        for (int ks = 0; ks < 8; ++ks) w2f[ks] = *(const bf16x8*)(W2T + (w * 16 + r16) * 256 + ks * 32 + q4 * 8);
        __builtin_amdgcn_sched_barrier(0);
#pragma unroll
        for (int ks = 0; ks < 8; ++ks) o = MFMA16(*(const LAS bf16x8*)(Hs + r16 * HSP + ks * 32 + q4 * 8), w2f[ks], o);
        bf16* dst = (bf16*)(a.ws + (kv ? WS_VCMP : WS_KCMP)) + ((size_t)((b * 2 + g) * 512 + cb * 16 + q4 * 4)) * 64 + w * 16 + r16;
#pragma unroll
        for (int j = 0; j < 4; ++j) dst[j * 64] = (bf16)(pk(o[j], 0.f) & 0xffffu);
    }
    __syncthreads();
}
DI void p_prep(const Args& a, int l, LAS unsigned char* lds, int tid) {
    const bool rfirst = ((blockIdx.x >> 3) & 1u) != 0u;
    for (int rep = 0; rep < REP_PREP; ++rep) {
#pragma unroll 1
    for (int part = 0; part < 2; ++part) {
        if ((part == 0) != rfirst) {
            int tc_ = tid; asm volatile("" : "+v"(tc_));
            for (int rc = 0; rc < REP_PREP_C; ++rc)
            for (int it = blockIdx.x; it < 256; it += gridDim.x) compress_item(a, l, it, lds, tc_);
        } else {
            int tl_ = tid; asm volatile("" : "+v"(tl_));
            const int lane = tl_ & 63, gw = blockIdx.x * NWAVES + (tl_ >> 6), NGW = gridDim.x * NWAVES;
            LAS unsigned char* bfr = lds + 16384 + tl_ * 16; asm volatile("" : "+v"(bfr));
            LAS float* ms = (LAS float*)(lds + 81920) + (tl_ >> 6) * 256;
            for (int rr = 0; rr < REP_PREP_R; ++rr)
            for (int it = gw; it < M / 4; it += NGW) rwkv_prep_item(a, l, it, lane, bfr, ms);
        }
        __syncthreads();
    }
    }
}
constexpr int SC_STEPS = 16, SC_SLOT = SC_STEPS * 768, SC_NSLOT = 12, SC_NSEQ = SEQ / SC_STEPS / 2;
constexpr size_t WS_SMID = WS_CTL + 512 * 1024;
#define SC_LOADSET(r, sq) do { _Pragma("unroll") for (int k_ = 0; k_ < 3; ++k_) r[k_] = *(const v4u*)(gp + (size_t)(sq) * SC_SLOT + k_ * 1024); } while (0)
#define SC_STAGE(r, sq) do { const int s_ = (sq); \
    if (s_ >= SC_NSLOT) { for (;;) { const unsigned m_ = min(min(FL[4], FL[5]), min(FL[6], FL[7])); if ((int)__builtin_amdgcn_readfirstlane(m_) >= s_ - (SC_NSLOT - 1)) break; __builtin_amdgcn_s_sleep(2); } } \
    asm volatile("" ::: "memory"); \
    _Pragma("unroll") for (int k_ = 0; k_ < 3; ++k_) *(LAS v4u*)(lp + ringoff + k_ * 1024) = r[k_]; \
    asm volatile("s_waitcnt lgkmcnt(0)" ::: "memory"); \
    if (lane == 0) FL[lw] = (unsigned)(s_ + 1); \
    if (s_ + 4 < SC_NSEQ) SC_LOADSET(r, s_ + 4); \
    ringoff += SC_SLOT; if (ringoff == SC_NSLOT * SC_SLOT) ringoff = 0; } while (0)
DI void scan_block(const Args& a, int job, LAS unsigned char* lds, int tid) {
    const int lane = tid & 63, w = tid >> 6, bh = job & 15, kind = job >> 4, b = bh >> 3, h = bh & 7, tbeg = kind ? SEQ / 2 : 0;
    volatile LAS unsigned* FL = (volatile LAS unsigned*)(lds + MISC_OFF) + 32;
    if (tid < 8) FL[tid] = 0u;
    __syncthreads();
    const unsigned char* src = (const unsigned char*)(a.ws + WS_REC) + ((size_t)(b * 8 + h) * SEQ + tbeg) * 768;
    if (w >= 4) {
        const int lw = w - 4;
        const unsigned char* gp = src + (lw * 192 + lane) * 16; LAS unsigned char* lp = lds + (lw * 192 + lane) * 16;
        v4u r0[3], r1[3], r2[3], r3[3]; int ringoff = 0;
        SC_LOADSET(r0, 0); SC_LOADSET(r1, 1); SC_LOADSET(r2, 2); SC_LOADSET(r3, 3);
#pragma unroll 1
        for (int sq = 0; sq < SC_NSEQ; sq += 4) { SC_STAGE(r0, sq); SC_STAGE(r1, sq + 1); SC_STAGE(r2, sq + 2); SC_STAGE(r3, sq + 3); }
    } else {
        const int r16 = lane & 15, q4 = lane >> 4; const bool lead = q4 == 0;
        bf16* yp = (bf16*)(a.ws + (kind == 2 ? WS_XN : WS_OA)) + (size_t)(b * SEQ + tbeg) * 512 + h * 64 + 16 * w + r16;
        const int oq0 = r16 < 4 ? ((0 * 4 + r16) * 4 + q4) * 16 : 2368, oq1 = r16 < 4 ? ((1 * 4 + r16) * 4 + q4) * 16 : 2368, or0 = r16 < 4 ? 512 + ((0 * 4 + r16) * 4 + q4) * 16 : 2368, or1 = r16 < 4 ? 512 + ((1 * 4 + r16) * 4 + q4) * 16 : 2368;
        const int oa3 = (lead && r16 < 4) ? 2304 + r16 * 16 : 2368, ovv = (lead && kind != 2) ? 2560 + (16 * w + r16) * 8 : 2368, ok0 = lead ? 1024 + r16 * 16 : 2368, ok1 = lead ? 1024 + (16 + r16) * 16 : 2368,
                  ok2 = lead ? 1024 + (32 + r16) * 16 : 2368, ok3 = lead ? 1024 + (48 + r16) * 16 : 2368, ow = 2048 + 16 * q4;
        f32x4 acc[4];
#pragma unroll
        for (int jt = 0; jt < 4; ++jt)
#pragma unroll
            for (int e = 0; e < 4; ++e) acc[jt][e] = (kind == 2 && 16 * w + r16 == 16 * jt + 4 * q4 + e) ? 1.0f : 0.f;
#define SB_DECL(P) v4u P##aq0, P##aq1, P##ar0, P##ar1, P##a3, P##ak0, P##ak1, P##ak2, P##ak3; f32x4 P##w0, P##w1, P##w2, P##w3; v2u P##vv;
#define SB_LOAD(P, RB) do { const LAS unsigned char* rb_ = (RB); \
        P##aq0 = *(const LAS v4u*)(rb_ + oq0); P##aq1 = *(const LAS v4u*)(rb_ + oq1); P##ar0 = *(const LAS v4u*)(rb_ + or0); P##ar1 = *(const LAS v4u*)(rb_ + or1); P##a3 = *(const LAS v4u*)(rb_ + oa3); \
        P##ak0 = *(const LAS v4u*)(rb_ + ok0); P##ak1 = *(const LAS v4u*)(rb_ + ok1); P##ak2 = *(const LAS v4u*)(rb_ + ok2); P##ak3 = *(const LAS v4u*)(rb_ + ok3); \
        P##w0 = *(const LAS f32x4*)(rb_ + ow); P##w1 = *(const LAS f32x4*)(rb_ + ow + 64); P##w2 = *(const LAS f32x4*)(rb_ + ow + 128); P##w3 = *(const LAS f32x4*)(rb_ + ow + 192); \
        P##vv = *(const LAS v2u*)(rb_ + ovv); } while (0)
#define SB_COMPUTE(P, T0) do { \
        v4u b0, b1; \
        b0.x = pk(acc[0][0], acc[0][1]); b0.y = pk(acc[0][2], acc[0][3]); b0.z = pk(acc[1][0], acc[1][1]); b0.w = pk(acc[1][2], acc[1][3]); \
        b1.x = pk(acc[2][0], acc[2][1]); b1.y = pk(acc[2][2], acc[2][3]); b1.z = pk(acc[3][0], acc[3][1]); b1.w = pk(acc[3][2], acc[3][3]); \
        const v4u b3 = (v4u){P##vv.x, P##vv.y, 0u, 0u}, a3a = (v4u){P##a3.x, P##a3.y, 0u, 0u}, a3y = (v4u){P##a3.z, P##a3.w, 0u, 0u}; \
        const f32x4 zf_ = (f32x4){0.f, 0.f, 0.f, 0.f}; \
        f32x4 da = MFMA16(__builtin_bit_cast(bf16x8, a3a), __builtin_bit_cast(bf16x8, b3), zf_), dy = MFMA16(__builtin_bit_cast(bf16x8, a3y), __builtin_bit_cast(bf16x8, b3), zf_);     \
        da = MFMA16(__builtin_bit_cast(bf16x8, P##aq0), __builtin_bit_cast(bf16x8, b0), da); \
        const f32x4 da2 = MFMA16(__builtin_bit_cast(bf16x8, P##aq1), __builtin_bit_cast(bf16x8, b1), zf_);                    \
        dy = MFMA16(__builtin_bit_cast(bf16x8, P##ar0), __builtin_bit_cast(bf16x8, b0), dy); dy = MFMA16(__builtin_bit_cast(bf16x8, P##ar1), __builtin_bit_cast(bf16x8, b1), dy); \
        da = da + da2; \
        acc[0] = acc[0] * P##w0; acc[1] = acc[1] * P##w1; acc[2] = acc[2] * P##w2; acc[3] = acc[3] * P##w3; \
        const v4u bc = (v4u){pk(da[0], da[1]), pk(da[2], da[3]), P##vv.x, P##vv.y};        \
        acc[0] = MFMA16(__builtin_bit_cast(bf16x8, P##ak0), __builtin_bit_cast(bf16x8, bc), acc[0]); acc[1] = MFMA16(__builtin_bit_cast(bf16x8, P##ak1), __builtin_bit_cast(bf16x8, bc), acc[1]); \
        acc[2] = MFMA16(__builtin_bit_cast(bf16x8, P##ak2), __builtin_bit_cast(bf16x8, bc), acc[2]); acc[3] = MFMA16(__builtin_bit_cast(bf16x8, P##ak3), __builtin_bit_cast(bf16x8, bc), acc[3]); \
        if (lead) { bf16* yq = yp + (size_t)(T0) * 512; const unsigned p01 = pk(dy[0], dy[1]), p23 = pk(dy[2], dy[3]); \
            yq[0] = (bf16)(p01 & 0xffffu); yq[512] = (bf16)(p01 >> 16); yq[1024] = (bf16)(p23 & 0xffffu); yq[1536] = (bf16)(p23 >> 16); } } while (0)
#define SB_WAIT(SQ) do { for (;;) { const unsigned m_ = min(min(FL[0], FL[1]), min(FL[2], FL[3])); if ((int)__builtin_amdgcn_readfirstlane(m_) >= (SQ) + 1) break; __builtin_amdgcn_s_sleep(1); } asm volatile("" ::: "memory"); } while (0)
        SB_DECL(A_) SB_DECL(B_)
        int ringoff = 0;
        SB_WAIT(0); SB_LOAD(A_, lds);
#pragma unroll 1
        for (int sq = 0; sq < SC_NSEQ; ++sq) {
            const LAS unsigned char* sb = lds + ringoff; const int t0 = sq * SC_STEPS;
            int nxt = ringoff + SC_SLOT; if (nxt == SC_NSLOT * SC_SLOT) nxt = 0;
            SB_LOAD(B_, sb + 3072); SB_COMPUTE(A_, t0);
            SB_LOAD(A_, sb + 6144); SB_COMPUTE(B_, t0 + 4);
            SB_LOAD(B_, sb + 9216); SB_COMPUTE(A_, t0 + 8);
            if (sq + 1 < SC_NSEQ) { SB_WAIT(sq + 1); SB_LOAD(A_, lds + nxt); }
            SB_COMPUTE(B_, t0 + 12);
            asm volatile("s_waitcnt lgkmcnt(0)" ::: "memory");
            if (lane == 0) FL[4 + w] = (unsigned)(sq + 1);
            ringoff = nxt;
        }
        if (kind == 0) { bf16* sm = (bf16*)(a.ws + WS_SMID) + (size_t)(bh * 64 + 16 * w + r16) * 64 + 4 * q4;
#pragma unroll
            for (int jt = 0; jt < 4; ++jt) { v2u o; o.x = pk(acc[jt][0], acc[jt][1]); o.y = pk(acc[jt][2], acc[jt][3]); *(v2u*)(sm + 16 * jt) = o; } }
    }
    __syncthreads();
}
DI void rwkv_post_row(const Args& a, int l, int m, int lane) {
    const int c = 8 * lane, h = lane >> 3, j0 = c & 63;
    bf16* yrow = (bf16*)(a.ws + WS_OA) + (size_t)m * 512 + c;
    float y[8], g[8]; unpack8(*(const v4u*)yrow, y); unpack8(*(const v4u*)((const bf16*)(a.ws + WS_G) + (size_t)m * 512 + c), g);
    const bf16* vvp = (const bf16*)(a.ws + WS_REC + ((size_t)((m >> 13) * 8 + h) * 2048 + ((m & (SEQ - 1)) >> 2)) * 3072 + 2560) + (size_t)j0 * 4 + (m & 3);
    float vrow[8];
#pragma unroll
    for (int e = 0; e < 8; ++e) vrow[e] = bflo((unsigned)vvp[e * 4]);
    const float bon = ((const float*)(a.ws + WS_BON))[m * 8 + h];
    float sm = 0.f;
#pragma unroll
    for (int e = 0; e < 8; ++e) sm += y[e];
    const float mean = oct_sum(sm) * (1.f / 64.f);
    float sv = 0.f;
#pragma unroll
    for (int e = 0; e < 8; ++e) { y[e] -= mean; sv += y[e] * y[e]; }
    const float rstd = rsqrtf(oct_sum(sv) * (1.f / 64.f) + 64e-5f);
    const f32x4 lw0 = *(const f32x4*)(a.in[I_LNW] + l * 512 + c), lw1 = *(const f32x4*)(a.in[I_LNW] + l * 512 + c + 4);
    const f32x4 lb0 = *(const f32x4*)(a.in[I_LNB] + l * 512 + c), lb1 = *(const f32x4*)(a.in[I_LNB] + l * 512 + c + 4);
    float o[8];
#pragma unroll
    for (int e = 0; e < 8; ++e) { const float lw = e < 4 ? lw0[e & 3] : lw1[e & 3], lb = e < 4 ? lb0[e & 3] : lb1[e & 3];
        const float v = vrow[e];
        o[e] = (y[e] * rstd * lw + lb + bon * v) * g[e]; }
    v4u w; w.x = pk(o[0], o[1]); w.y = pk(o[2], o[3]); w.z = pk(o[4], o[5]); w.w = pk(o[6], o[7]);
    *(v4u*)yrow = w;
}
DI void scan_fixup(const Args& a, int m0, int lane) {
    const int r16 = lane & 15, q4 = lane >> 4, b = m0 >> 13, mt = m0 + (r16 & 7);
    const bf16* U = (const bf16*)(a.ws + WS_XN) + (size_t)mt * 512; bf16* Y = (bf16*)(a.ws + WS_OA) + (size_t)mt * 512;
#pragma unroll 1
    for (int h = 0; h < 8; ++h) {
        const bf16* sm = (const bf16*)(a.ws + WS_SMID) + (size_t)((b * 8 + h) * 64 + r16) * 64 + q4 * 8;
        bf16x8 ub[2], sa[4][2]; v2u yo[4];
#pragma unroll
        for (int ks = 0; ks < 2; ++ks) { ub[ks] = *(const bf16x8*)(U + h * 64 + ks * 32 + q4 * 8);
#pragma unroll
            for (int it = 0; it < 4; ++it) sa[it][ks] = *(const bf16x8*)(sm + (size_t)it * 16 * 64 + ks * 32); }
#pragma unroll
        for (int it = 0; it < 4; ++it) yo[it] = *(const v2u*)(Y + h * 64 + 16 * it + 4 * q4);
        __builtin_amdgcn_sched_barrier(0);
#pragma unroll
        for (int it = 0; it < 4; ++it) { f32x4 d = (f32x4){0.f, 0.f, 0.f, 0.f};
#pragma unroll
            for (int ks = 0; ks < 2; ++ks) d = MFMA16(sa[it][ks], ub[ks], d);
            v2u o; o.x = pk(bflo(yo[it].x) + d[0], bfhi(yo[it].x) + d[1]); o.y = pk(bflo(yo[it].y) + d[2], bfhi(yo[it].y) + d[3]);
            if (r16 < 8) *(v2u*)(Y + h * 64 + 16 * it + 4 * q4) = o; }
    }
}
DI void p_post(const Args& a, int l, int tid) {
    const int lane = tid & 63, gw = blockIdx.x * NWAVES + (tid >> 6), NGW = gridDim.x * NWAVES;
    for (int g0 = gw; g0 < M / 8; g0 += NGW) {
        const int j_ = g0 & (SEQ / 8 - 1), w_ = j_ & 7, hf_ = (w_ ^ (w_ >> 2)) & 1, rk_ = __popc((hf_ ? 0x5Au : 0xA5u) & ((1u << w_) - 1u));
        const int grp = g0 - j_ + hf_ * (SEQ / 16) + (j_ >> 3) * 4 + rk_, m0 = grp * 8;
        if ((m0 & (SEQ - 1)) >= SEQ / 2) { scan_fixup(a, m0, lane); __threadfence(); }
#pragma unroll 1
        for (int t = 0; t < 8; ++t) rwkv_post_row(a, l, m0 + t, lane);
    }
}
constexpr int KP = 144, VP = 136;
constexpr int L_KT0 = 0, L_VT0 = 9216, L_KT1 = 17920, L_VT1 = 27136, L_IMP = 35840, L_SELM = 68864, L_UNI = 69888, L_LIST = 69920, L_NLIST = 70432, L_LUT = 70448, L_FARB = 72512, L_Q = 73728;
DI void load_kv_regs(const bf16* Ksrc, size_t kp, const bf16* Vsrc, size_t vp, int row0, int tid, v4u& kr, v4u& vr) {
    const int key = tid >> 3, ch = tid & 7;
    kr = *(const v4u*)(Ksrc + (size_t)(row0 + key) * kp + ch * 8); vr = *(const v4u*)(Vsrc + (size_t)(row0 + key) * vp + ch * 8);
}
DI void store_kv_lds(LAS unsigned char* Kt, LAS unsigned char* Vt, int tid, v4u kr, v4u vr) {
    const int key = tid >> 3, ch = tid & 7;
    *(LAS v4u*)(Kt + key * KP + ch * 16) = kr;
    *(LAS v4u*)(Vt + (ch >> 2) * 4096 + key * 64 + (ch & 3) * 16) = vr;
}
DI void load_q(const bf16* qrow, float qs, int hh, LAS unsigned char* qf) {
_Pragma("unroll")
    for (int ks = 0; ks < 4; ++ks) { float z[8]; unpack8(*(const v4u*)(qrow + ks * 16 + hh * 8), z);
_Pragma("unroll")
        for (int e = 0; e < 8; ++e) z[e] *= qs;
        *(LAS bf16x8*)(qf + ks * 8192) = pack8(z); }
}
DI void qk_tile(const LAS unsigned char* Kt, const LAS unsigned char* qf, int r, int hh, f32x16& s0, f32x16& s1) {
_Pragma("unroll")
    for (int i = 0; i < 16; ++i) { s0[i] = 0.f; s1[i] = 0.f; }
_Pragma("unroll")
    for (int ks = 0; ks < 4; ++ks) {
        const bf16x8 a0 = *(const LAS bf16x8*)(Kt + r * KP + (ks * 16 + hh * 8) * 2), a1 = *(const LAS bf16x8*)(Kt + (32 + r) * KP + (ks * 16 + hh * 8) * 2);
        const bf16x8 qv = *(const LAS bf16x8*)(qf + ks * 8192);
        s0 = MFMA32(a0, qv, s0); s1 = MFMA32(a1, qv, s1); }
}
DI void qk_tile_r(const LAS unsigned char* Kt, const bf16x8 (&qr)[4], int r, int hh, f32x16& s0, f32x16& s1) {
_Pragma("unroll")
    for (int i = 0; i < 16; ++i) { s0[i] = 0.f; s1[i] = 0.f; }
_Pragma("unroll")
    for (int ks = 0; ks < 4; ++ks) {
        const bf16x8 a0 = *(const LAS bf16x8*)(Kt + r * KP + (ks * 16 + hh * 8) * 2), a1 = *(const LAS bf16x8*)(Kt + (32 + r) * KP + (ks * 16 + hh * 8) * 2);
        s0 = MFMA32(a0, qr[ks], s0); s1 = MFMA32(a1, qr[ks], s1); }
}
typedef short v4i16_t __attribute__((ext_vector_type(4)));
DI v2u vtr(const LAS unsigned char* p) { return __builtin_bit_cast(v2u, __builtin_amdgcn_ds_read_tr16_b64_v4i16((LAS v4i16_t*)p)); }
DI void pv_tile(const LAS unsigned char* Vt, const f32x16& p0, const f32x16& p1, int r, int hh, f32x16& o0, f32x16& o1) {
    const LAS unsigned char* vp = Vt + ((r >> 4) & 1) * 32 + (r & 3) * 8 + (4 * hh + ((r & 15) >> 2)) * 64;
_Pragma("unroll")
    for (int kk = 0; kk < 4; ++kk) {
        float z[8];
_Pragma("unroll")
        for (int e = 0; e < 8; ++e) z[e] = (kk < 2) ? p0[8 * (kk & 1) + e] : p1[8 * (kk & 1) + e];
        const bf16x8 pf = pack8(z);
_Pragma("unroll")
        for (int dt = 0; dt < 2; ++dt) {
            const v2u lo = vtr(vp + dt * 4096 + kk * 1024), hi = vtr(vp + dt * 4096 + kk * 1024 + 512);
            const bf16x8 af = __builtin_bit_cast(bf16x8, ((v4u){lo.x, lo.y, hi.x, hi.y}));
            if (dt == 0) o0 = MFMA32(af, pf, o0); else o1 = MFMA32(af, pf, o1); }
    }
}
DI float max3(float a, float b, float c) { float d; asm("v_max3_f32 %0, %1, %2, %3" : "=v"(d) : "v"(a), "v"(b), "v"(c)); return d; }
DI float tile_max(const f32x16& s0, const f32x16& s1) {
    float bm = max3(s0[0], s1[0], s1[0]);
_Pragma("unroll")
    for (int i = 1; i < 16; ++i) bm = max3(bm, s0[i], s1[i]);
    return bm;
}
DI float tile_exp(f32x16& s0, f32x16& s1, float off) {
    const f32x2 off2 = (f32x2){off, off}; f32x2 ps2 = (f32x2){0.f, 0.f};
_Pragma("unroll")
    for (int i = 0; i < 16; i += 2) {
        f32x2 t = (f32x2){s0[i], s0[i + 1]} + off2, u = (f32x2){s1[i], s1[i + 1]} + off2;
        t.x = __builtin_amdgcn_exp2f(t.x); t.y = __builtin_amdgcn_exp2f(t.y); u.x = __builtin_amdgcn_exp2f(u.x); u.y = __builtin_amdgcn_exp2f(u.y);
        s0[i] = t.x; s0[i + 1] = t.y; s1[i] = u.x; s1[i + 1] = u.y; ps2 += t; ps2 += u; }
    return ps2.x + ps2.y;
}
DI void sm_update(f32x16& s0, f32x16& s1, float& m, float& lp, f32x16& o0, f32x16& o1) {
    float bm = tile_max(s0, s1);
    bm = max3(bm, __shfl_xor(bm, 32), NEG_INF);
    const float mn = fmaxf(m, bm), ms = (mn == NEG_INF) ? 0.f : mn;
    const float alpha = __builtin_amdgcn_exp2f(m - ms);
    const float ps = tile_exp(s0, s1, -ms);
    lp = lp * alpha + ps; m = mn;
    if (__builtin_amdgcn_ballot_w64(alpha != 1.0f) != 0ull) {
_Pragma("unroll")
        for (int i = 0; i < 16; ++i) { o0[i] *= alpha; o1[i] *= alpha; } }
}
DI void sm_update_row(f32x16& s0, f32x16& s1, float brow, float& m, float& lp, f32x16& o0, f32x16& o1) {
    float bm = tile_max(s0, s1);
    bm = max3(bm, __shfl_xor(bm, 32), NEG_INF) + brow;
    const float mn = fmaxf(m, bm), ms = (mn == NEG_INF) ? 0.f : mn;
    const float alpha = __builtin_amdgcn_exp2f(m - ms), off = brow - ms;
    const float ps = tile_exp(s0, s1, off);
    lp = lp * alpha + ps; m = mn;
    if (__builtin_amdgcn_ballot_w64(alpha != 1.0f) != 0ull) {
_Pragma("unroll")
        for (int i = 0; i < 16; ++i) { o0[i] *= alpha; o1[i] *= alpha; } }
}
DI void sm_pv(f32x16& s0, f32x16& s1, float brow, float& m, float& lp, f32x16& o0, f32x16& o1, const LAS unsigned char* Vt, int r, int hh) {
    float bm = tile_max(s0, s1);
    bm = max3(bm, __shfl_xor(bm, 32), NEG_INF) + brow;
    const float mn = fmaxf(m, bm), ms = (mn == NEG_INF) ? 0.f : mn;
    const float alpha = __builtin_amdgcn_exp2f(m - ms), off = brow - ms;
    if (__builtin_amdgcn_ballot_w64(alpha != 1.0f) != 0ull) {
_Pragma("unroll")
        for (int i = 0; i < 16; ++i) { o0[i] *= alpha; o1[i] *= alpha; } }
    const LAS unsigned char* vp = Vt + ((r >> 4) & 1) * 32 + (r & 3) * 8 + (4 * hh + ((r & 15) >> 2)) * 64;
    const f32x2 off2 = (f32x2){off, off}; f32x2 ps2 = (f32x2){0.f, 0.f};
_Pragma("unroll")
    for (int kk = 0; kk < 4; ++kk) {
        const v2u lo0 = vtr(vp + kk * 1024), hi0 = vtr(vp + kk * 1024 + 512), lo1 = vtr(vp + 4096 + kk * 1024), hi1 = vtr(vp + 4096 + kk * 1024 + 512);
        v4u pw;
_Pragma("unroll")
        for (int j = 0; j < 4; ++j) { const int i = 8 * (kk & 1) + 2 * j;
            f32x2 t = ((kk < 2) ? (f32x2){s0[i], s0[i + 1]} : (f32x2){s1[i], s1[i + 1]}) + off2;
            t.x = __builtin_amdgcn_exp2f(t.x); t.y = __builtin_amdgcn_exp2f(t.y); ps2 += t; pw[j] = pk(t.x, t.y); }
        const bf16x8 pf = __builtin_bit_cast(bf16x8, pw);
        o0 = MFMA32(__builtin_bit_cast(bf16x8, ((v4u){lo0.x, lo0.y, hi0.x, hi0.y})), pf, o0);
        o1 = MFMA32(__builtin_bit_cast(bf16x8, ((v4u){lo1.x, lo1.y, hi1.x, hi1.y})), pf, o1);
        __builtin_amdgcn_sched_barrier(0);
    }
    lp = lp * alpha + (ps2.x + ps2.y); m = mn;
}
__device__ __forceinline__ float xmax_rows(float v) {
    float a = v, b = v;
    asm volatile("s_nop 1\n\tv_permlane16_swap_b32 %0, %1" : "+v"(a), "+v"(b));
    a = fmaxf(a, b); b = a;
    asm volatile("s_nop 1\n\tv_permlane32_swap_b32 %0, %1" : "+v"(a), "+v"(b));
    return fmaxf(a, b);
}
#define SEL16_GROUP(MINE, SLOT, SW, TQ, MR, LR, OO, PP) if (MINE) { \
                    const bf16x8 q0 = qreg[SLOT], q1 = qreg[(SLOT) + 1]; \
                    f32x4 s[4]; \
                    _Pragma("unroll") for (int kt = 0; kt < 4; ++kt) { s[kt] = MFMA16(kf[kt][0], q0, ((f32x4){0.f, 0.f, 0.f, 0.f})); s[kt] = MFMA16(kf[kt][1], q1, s[kt]); } \
                    const unsigned swd = n < 32 ? SW[0] : (n < 64 ? SW[1] : (n < 96 ? SW[2] : SW[3])); \
                    const bool selq = (swd >> (n & 31)) & 1u; \
                    float brow = selq ? farb2 : NEG_INF; \
                    if ((cur - n) < 3) { brow = 0.f; \
                        float bb_[4][4]; \
                        _Pragma("unroll") for (int kt = 0; kt < 4; ++kt) _Pragma("unroll") for (int jj = 0; jj < 4; ++jj) { const int d0 = (TQ) - (kv0 + 16 * kt + 4 * q4 + jj); \
                            bb_[kt][jj] = LUT[head2 * 129 + (int)min((unsigned)d0, 128u)]; } \
                        asm volatile("" : "+v"(bb_[0][0]), "+v"(bb_[0][1]), "+v"(bb_[0][2]), "+v"(bb_[0][3]), "+v"(bb_[1][0]), "+v"(bb_[1][1]), "+v"(bb_[1][2]), "+v"(bb_[1][3]), \
                                          "+v"(bb_[2][0]), "+v"(bb_[2][1]), "+v"(bb_[2][2]), "+v"(bb_[2][3]), "+v"(bb_[3][0]), "+v"(bb_[3][1]), "+v"(bb_[3][2]), "+v"(bb_[3][3])); \
                        _Pragma("unroll") for (int kt = 0; kt < 4; ++kt) _Pragma("unroll") for (int jj = 0; jj < 4; ++jj) { const int d0 = (TQ) - (kv0 + 16 * kt + 4 * q4 + jj); \
                            s[kt][jj] = (selq && d0 >= 0) ? s[kt][jj] + bb_[kt][jj] : NEG_INF; } } \
                    float bm = max3(s[0][0], s[0][1], s[0][2]); \
                    bm = max3(bm, s[0][3], s[1][0]); bm = max3(bm, s[1][1], s[1][2]); bm = max3(bm, s[1][3], s[2][0]); bm = max3(bm, s[2][1], s[2][2]); bm = max3(bm, s[2][3], s[3][0]); \
                    bm = max3(bm, s[3][1], s[3][2]); bm = fmaxf(bm, s[3][3]); \
                    bm = xmax_rows(bm); \
                    bm += brow; \
                    const float mn = fmaxf(MR, bm), ms = (mn == NEG_INF) ? 0.f : mn; \
                    const float alpha = __builtin_amdgcn_exp2f(MR - ms), off = brow - ms; \
                    f32x2 ps2 = (f32x2){0.f, 0.f}; const f32x2 off2 = (f32x2){off, off}; \
                    _Pragma("unroll") for (int kt = 0; kt < 4; ++kt) { f32x2 t0_ = (f32x2){s[kt][0], s[kt][1]} + off2, t1_ = (f32x2){s[kt][2], s[kt][3]} + off2; \
                        t0_.x = __builtin_amdgcn_exp2f(t0_.x); t0_.y = __builtin_amdgcn_exp2f(t0_.y); t1_.x = __builtin_amdgcn_exp2f(t1_.x); t1_.y = __builtin_amdgcn_exp2f(t1_.y); \
                        ps2 += t0_; ps2 += t1_; s[kt][0] = t0_.x; s[kt][1] = t0_.y; s[kt][2] = t1_.x; s[kt][3] = t1_.y; } \
                    LR = LR * alpha + (ps2.x + ps2.y); MR = mn; \
                    if (__builtin_amdgcn_ballot_w64(alpha != 1.0f) != 0ull) { _Pragma("unroll") for (int dt = 0; dt < 4; ++dt) OO[dt] *= alpha; } \
                    _Pragma("unroll") for (int sK = 0; sK < 2; ++sK) { v4u pw; pw.x = pk(s[2 * sK][0], s[2 * sK][1]); pw.y = pk(s[2 * sK][2], s[2 * sK][3]); pw.z = pk(s[2 * sK + 1][0], s[2 * sK + 1][1]); pw.w = pk(s[2 * sK + 1][2], s[2 * sK + 1][3]); \
                        PP[sK] = __builtin_bit_cast(bf16x8, pw); } }
#define KV_PAIR_LOOP(NBLK, ROW0_OF, KSRC, KPITCH, VSRC, VPITCH, ...) do { const int nb_ = (NBLK); if (nb_ > 0) { const int np_ = (nb_ + 1) >> 1; v4u ka0_, va0_, ka1_, va1_, kb0_, vb0_, kb1_, vb1_; \
    { const int i_ = 0; load_kv_regs((KSRC), (KPITCH), (VSRC), (VPITCH), (ROW0_OF), tid, ka0_, va0_); } \
    { const int i_ = min(1, nb_ - 1); load_kv_regs((KSRC), (KPITCH), (VSRC), (VPITCH), (ROW0_OF), tid, ka1_, va1_); } \
    { const int i_ = min(2, nb_ - 1); load_kv_regs((KSRC), (KPITCH), (VSRC), (VPITCH), (ROW0_OF), tid, kb0_, vb0_); } \
    { const int i_ = min(3, nb_ - 1); load_kv_regs((KSRC), (KPITCH), (VSRC), (VPITCH), (ROW0_OF), tid, kb1_, vb1_); } \
    store_kv_lds(lds + L_KT0, lds + L_VT0, tid, ka0_, va0_); store_kv_lds(lds + L_KT1, lds + L_VT1, tid, ka1_, va1_); __syncthreads(); \
    for (int ipp_ = 0; ipp_ < np_; ipp_ += 2) { \
        { const int i_ = min(2 * ipp_ + 4, nb_ - 1); load_kv_regs((KSRC), (KPITCH), (VSRC), (VPITCH), (ROW0_OF), tid, ka0_, va0_); } \
        { const int i_ = min(2 * ipp_ + 5, nb_ - 1); load_kv_regs((KSRC), (KPITCH), (VSRC), (VPITCH), (ROW0_OF), tid, ka1_, va1_); } \
        { const int ip_ = ipp_; __VA_ARGS__ } \
        __syncthreads(); \
        store_kv_lds(lds + L_KT0, lds + L_VT0, tid, kb0_, vb0_); store_kv_lds(lds + L_KT1, lds + L_VT1, tid, kb1_, vb1_); \
        __syncthreads(); \
        { const int i_ = min(2 * ipp_ + 6, nb_ - 1); load_kv_regs((KSRC), (KPITCH), (VSRC), (VPITCH), (ROW0_OF), tid, kb0_, vb0_); } \
        { const int i_ = min(2 * ipp_ + 7, nb_ - 1); load_kv_regs((KSRC), (KPITCH), (VSRC), (VPITCH), (ROW0_OF), tid, kb1_, vb1_); } \
        if (ipp_ + 1 < np_) { const int ip_ = ipp_ + 1; __VA_ARGS__ } \
        __syncthreads(); \
        store_kv_lds(lds + L_KT0, lds + L_VT0, tid, ka0_, va0_); store_kv_lds(lds + L_KT1, lds + L_VT1, tid, ka1_, va1_); \
        __syncthreads(); } \
    asm volatile("s_waitcnt vmcnt(0)" ::: "memory"); } } while (0)
#define KV_LOOP2(NBLK, ROW0_OF, KSRC, KPITCH, VSRC, VPITCH, ...) do { const int nb_ = (NBLK); if (nb_ > 0) { v4u kra_, vra_, krb_, vrb_; \
      \
    { const int i_ = 0; load_kv_regs((KSRC), (KPITCH), (VSRC), (VPITCH), (ROW0_OF), tid, kra_, vra_); } \
    { const int i_ = min(1, nb_ - 1); load_kv_regs((KSRC), (KPITCH), (VSRC), (VPITCH), (ROW0_OF), tid, krb_, vrb_); } \
    store_kv_lds(lds + L_KT0, lds + L_VT0, tid, kra_, vra_); __syncthreads(); \
    for (int ib_ = 0; ib_ < nb_; ib_ += 2) { \
        { const int i_ = min(ib_ + 2, nb_ - 1); load_kv_regs((KSRC), (KPITCH), (VSRC), (VPITCH), (ROW0_OF), tid, kra_, vra_); } \
        { const int i_ = ib_; const LAS unsigned char* Kt = lds + L_KT0; const LAS unsigned char* Vt = lds + L_VT0; __VA_ARGS__ } \
        store_kv_lds(lds + L_KT1, lds + L_VT1, tid, krb_, vrb_); \
        __syncthreads(); \
        { const int i_ = min(ib_ + 3, nb_ - 1); load_kv_regs((KSRC), (KPITCH), (VSRC), (VPITCH), (ROW0_OF), tid, krb_, vrb_); } \
        if (ib_ + 1 < nb_) { const int i_ = ib_ + 1; const LAS unsigned char* Kt = lds + L_KT1; const LAS unsigned char* Vt = lds + L_VT1; __VA_ARGS__ } \
        store_kv_lds(lds + L_KT0, lds + L_VT0, tid, kra_, vra_); \
        __syncthreads(); } \
    asm volatile("s_waitcnt vmcnt(0)" ::: "memory"); } } while (0)
#define KV_LOOP(NBLK, ROW0_OF, KSRC, KPITCH, VSRC, VPITCH, ...) do { const int nb_ = (NBLK); if (nb_ > 0) { v4u kr_, vr_; \
    { const int i_ = 0; load_kv_regs((KSRC), (KPITCH), (VSRC), (VPITCH), (ROW0_OF), tid, kr_, vr_); } \
    store_kv_lds(lds + L_KT0, lds + L_VT0, tid, kr_, vr_); __syncthreads(); \
    for (int ib_ = 0; ib_ < nb_; ++ib_) { \
        if (ib_ + 1 < nb_) { const int i_ = ib_ + 1; load_kv_regs((KSRC), (KPITCH), (VSRC), (VPITCH), (ROW0_OF), tid, kr_, vr_); } \
        { const int i_ = ib_; const LAS unsigned char* Kt = lds + ((ib_ & 1) ? L_KT1 : L_KT0); const LAS unsigned char* Vt = lds + ((ib_ & 1) ? L_VT1 : L_VT0); __VA_ARGS__ } \
        if (ib_ + 1 < nb_) store_kv_lds(lds + ((ib_ & 1) ? L_KT0 : L_KT1), lds + ((ib_ & 1) ? L_VT0 : L_VT1), tid, kr_, vr_); \
        __syncthreads(); } } } while (0)

DI void store_o(bf16* orow, const f32x16& v0, const f32x16& v1, int hh) {
_Pragma("unroll")
    for (int g4 = 0; g4 < 4; ++g4) {
        v2u w; w.x = pk(v0[4 * g4], v0[4 * g4 + 1]); w.y = pk(v0[4 * g4 + 2], v0[4 * g4 + 3]); *(v2u*)(orow + 8 * g4 + 4 * hh) = w;
        w.x = pk(v1[4 * g4], v1[4 * g4 + 1]); w.y = pk(v1[4 * g4 + 2], v1[4 * g4 + 3]); *(v2u*)(orow + 32 + 8 * g4 + 4 * hh) = w; }
}

DI void add_o(bf16* orow, const f32x16& v0, const f32x16& v1, int hh) {
_Pragma("unroll")
    for (int g4 = 0; g4 < 4; ++g4) {
        v2u* p0 = (v2u*)(orow + 8 * g4 + 4 * hh); v2u* p1 = (v2u*)(orow + 32 + 8 * g4 + 4 * hh); const v2u a0 = *p0, a1 = *p1; v2u w;
        w.x = pk(bflo(a0.x) + v0[4 * g4], bfhi(a0.x) + v0[4 * g4 + 1]); w.y = pk(bflo(a0.y) + v0[4 * g4 + 2], bfhi(a0.y) + v0[4 * g4 + 3]); *p0 = w;
        w.x = pk(bflo(a1.x) + v1[4 * g4], bfhi(a1.x) + v1[4 * g4 + 1]); w.y = pk(bflo(a1.y) + v1[4 * g4 + 2], bfhi(a1.y) + v1[4 * g4 + 3]); *p1 = w; }
}
DI void nsa_tile(const Args& a, int l, int b, int g, int qt, LAS unsigned char* lds, int tid) {
    asm volatile("" : "+v"(tid));
    const int lane = tid & 63, w = tid >> 6, r = lane & 31, hh = lane >> 5, head = w >> 1, ql = 32 * (w & 1) + r;
    const int t0 = qt * 64, cur = qt, tq = t0 + ql, mq = b * SEQ + tq;
    const bf16* PROJ = (const bf16*)(a.ws + WS_PROJ);
    LAS unsigned* IMP = (LAS unsigned*)(lds + L_IMP); LAS unsigned* SELM = (LAS unsigned*)(lds + L_SELM); LAS unsigned* UNI = (LAS unsigned*)(lds + L_UNI);
    LAS int* LIST = (LAS int*)(lds + L_LIST); LAS int* NLIST = (LAS int*)(lds + L_NLIST); LAS float* LUT = (LAS float*)(lds + L_LUT); LAS float* FARB = (LAS float*)(lds + L_FARB);
    { const int hh_ = tid >> 7, dist = tid & 127; LUT[hh_ * 129 + dist] = a.in[I_REL][(int)T5_BK[dist] * 16 + g * 4 + hh_] * LOG2E;
      if (tid < 4) { const float fb = a.in[I_REL][31 * 16 + g * 4 + tid] * LOG2E; FARB[tid] = fb; LUT[tid * 129 + 128] = fb; } }
    for (int i = tid; i < 64 * 129; i += NT) IMP[i] = 0u;
    if (tid < 4) UNI[tid] = 0u;
    LAS unsigned char* qf = lds + L_Q + tid * 16; asm volatile("" : "+v"(qf));
    load_q(PROJ + (size_t)mq * NP + C_NQ + (g * 4 + head) * 64, 0.125f * LOG2E, hh, qf);
    bf16* orow = (bf16*)(a.ws + WS_OB) + (size_t)mq * 512 + (g * 4 + head) * 64;
    float gc, gs, gw_;
    { const bf16* gp = PROJ + (size_t)mq * NP + C_NG + (g * 4 + head) * 3; gc = sigm(bflo((unsigned)gp[0])); gs = sigm(bflo((unsigned)gp[1])); gw_ = sigm(bflo((unsigned)gp[2])); }
    f32x16 o0, o1, s0, s1;
    __syncthreads();
    const bf16* Kc = (const bf16*)(a.ws + WS_KCMP) + (size_t)((b * 2 + g) * 512) * 64; const bf16* Vc = (const bf16*)(a.ws + WS_VCMP) + (size_t)((b * 2 + g) * 512) * 64;
    int ncv = 4 * cur + 3; ncv = ncv < 511 ? ncv : 511;
    const int ncb = (ncv + 63) >> 6;
    float m = NEG_INF, lp = 0.f;
    KV_LOOP(ncb, i_ * 64, Kc, 64, Vc, 64, {
        qk_tile(Kt, qf, r, hh, s0, s1);
_Pragma("unroll")
        for (int i = 0; i < 16; ++i) { const int c0 = i_ * 64 + crow(i, hh), c1 = c0 + 32;
            s0[i] = (16 * c0 + 31 <= tq && c0 < 511) ? s0[i] : NEG_INF; s1[i] = (16 * c1 + 31 <= tq && c1 < 511) ? s1[i] : NEG_INF; }
_Pragma("unroll")
        for (int i = 0; i < 16; ++i) { o0[i] = 0.f; o1[i] = 0.f; }
        sm_update(s0, s1, m, lp, o0, o1);
    });
    {
        const float lt = lp + __shfl_xor(lp, 32), inv = lt > 0.f ? 1.0f / lt : 0.f, ms = (m == NEG_INF) ? 0.f : m;
_Pragma("unroll")
        for (int i = 0; i < 16; ++i) { o0[i] = 0.f; o1[i] = 0.f; }
        KV_LOOP(ncb, i_ * 64, Kc, 64, Vc, 64, {
            qk_tile(Kt, qf, r, hh, s0, s1);
_Pragma("unroll")
            for (int i = 0; i < 16; ++i) { const int c0 = i_ * 64 + crow(i, hh), c1 = c0 + 32;
                s0[i] = (16 * c0 + 31 <= tq && c0 < 511) ? __builtin_amdgcn_exp2f(s0[i] - ms) * inv : 0.f; s1[i] = (16 * c1 + 31 <= tq && c1 < 511) ? __builtin_amdgcn_exp2f(s1[i] - ms) * inv : 0.f; }
_Pragma("unroll")
            for (int g4 = 0; g4 < 4; ++g4) {
                const int n0 = i_ * 16 + 2 * g4 + hh, n1 = n0 + 8;
                const float G0 = (s0[4 * g4] + s0[4 * g4 + 1]) + (s0[4 * g4 + 2] + s0[4 * g4 + 3]), G1 = (s1[4 * g4] + s1[4 * g4 + 1]) + (s1[4 * g4 + 2] + s1[4 * g4 + 3]);
                __hip_atomic_fetch_add(IMP + ql * 129 + n0, (unsigned)(G0 * 1048576.f + 0.5f), __ATOMIC_RELAXED, __HIP_MEMORY_SCOPE_WORKGROUP);
                __hip_atomic_fetch_add(IMP + ql * 129 + n0 + 1, (unsigned)(s0[4 * g4 + 3] * 1048576.f + 0.5f), __ATOMIC_RELAXED, __HIP_MEMORY_SCOPE_WORKGROUP);
                __hip_atomic_fetch_add(IMP + ql * 129 + n1, (unsigned)(G1 * 1048576.f + 0.5f), __ATOMIC_RELAXED, __HIP_MEMORY_SCOPE_WORKGROUP);
                __hip_atomic_fetch_add(IMP + ql * 129 + n1 + 1, (unsigned)(s1[4 * g4 + 3] * 1048576.f + 0.5f), __ATOMIC_RELAXED, __HIP_MEMORY_SCOPE_WORKGROUP); }
            pv_tile(Vt, s0, s1, r, hh, o0, o1);
        });
_Pragma("unroll")
        for (int i = 0; i < 16; ++i) { o0[i] *= gc; o1[i] *= gc; }
        store_o(orow, o0, o1, hh);
    }
    __syncthreads();
    {
        const int nforced = cur == 0 ? 1 : (cur == 1 ? 2 : 3), need = 16 - nforced, cnt = cur + 1 - nforced;
        for (int qq = 0; qq < 8; ++qq) { const int q = 8 * w + qq;
            const int n0 = lane, n1 = lane + 64;
            const bool f0 = (n0 == 0) || (n0 == cur) || (n0 == cur - 1), f1 = (n1 == cur) || (n1 == cur - 1);
            const bool v0 = n0 <= cur, v1 = n1 <= cur;
            unsigned i0 = IMP[q * 129 + n0], i1 = IMP[q * 129 + n1]; i0 = i0 < 0x1FFFFFEu ? i0 : 0x1FFFFFEu; i1 = i1 < 0x1FFFFFEu ? i1 : 0x1FFFFFEu;
            const unsigned k0 = (v0 && !f0) ? ((i0 << 7) | (unsigned)(127 - n0)) + 1u : 0u, k1 = (v1 && !f1) ? ((i1 << 7) | (unsigned)(127 - n1)) + 1u : 0u;
            unsigned T = 1u;
            if (cnt > need) { T = 0u;
                for (int bit = 31; bit >= 0; --bit) { const unsigned cand = T | (1u << bit);
                    const int c = __popcll(__ballot(k0 >= cand)) + __popcll(__ballot(k1 >= cand));
                    if (c >= need) T = cand; } }
            const bool sel0 = (k0 >= T && k0 != 0u) || (f0 && v0), sel1 = (k1 >= T && k1 != 0u) || (f1 && v1);
            const unsigned long long b0 = __ballot(sel0), b1 = __ballot(sel1);
            if (lane == 0) { SELM[q * 4] = (unsigned)b0; SELM[q * 4 + 1] = (unsigned)(b0 >> 32); SELM[q * 4 + 2] = (unsigned)b1; SELM[q * 4 + 3] = (unsigned)(b1 >> 32);
                __hip_atomic_fetch_or(UNI + 0, (unsigned)b0, __ATOMIC_RELAXED, __HIP_MEMORY_SCOPE_WORKGROUP); __hip_atomic_fetch_or(UNI + 1, (unsigned)(b0 >> 32), __ATOMIC_RELAXED, __HIP_MEMORY_SCOPE_WORKGROUP);
                __hip_atomic_fetch_or(UNI + 2, (unsigned)b1, __ATOMIC_RELAXED, __HIP_MEMORY_SCOPE_WORKGROUP); __hip_atomic_fetch_or(UNI + 3, (unsigned)(b1 >> 32), __ATOMIC_RELAXED, __HIP_MEMORY_SCOPE_WORKGROUP); }
        }
    }
    __syncthreads();
    if (w == 0) {
        const unsigned long long u0 = (unsigned long long)UNI[0] | ((unsigned long long)UNI[1] << 32), u1 = (unsigned long long)UNI[2] | ((unsigned long long)UNI[3] << 32);
        const unsigned long long lowm = (1ull << lane) - 1ull;
        if ((u0 >> lane) & 1ull) LIST[__popcll(u0 & lowm)] = lane;
        if ((u1 >> lane) & 1ull) LIST[__popcll(u0) + __popcll(u1 & lowm)] = 64 + lane;
        if (lane == 0) NLIST[0] = __popcll(u0) + __popcll(u1);
    }
    __syncthreads();
    const float farb = FARB[head];
    asm volatile("s_waitcnt vmcnt(0)" ::: "memory");
    __syncthreads();
    {
        int ln_ = lane; asm volatile("" : "+v"(ln_));
        const int r16 = ln_ & 15, q4 = ln_ >> 4, head2 = r16 & 3, t4 = r16 >> 2;
        const int hk = w & 1, wp = w >> 1;
        LAS unsigned char* QT = lds + L_Q + 32768;
        LAS unsigned char* OSH = hk ? (lds + L_Q) : (lds + L_IMP);
        LAS float* MS = (LAS float*)(lds + L_Q + 65536);
        LAS float* LS = MS + 512;
        const int tlA = 8 * w + t4, tlB = tlA + 4, mqA = b * SEQ + t0 + tlA, mqB = b * SEQ + t0 + tlB;
        { bf16 const* qa = PROJ + (size_t)mqA * NP + C_NQ + (g * 4 + head2) * 64 + q4 * 8; bf16 const* qb = PROJ + (size_t)mqB * NP + C_NQ + (g * 4 + head2) * 64 + q4 * 8;
          v4u raw[4]; raw[0] = *(const v4u*)qa; raw[1] = *(const v4u*)(qa + 32); raw[2] = *(const v4u*)qb; raw[3] = *(const v4u*)(qb + 32);
_Pragma("unroll")
          for (int k = 0; k < 4; ++k) { float z[8]; unpack8(raw[k], z);
_Pragma("unroll")
              for (int e = 0; e < 8; ++e) z[e] *= 0.125f * LOG2E;
              const int R = ((k < 2) ? tlA : tlB) * 4 + head2, c = (k & 1) * 4 + q4;
              *(LAS bf16x8*)(QT + R * 128 + ((c ^ (R & 7)) << 4)) = pack8(z); } }
        { unsigned zz_ = 0u; asm volatile("" : "+v"(zz_)); const v4u z4 = (v4u){zz_, zz_, zz_, zz_};
_Pragma("unroll")
          for (int i = 0; i < 4; ++i) { *(LAS v4u*)(lds + L_IMP + tid * 64 + i * 16) = z4; *(LAS v4u*)(lds + L_Q + tid * 64 + i * 16) = z4; }
          unsigned ni_ = __builtin_bit_cast(unsigned, NEG_INF); asm volatile("" : "+v"(ni_));
          ((LAS unsigned*)MS)[tid] = ni_; *(LAS v4u*)(LS + tid * 4) = z4; }
        const float farb2 = FARB[head2];
        const bf16* Ks = (const bf16*)(a.ws + WS_KV0) + (size_t)(M + b * SEQ) * 256 + g * 64; const bf16* Vs = Ks + 128;
        const int nl = NLIST[0];
        KV_PAIR_LOOP(nl, LIST[i_] * 64, Ks, 256, Vs, 256, {
          const int bi = 2 * ip_ + hk;
          if (bi < nl) {
            const LAS unsigned char* Kt = lds + (hk ? L_KT1 : L_KT0); const LAS unsigned char* Vt = lds + (hk ? L_VT1 : L_VT0);
            const int n = LIST[bi], kv0 = n * 64;
            const bool selt = (SELM[lane * 4 + (n >> 5)] >> (n & 31)) & 1u;
            const unsigned long long tm = __builtin_amdgcn_ballot_w64(selt);
            const int ng = (__popcll(tm) + 3) >> 2;
            if (wp < ng) {
                const int rank = (int)__builtin_amdgcn_mbcnt_hi((unsigned)(tm >> 32), __builtin_amdgcn_mbcnt_lo((unsigned)tm, 0u));
                bf16x8 kf[4][2];
_Pragma("unroll")
                for (int kt = 0; kt < 4; ++kt)
_Pragma("unroll")
                    for (int ds = 0; ds < 2; ++ds) kf[kt][ds] = *(const LAS bf16x8*)(Kt + (16 * kt + r16) * KP + (ds * 32 + q4 * 8) * 2);
                const LAS unsigned char* vb = Vt + (4 * q4 + (r16 >> 2)) * 64 + (r16 & 3) * 8;
_Pragma("unroll 1")
                for (int G = wp; G < ng; G += 4) {
                    unsigned long long m2 = __builtin_amdgcn_ballot_w64(selt && (rank >> 2) == G);
                    const int nt = __popcll(m2);
                    const int tk0 = __builtin_ctzll(m2); m2 &= m2 - 1ull;
                    const int tk1 = m2 ? __builtin_ctzll(m2) : tk0; m2 &= m2 - 1ull;
                    const int tk2 = m2 ? __builtin_ctzll(m2) : tk0; m2 &= m2 - 1ull;
                    const int tk3 = m2 ? __builtin_ctzll(m2) : tk0;
                    const int tokl = t4 == 0 ? tk0 : (t4 == 1 ? tk1 : (t4 == 2 ? tk2 : tk3));
                    const bool selq = t4 < nt;
                    const int R = tokl * 4 + head2, tqr = t0 + tokl;
                    const bf16x8 q0 = *(const LAS bf16x8*)(QT + R * 128 + ((q4 ^ (R & 7)) << 4)), q1 = *(const LAS bf16x8*)(QT + R * 128 + (((4 + q4) ^ (R & 7)) << 4));
                    LAS unsigned char* osr = OSH + R * 128 + (q4 & 1) * 8;
                    v2u ob[4];
_Pragma("unroll")
                    for (int dt = 0; dt < 4; ++dt) ob[dt] = *(const LAS v2u*)(osr + (((2 * dt + (q4 >> 1)) ^ (R & 7)) << 4));
                    float MR = MS[hk * 256 + R], LR = LS[(hk * 256 + R) * 4 + q4];
                    f32x4 s[4];
_Pragma("unroll")
                    for (int kt = 0; kt < 4; ++kt) { s[kt] = MFMA16(kf[kt][0], q0, ((f32x4){0.f, 0.f, 0.f, 0.f})); s[kt] = MFMA16(kf[kt][1], q1, s[kt]); }
                    bf16x8 vf[2][4];
_Pragma("unroll")
                    for (int sK = 0; sK < 2; ++sK)
_Pragma("unroll")
                        for (int dt = 0; dt < 4; ++dt) { const LAS unsigned char* vp = vb + (dt >> 1) * 4096 + (dt & 1) * 32 + (32 * sK) * 64;
                            const v2u lo = vtr(vp), hi = vtr(vp + 16 * 64);
                            vf[sK][dt] = __builtin_bit_cast(bf16x8, ((v4u){lo.x, lo.y, hi.x, hi.y})); }
                    f32x4 oo[4];
_Pragma("unroll")
                    for (int dt = 0; dt < 4; ++dt) oo[dt] = (f32x4){bflo(ob[dt].x), bfhi(ob[dt].x), bflo(ob[dt].y), bfhi(ob[dt].y)};
                    float brow = selq ? farb2 : NEG_INF;
                    if ((cur - n) < 3) { brow = 0.f;
                        float bb_[4][4];
_Pragma("unroll")
                        for (int kt = 0; kt < 4; ++kt)
_Pragma("unroll")
                            for (int jj = 0; jj < 4; ++jj) { const int d0 = tqr - (kv0 + 16 * kt + 4 * q4 + jj); bb_[kt][jj] = LUT[head2 * 129 + (int)min((unsigned)d0, 128u)]; }
                        asm volatile("" : "+v"(bb_[0][0]), "+v"(bb_[0][1]), "+v"(bb_[0][2]), "+v"(bb_[0][3]), "+v"(bb_[1][0]), "+v"(bb_[1][1]), "+v"(bb_[1][2]), "+v"(bb_[1][3]),
                                          "+v"(bb_[2][0]), "+v"(bb_[2][1]), "+v"(bb_[2][2]), "+v"(bb_[2][3]), "+v"(bb_[3][0]), "+v"(bb_[3][1]), "+v"(bb_[3][2]), "+v"(bb_[3][3]));
_Pragma("unroll")
                        for (int kt = 0; kt < 4; ++kt)
_Pragma("unroll")
                            for (int jj = 0; jj < 4; ++jj) { const int d0 = tqr - (kv0 + 16 * kt + 4 * q4 + jj); s[kt][jj] = (selq && d0 >= 0) ? s[kt][jj] + bb_[kt][jj] : NEG_INF; } }
                    float bm = max3(s[0][0], s[0][1], s[0][2]);
                    bm = max3(bm, s[0][3], s[1][0]); bm = max3(bm, s[1][1], s[1][2]); bm = max3(bm, s[1][3], s[2][0]); bm = max3(bm, s[2][1], s[2][2]); bm = max3(bm, s[2][3], s[3][0]);
                    bm = max3(bm, s[3][1], s[3][2]); bm = fmaxf(bm, s[3][3]);
                    bm = xmax_rows(bm);
                    bm += brow;
                    const float mn = fmaxf(MR, bm), ms = (mn == NEG_INF) ? 0.f : mn;
                    const float alpha = __builtin_amdgcn_exp2f(MR - ms), off = brow - ms;
                    f32x2 ps2 = (f32x2){0.f, 0.f}; const f32x2 off2 = (f32x2){off, off};
_Pragma("unroll")
                    for (int kt = 0; kt < 4; ++kt) { f32x2 t0_ = (f32x2){s[kt][0], s[kt][1]} + off2, t1_ = (f32x2){s[kt][2], s[kt][3]} + off2;
                        t0_.x = __builtin_amdgcn_exp2f(t0_.x); t0_.y = __builtin_amdgcn_exp2f(t0_.y); t1_.x = __builtin_amdgcn_exp2f(t1_.x); t1_.y = __builtin_amdgcn_exp2f(t1_.y);
                        ps2 += t0_; ps2 += t1_; s[kt][0] = t0_.x; s[kt][1] = t0_.y; s[kt][2] = t1_.x; s[kt][3] = t1_.y; }
                    LR = LR * alpha + (ps2.x + ps2.y); MR = mn;
_Pragma("unroll")
                    for (int dt = 0; dt < 4; ++dt) oo[dt] *= alpha;
                    bf16x8 pp[2];
_Pragma("unroll")
                    for (int sK = 0; sK < 2; ++sK) { v4u pw; pw.x = pk(s[2 * sK][0], s[2 * sK][1]); pw.y = pk(s[2 * sK][2], s[2 * sK][3]); pw.z = pk(s[2 * sK + 1][0], s[2 * sK + 1][1]); pw.w = pk(s[2 * sK + 1][2], s[2 * sK + 1][3]);
                        pp[sK] = __builtin_bit_cast(bf16x8, pw); }
_Pragma("unroll")
                    for (int sK = 0; sK < 2; ++sK)
_Pragma("unroll")
                        for (int dt = 0; dt < 4; ++dt) oo[dt] = MFMA16(vf[sK][dt], pp[sK], oo[dt]);
                    if (selq) {
_Pragma("unroll")
                        for (int dt = 0; dt < 4; ++dt) { v2u wv; wv.x = pk(oo[dt][0], oo[dt][1]); wv.y = pk(oo[dt][2], oo[dt][3]); *(LAS v2u*)(osr + (((2 * dt + (q4 >> 1)) ^ (R & 7)) << 4)) = wv; }
                        LS[(hk * 256 + R) * 4 + q4] = LR;
                        if (q4 == 0) MS[hk * 256 + R] = MR; }
                }
            }
          }
        });
_Pragma("unroll")
        for (int G2 = 0; G2 < 2; ++G2) { const int tl = G2 ? tlB : tlA, mqq = G2 ? mqB : mqA, R = tl * 4 + head2;
            const float gsq = sigm(bflo((unsigned)(PROJ + (size_t)mqq * NP + C_NG + (g * 4 + head2) * 3)[1]));
            const float m0 = MS[R], m1 = MS[256 + R], mm = fmaxf(m0, m1), msf = (mm == NEG_INF) ? 0.f : mm;
            const float a0 = __builtin_amdgcn_exp2f(m0 - msf), a1 = __builtin_amdgcn_exp2f(m1 - msf);
            const float l0 = (LS[R * 4 + 0] + LS[R * 4 + 1]) + (LS[R * 4 + 2] + LS[R * 4 + 3]), l1 = (LS[(256 + R) * 4 + 0] + LS[(256 + R) * 4 + 1]) + (LS[(256 + R) * 4 + 2] + LS[(256 + R) * 4 + 3]);
            const float lt = l0 * a0 + l1 * a1;
            const float sc = lt > 0.f ? gsq / lt : 0.f, sc0 = sc * a0, sc1 = sc * a1;
            const LAS unsigned char* os0 = lds + L_IMP + R * 128 + (q4 & 1) * 8; const LAS unsigned char* os1 = lds + L_Q + R * 128 + (q4 & 1) * 8;
            bf16* orw = (bf16*)(a.ws + WS_OB) + (size_t)mqq * 512 + (g * 4 + head2) * 64 + 4 * q4;
            v2u old_[4], h0[4], h1[4];
_Pragma("unroll")
            for (int dt = 0; dt < 4; ++dt) { old_[dt] = *(const v2u*)(orw + 16 * dt); const int co = ((2 * dt + (q4 >> 1)) ^ (R & 7)) << 4; h0[dt] = *(const LAS v2u*)(os0 + co); h1[dt] = *(const LAS v2u*)(os1 + co); }
_Pragma("unroll")
            for (int dt = 0; dt < 4; ++dt) { v2u wv;
                wv.x = pk(bflo(old_[dt].x) + bflo(h0[dt].x) * sc0 + bflo(h1[dt].x) * sc1, bfhi(old_[dt].x) + bfhi(h0[dt].x) * sc0 + bfhi(h1[dt].x) * sc1);
                wv.y = pk(bflo(old_[dt].y) + bflo(h0[dt].y) * sc0 + bflo(h1[dt].y) * sc1, bfhi(old_[dt].y) + bfhi(h0[dt].y) * sc0 + bfhi(h1[dt].y) * sc1);
                *(v2u*)(orw + 16 * dt) = wv; } }
    }
    asm volatile("s_waitcnt vmcnt(0)" ::: "memory");
    __syncthreads();
    load_q(PROJ + (size_t)mq * NP + C_NQ + (g * 4 + head) * 64, 0.125f * LOG2E, hh, qf);
    {
        const int nlo = cur >= 8 ? cur - 8 : 0;
        const bf16* Kw = (const bf16*)(a.ws + WS_KV1) + (size_t)(b * SEQ) * 256 + g * 64; const bf16* Vw = Kw + 128;
        m = NEG_INF; lp = 0.f;
_Pragma("unroll")
        for (int i = 0; i < 16; ++i) { o0[i] = 0.f; o1[i] = 0.f; }
        KV_LOOP(cur - nlo + 1, (nlo + i_) * 64, Kw, 256, Vw, 256, {
            const int kv0 = (nlo + i_) * 64, dn = cur - (nlo + i_);
            qk_tile(Kt, qf, r, hh, s0, s1);
            float brow = farb;
            if (dn < 3 || dn > 7) { brow = 0.f;
_Pragma("unroll")
                for (int i = 0; i < 16; ++i) { const int d0 = tq - (kv0 + crow(i, hh)), d1 = d0 - 32;
                    const float b0 = LUT[head * 129 + (int)min((unsigned)d0, 128u)], b1 = LUT[head * 129 + (int)min((unsigned)d1, 128u)];
                    s0[i] = (d0 >= 0 && d0 < 512) ? s0[i] + b0 : NEG_INF; s1[i] = (d1 >= 0 && d1 < 512) ? s1[i] + b1 : NEG_INF;
                    if ((i & 3) == 3) asm volatile("" ::: "memory"); }
            }
            sm_pv(s0, s1, brow, m, lp, o0, o1, Vt, r, hh);
        });
        const float lt = lp + __shfl_xor(lp, 32), sc = lt > 0.f ? gw_ / lt : 0.f;
_Pragma("unroll")
        for (int i = 0; i < 16; ++i) { o0[i] *= sc; o1[i] *= sc; }
        add_o(orow, o0, o1, hh);
    }
    __syncthreads();
}
DI void swa_tile(const Args& a, int l, int b, int g, int qt, LAS unsigned char* lds, int tid) {
    asm volatile("" : "+v"(tid));
    const int lane = tid & 63, w = tid >> 6, r = lane & 31, hh = lane >> 5, head = w >> 1, ql = 32 * (w & 1) + r;
    const int t0 = qt * 64, cur = qt, tq = t0 + ql, mq = b * SEQ + tq;
    const bf16* PROJ = (const bf16*)(a.ws + WS_PROJ);
    LAS float* LUT = (LAS float*)(lds + L_LUT);
    { const int hh_ = tid >> 7, dist = tid & 127; LUT[hh_ * 129 + dist] = a.in[I_REL][(int)T5_BK[dist] * 16 + 8 + g * 4 + hh_] * LOG2E; if (tid < 4) LUT[tid * 129 + 128] = 0.f; }
    LAS unsigned char* qf = lds + L_Q + tid * 16; asm volatile("" : "+v"(qf));
    load_q(PROJ + (size_t)mq * NP + C_SQ + (g * 4 + head) * 64, 0.125f * LOG2E, hh, qf);
    const float sink = a.in[I_SINK][l * 8 + g * 4 + head] * LOG2E;
    f32x16 o0, o1, s0, s1;
_Pragma("unroll")
    for (int i = 0; i < 16; ++i) { o0[i] = 0.f; o1[i] = 0.f; }
    float m = sink, lp = hh == 0 ? 1.0f : 0.f;
    __syncthreads();
    const int nlo = cur >= 2 ? cur - 2 : 0;
    const bf16* Kw = (const bf16*)(a.ws + WS_KV1) + (size_t)(M + b * SEQ) * 256 + g * 64; const bf16* Vw = Kw + 128;
    KV_LOOP(cur - nlo + 1, (nlo + i_) * 64, Kw, 256, Vw, 256, {
        const int kv0 = (nlo + i_) * 64;
        qk_tile(Kt, qf, r, hh, s0, s1);
_Pragma("unroll")
        for (int i = 0; i < 16; ++i) { const int d0 = tq - (kv0 + crow(i, hh)), d1 = d0 - 32;
            s0[i] = (d0 >= 0 && d0 < 128) ? s0[i] + LUT[head * 129 + (int)min((unsigned)d0, 128u)] : NEG_INF; s1[i] = (d1 >= 0 && d1 < 128) ? s1[i] + LUT[head * 129 + (int)min((unsigned)d1, 128u)] : NEG_INF; }
        sm_pv(s0, s1, 0.f, m, lp, o0, o1, Vt, r, hh);
    });
    const float lt = lp + __shfl_xor(lp, 32), sc = 1.0f / lt;
_Pragma("unroll")
    for (int i = 0; i < 16; ++i) { o0[i] *= sc; o1[i] *= sc; }
    store_o((bf16*)(a.ws + WS_OC) + (size_t)mq * 512 + (g * 4 + head) * 64, o0, o1, hh);
    __syncthreads();
}
constexpr int CW_Q = 8192;
DI void p_mix(const Args& a, int l, LAS unsigned char* lds, int tid) {
    unsigned* qhead = (unsigned*)(a.ws + WS_CTL) + CW_Q + 64 * l;
    volatile LAS int* QI = (volatile LAS int*)(lds + MISC_OFF) + 16;
#if PROBE_DELAY_SCAN_US
    if (blockIdx.x < 48) spin_us(PROBE_DELAY_SCAN_US);
#endif
#if PROBE_DELAY_ATTN_US
    if (blockIdx.x >= 48) spin_us(PROBE_DELAY_ATTN_US);
#endif
    for (int rep = 0; rep < REP_SCAN; ++rep)
    for (int it = blockIdx.x; it < 48; it += gridDim.x) scan_block(a, it, lds, tid);
    for (;;) {
        if (tid == 0) QI[0] = (int)__hip_atomic_fetch_add(qhead, 1u, __ATOMIC_RELAXED, __HIP_MEMORY_SCOPE_AGENT);
        __syncthreads();
        const int idx = QI[0];
        __syncthreads();
        if (idx >= 1024) break;
        if (idx < 512) { const int qt = 127 - (idx >> 2), bg = idx & 3; nsa_tile(a, l, bg >> 1, bg & 1, qt, lds, tid); }
        else { const int j = idx - 512, bg = j >> 7, qt = j & 127; swa_tile(a, l, bg >> 1, bg & 1, qt, lds, tid); }
    }
}

DI void cvt_fp8(const float* src, unsigned char* dst, size_t n, float sc, size_t gtid, size_t gthreads) {
    for (size_t i = gtid * 16; i < n; i += gthreads * 16) { v4u o;
#pragma unroll
        for (int c = 0; c < 4; ++c) { const f32x4 v = *(const f32x4*)(src + i + 4 * c) * sc; int w = 0; w = __builtin_amdgcn_cvt_pk_fp8_f32(v.x, v.y, w, false); w = __builtin_amdgcn_cvt_pk_fp8_f32(v.z, v.w, w, true); o[c] = (unsigned)w; }
        *(v4u*)(dst + i) = o; }
}
DI void cvt_fp4(const float* src, unsigned char* dst, size_t n, float sc, size_t gtid, size_t gthreads) {
    for (size_t i = gtid * 16; i < n; i += gthreads * 16) { v2u o;
#pragma unroll
        for (int d = 0; d < 2; ++d) { unsigned w = 0u;
#pragma unroll
            for (int c = 0; c < 2; ++c) { const f32x4 v = *(const f32x4*)(src + i + 8 * d + 4 * c) * sc;
                if (c == 0) { w = __builtin_amdgcn_cvt_scalef32_pk_fp4_f32(w, v.x, v.y, 1.0f, 0); w = __builtin_amdgcn_cvt_scalef32_pk_fp4_f32(w, v.z, v.w, 1.0f, 1); }
                else        { w = __builtin_amdgcn_cvt_scalef32_pk_fp4_f32(w, v.x, v.y, 1.0f, 2); w = __builtin_amdgcn_cvt_scalef32_pk_fp4_f32(w, v.z, v.w, 1.0f, 3); } }
            o[d] = w; }
        *(v2u*)(dst + i / 2) = o; }
}
constexpr float PV_I4 = 16.f;
constexpr float PU_I4 = 96.f;
DI void cvt_i4(const float* src, unsigned char* dst, size_t n, float sc, size_t gtid, size_t gthreads) {
    for (size_t i = gtid * 16; i < n; i += gthreads * 64) { f32x4 v[4][4];
#pragma unroll
        for (int u = 0; u < 4; ++u)
#pragma unroll
            for (int c = 0; c < 4; ++c) v[u][c] = *(const f32x4*)(src + i + (size_t)u * gthreads * 16 + 4 * c);
        __builtin_amdgcn_sched_barrier(0);
#pragma unroll
        for (int u = 0; u < 4; ++u) { v2u o;
#pragma unroll
            for (int d = 0; d < 2; ++d) { unsigned w = 0u;
#pragma unroll
                for (int e = 0; e < 8; ++e) { const float x = v[u][2 * d + (e >> 2)][e & 3] * sc; int qi = (int)__builtin_rintf(x); qi = qi < -8 ? -8 : (qi > 7 ? 7 : qi); w |= ((unsigned)qi & 15u) << (4 * e); }
                o[d] = w; }
            *(v2u*)(dst + (i + (size_t)u * gthreads * 16) / 2) = o; }
        __builtin_amdgcn_sched_barrier(0); }
}
DI void p_norm2(const Args& a, int l, int tid) {
    p_rms(a.out, a.in[I_LN2] + l * D, (bf16*)(a.ws + WS_XN), tid);
}
DI void p_cvt_tables(const Args& a, int l, int tid) {
    const size_t gtid = (size_t)blockIdx.x * NT + tid, gth = (size_t)gridDim.x * NT;
    cvt_i4(a.in[I_PU] + (size_t)l * 16384 * 1024, a.ws + WS_PU, (size_t)16384 * 1024, PU_I4, gtid, gth);
    cvt_i4(a.in[I_PV] + (size_t)l * 16384 * 1024, a.ws + WS_PV, (size_t)16384 * 1024, PV_I4, gtid, gth);
}
constexpr int P_SC = 0, P_TOP = 132096, P_EXP = 0, P_GATE = 8192;
DI void peer_sel_a(const Args& a, int l, int grp, int hh, LAS unsigned char* lds, int tid) {
    const int lane = tid & 63, w = tid >> 6, r16 = lane & 15, q4 = lane >> 4, m0 = grp * 32;
    LAS float* SC = (LAS float*)(lds + P_SC);
    const bf16* PQ = (const bf16*)(a.ws + WS_PQ); const bf16* SK = (const bf16*)(a.ws + WS_SK) + (size_t)l * 16 * 128 * 128;
    { const int hp = 8 * hh + w;
        bf16x8 af[2][4], bq[4][8];
        const bf16* ap = PQ + (size_t)(m0 + r16) * 2048 + hp * 128 + q4 * 8; const bf16* bp = SK + (size_t)(hp * 128 + r16) * 128 + q4 * 8;
#pragma unroll
        for (int ks = 0; ks < 4; ++ks) { af[0][ks] = *(const bf16x8*)(ap + ks * 32); af[1][ks] = *(const bf16x8*)(ap + (size_t)16 * 2048 + ks * 32);
#pragma unroll
            for (int nt = 0; nt < 8; ++nt) bq[ks][nt] = *(const bf16x8*)(bp + (size_t)nt * 16 * 128 + ks * 32); }
        __builtin_amdgcn_sched_barrier(0);
#pragma unroll
        for (int t2 = 0; t2 < 2; ++t2) { f32x4 acc[8];
#pragma unroll
            for (int nt = 0; nt < 8; ++nt) acc[nt] = (f32x4){0.f, 0.f, 0.f, 0.f};
#pragma unroll
            for (int ks = 0; ks < 4; ++ks)
#pragma unroll
                for (int nt = 0; nt < 8; ++nt) acc[nt] = MFMA16(af[t2][ks], bq[ks][nt], acc[nt]);
#pragma unroll
            for (int nt = 0; nt < 8; ++nt)
#pragma unroll
                for (int j = 0; j < 4; ++j) SC[((t2 * 16 + q4 * 4 + j) * 8 + w) * 129 + nt * 16 + r16] = acc[nt][j]; }
        __builtin_amdgcn_sched_barrier(0);
    }
}
DI void peer_sel_b(LAS unsigned char* lds, int tid) {
    LAS float* SC = (LAS float*)(lds + P_SC); LAS float* TOP = (LAS float*)(lds + P_TOP);
    if (tid < 256) { float T[16], Gv[16];
#define PK_LOAD16(A, g) _Pragma("unroll") for (int i_ = 0; i_ < 16; ++i_) A[i_] = __uint_as_float((__float_as_uint(SC[tid * 129 + (g) * 16 + i_]) & ~0x7Fu) | (unsigned)((g) * 16 + i_))
#define PK_CE(A, i_, l_) do { const float hi_ = fmaxf(A[i_], A[l_]), lo_ = fminf(A[i_], A[l_]); A[i_] = hi_; A[l_] = lo_; } while (0)
#define PK_SORT16(A) _Pragma("unroll") for (int k_ = 2; k_ <= 16; k_ <<= 1) _Pragma("unroll") for (int j_ = k_ >> 1; j_ > 0; j_ >>= 1) _Pragma("unroll") for (int i_ = 0; i_ < 16; ++i_) { const int l_ = i_ ^ j_; \
            if (l_ > i_) { if (((i_ & k_) == 0) || k_ == 16) PK_CE(A, i_, l_); else PK_CE(A, l_, i_); } }
#define PK_MERGE16(A) _Pragma("unroll") for (int j_ = 8; j_ > 0; j_ >>= 1) _Pragma("unroll") for (int i_ = 0; i_ < 16; ++i_) { const int l_ = i_ ^ j_; if (l_ > i_) PK_CE(A, i_, l_); }
        PK_LOAD16(T, 0); PK_SORT16(T);
#pragma unroll 1
        for (int g = 1; g < 8; ++g) { PK_LOAD16(Gv, g); PK_SORT16(Gv);
#pragma unroll
            for (int i_ = 0; i_ < 16; ++i_) T[i_] = fmaxf(T[i_], Gv[15 - i_]);
            PK_MERGE16(T); }
#pragma unroll
        for (int k = 0; k < 16; ++k) TOP[tid * 17 + k] = T[k]; }
}
DI void peer_sel_c(int hh, LAS unsigned char* lds, int tid, int* EL, float* GL) {
    LAS float* TOP = (LAS float*)(lds + P_TOP);
    if (tid < 128) { const int tok = tid >> 2, hl = tid & 3, h = 4 * hh + hl; const LAS float* T1 = TOP + ((tok * 8 + 2 * hl) * 17), *T2 = TOP + ((tok * 8 + 2 * hl + 1) * 17);
        float s1[16], s2[16], L[16];
#pragma unroll
        for (int k = 0; k < 16; ++k) { s1[k] = T1[k]; s2[k] = T2[k]; L[k] = NEG_INF; }
#pragma unroll
        for (int aa = 0; aa < 16; ++aa)
#pragma unroll
            for (int bb = 0; bb < 16; ++bb) if ((aa + 1) * (bb + 1) <= 16) {
                float x = __uint_as_float((__float_as_uint(s1[aa] + s2[bb]) & ~0xFFu) | (unsigned)(aa * 16 + bb));
#pragma unroll
                for (int k = 0; k < 16; ++k) { const float hi = fmaxf(L[k], x); x = fminf(L[k], x); L[k] = hi; } }
        float e[16], se = 0.f;
#pragma unroll
        for (int k = 0; k < 16; ++k) { e[k] = __expf(L[k] - L[0]); se += e[k]; }
        const float inv = 1.0f / se;
#pragma unroll
        for (int k = 0; k < 16; ++k) { const unsigned id = __float_as_uint(L[k]) & 0xFFu; const int i1 = (int)(__float_as_uint(T1[id >> 4]) & 0x7Fu), i2 = (int)(__float_as_uint(T2[id & 15u]) & 0x7Fu);
            EL[tok * 128 + h * 16 + k] = i1 * 128 + i2; GL[tok * 128 + h * 16 + k] = e[k] * inv; }
    }
}
#define DPPI(v, ctrl) __builtin_amdgcn_update_dpp(0, (v), (ctrl), 0xF, 0xF, true)
DI void peer_upass(const Args& a, int m, const int* EL, const float* GL, LAS float* ACT, int lane) {
    const unsigned char* PU = a.ws + WS_PU;
    const bf16* zrow = (const bf16*)(a.ws + WS_XN) + (size_t)m * 1024 + 16 * lane;
        unsigned zh[2], zl[2]; float uinv;
        { float zf[16]; { float t8[8]; unpack8(*(const v4u*)zrow, t8);
#pragma unroll
            for (int c = 0; c < 8; ++c) zf[c] = t8[c];
            unpack8(*(const v4u*)(zrow + 8), t8);
#pragma unroll
            for (int c = 0; c < 8; ++c) zf[8 + c] = t8[c]; }
          float am = 0.f;
#pragma unroll
          for (int c = 0; c < 16; ++c) am = fmaxf(am, fabsf(zf[c]));
          am = wave_max(am);
          am = fmaxf(am, 1e-20f);
          const float sz = 119.0f / am; uinv = am * (1.0f / (119.0f * PU_I4));
#pragma unroll
          for (int d = 0; d < 2; ++d) { unsigned wh = 0u, wl = 0u;
#pragma unroll
            for (int e = 0; e < 8; ++e) { const int z8 = (int)__builtin_rintf(zf[8 * d + e] * sz); const int lo = ((z8 + 8) & 15) - 8, hi = (z8 - lo) >> 4;
                wh |= ((unsigned)hi & 15u) << (4 * e); wl |= ((unsigned)lo & 15u) << (4 * e); }
            zh[d] = wh; zl[d] = wl; } }
    const int id_lo = EL[lane], id_hi = EL[64 + lane]; const float gt_lo = GL[lane], gt_hi = GL[64 + lane];
#pragma unroll 1
    for (int half = 0; half < 2; ++half) { const int idr = half ? id_hi : id_lo; const float gtr = half ? gt_hi : gt_lo;
            int coll = 0;
#pragma unroll 1
            for (int e0 = 0; e0 < 64; e0 += 32) { v2u ur[32];
#pragma unroll
                for (int k = 0; k < 32; ++k) { const int eid = __builtin_amdgcn_readlane(idr, e0 + k); ur[k] = *(const v2u*)(PU + (size_t)eid * 512 + 8 * lane); }
#pragma unroll
                for (int gq = 0; gq < 4; ++gq) { int x8[8];
#pragma unroll
                    for (int k = 0; k < 8; ++k) { const int w0 = (int)ur[8 * gq + k][0], w1 = (int)ur[8 * gq + k][1];
                        int hi = __builtin_amdgcn_sdot8(w0, (int)zh[0], 0, false); hi = __builtin_amdgcn_sdot8(w1, (int)zh[1], hi, false);
                        int lo = __builtin_amdgcn_sdot8(w0, (int)zl[0], 0, false); lo = __builtin_amdgcn_sdot8(w1, (int)zl[1], lo, false);
                        x8[k] = (hi << 4) + lo; }
                    int y4[4], z2[2], u;
#pragma unroll
                    for (int k = 0; k < 4; ++k) { const bool o = lane & 1; const int keep = o ? x8[2 * k + 1] : x8[2 * k], send = o ? x8[2 * k] : x8[2 * k + 1]; y4[k] = keep + DPPI(send, 0xB1); }
#pragma unroll
                    for (int k = 0; k < 2; ++k) { const bool o = lane & 2; const int keep = o ? y4[2 * k + 1] : y4[2 * k], send = o ? y4[2 * k] : y4[2 * k + 1]; z2[k] = keep + DPPI(send, 0x4E); }
                    { const bool o = lane & 4; const int keep = o ? z2[1] : z2[0], send = o ? z2[0] : z2[1]; const int fr_hi = DPPI(send, 0x104), fr_lo = DPPI(send, 0x114); u = keep + (o ? fr_lo : fr_hi); }
                    u += DPPI(u, 0x128);
                    { int ub; asm volatile("v_mov_b32_e32 %1, %0\n\ts_nop 1\n\tv_permlane16_swap_b32_e32 %0, %1" : "+v"(u), "=&v"(ub)); u += ub; }
                    { int ub; asm volatile("v_mov_b32_e32 %1, %0\n\ts_nop 1\n\tv_permlane32_swap_b32_e32 %0, %1" : "+v"(u), "=&v"(ub)); u += ub; }
                    coll = ((lane >> 3) == ((e0 >> 3) + gq)) ? u : coll; }
            }
        ACT[half * 64 + lane] = gtr * gelu_erf((float)coll * uinv);
    }
}
DI void peer_vpass(const Args& a, int l, int m, const int* EL, const LAS float* ACT, int lane) {
    const unsigned char* PV = a.ws + WS_PV;
    bf16* zrow = (bf16*)(a.ws + WS_XN) + (size_t)m * 1024 + 16 * lane;
    f32x2 acc[8];
#pragma unroll
    for (int d = 0; d < 8; ++d) acc[d] = (f32x2){0.f, 0.f};
    const int id_lo = EL[lane], id_hi = EL[64 + lane];
#pragma unroll 1
    for (int half = 0; half < 2; ++half) { const int idr = half ? id_hi : id_lo; const float actf = ACT[half * 64 + lane];
            float am = fabsf(actf);
            am = wave_max(am);
            const float sa = am > 0.f ? 119.0f / am : 0.f;
            int wh, wl;
            { const int a8 = (int)__builtin_rintf(actf * sa); const int lo = ((a8 + 8) & 15) - 8, hi = (a8 - lo) >> 4; const int sh = 4 * (lane & 7);
              wh = (int)(((unsigned)hi & 15u) << sh); wl = (int)(((unsigned)lo & 15u) << sh);
              wh += DPPI(wh, 0xB1); wh += DPPI(wh, 0x4E); wh += DPPI(wh, 0x141); wl += DPPI(wl, 0xB1); wl += DPPI(wl, 0x4E); wl += DPPI(wl, 0x141); }
            int ih[16], il[16];
#pragma unroll
            for (int jj = 0; jj < 16; ++jj) { ih[jj] = 0; il[jj] = 0; }
#pragma unroll 1
            for (int e0 = 0; e0 < 64; e0 += 32) { v2u vr[32];
#pragma unroll
                for (int k = 0; k < 32; ++k) { const int eid = __builtin_amdgcn_readlane(idr, e0 + k); vr[k] = *(const v2u*)(PV + (size_t)eid * 512 + 8 * lane); }
#pragma unroll
                for (int gq = 0; gq < 4; ++gq) { const int Ah = __builtin_amdgcn_readlane(wh, e0 + 8 * gq), Al = __builtin_amdgcn_readlane(wl, e0 + 8 * gq);
#pragma unroll
                    for (int d = 0; d < 2; ++d) { unsigned t[8];
#pragma unroll
                        for (int k = 0; k < 8; ++k) t[k] = vr[8 * gq + k][d];
#pragma unroll
                        for (int k = 0; k < 4; ++k) { const unsigned x = t[k], y = t[k + 4]; t[k] = __builtin_amdgcn_perm(y, x, 0x05040100u); t[k + 4] = __builtin_amdgcn_perm(y, x, 0x07060302u); }
#pragma unroll
                        for (int kk = 0; kk < 4; ++kk) { const int k = (kk & 1) + 4 * (kk >> 1); const unsigned x = t[k], y = t[k + 2]; t[k] = __builtin_amdgcn_perm(y, x, 0x06020400u); t[k + 2] = __builtin_amdgcn_perm(y, x, 0x07030501u); }
#pragma unroll
                        for (int k = 0; k < 8; k += 2) { const unsigned x = t[k], y = t[k + 1]; t[k] = (x & 0x0F0F0F0Fu) | ((y << 4) & 0xF0F0F0F0u); t[k + 1] = ((x >> 4) & 0x0F0F0F0Fu) | (y & 0xF0F0F0F0u); }
#pragma unroll
                        for (int k = 0; k < 8; ++k) { ih[8 * d + k] = __builtin_amdgcn_sdot8((int)t[k], Ah, ih[8 * d + k], false); il[8 * d + k] = __builtin_amdgcn_sdot8((int)t[k], Al, il[8 * d + k], false); } } }
            }
            { const float sc = am * (1.0f / (119.0f * PV_I4));
#pragma unroll
              for (int d = 0; d < 8; ++d) { acc[d].x += (float)((ih[2 * d] << 4) + il[2 * d]) * sc; acc[d].y += (float)((ih[2 * d + 1] << 4) + il[2 * d + 1]) * sc; } }
        }
    {
        if ((DBG_ZERO >> 3) & 1) {
#pragma unroll
            for (int d = 0; d < 8; ++d) acc[d] = (f32x2){0.f, 0.f}; }
        float* xo = a.out + (size_t)m * 1024 + 16 * lane;
        f32x4 x0 = *(const f32x4*)(xo), x1 = *(const f32x4*)(xo + 4), x2 = *(const f32x4*)(xo + 8), x3 = *(const f32x4*)(xo + 12);
        x0 += (f32x4){acc[0].x, acc[0].y, acc[1].x, acc[1].y}; x1 += (f32x4){acc[2].x, acc[2].y, acc[3].x, acc[3].y}; x2 += (f32x4){acc[4].x, acc[4].y, acc[5].x, acc[5].y}; x3 += (f32x4){acc[6].x, acc[6].y, acc[7].x, acc[7].y};
        float ss = (x0.x * x0.x + x0.y * x0.y + x0.z * x0.z + x0.w * x0.w) + (x1.x * x1.x + x1.y * x1.y + x1.z * x1.z + x1.w * x1.w)
                 + (x2.x * x2.x + x2.y * x2.y + x2.z * x2.z + x2.w * x2.w) + (x3.x * x3.x + x3.y * x3.y + x3.z * x3.z + x3.w * x3.w);
        const float rs = rsqrtf(wave_sum(ss) * (1.f / D) + 1e-6f);
        const float* nw = ((l == LAYERS - 1) ? a.in[I_LNF] : a.in[I_LN1] + (l + 1) * D) + 16 * lane;
        const f32x4 w0 = *(const f32x4*)(nw), w1 = *(const f32x4*)(nw + 4), w2 = *(const f32x4*)(nw + 8), w3 = *(const f32x4*)(nw + 12);
        const f32x4 n0 = x0 * rs * w0, n1 = x1 * rs * w1, n2 = x2 * rs * w2, n3 = x3 * rs * w3;
        if (l == LAYERS - 1) {
            *(f32x4*)(xo) = n0; *(f32x4*)(xo + 4) = n1; *(f32x4*)(xo + 8) = n2; *(f32x4*)(xo + 12) = n3;
        } else {
            *(f32x4*)(xo) = x0; *(f32x4*)(xo + 4) = x1; *(f32x4*)(xo + 8) = x2; *(f32x4*)(xo + 12) = x3;
            v4u p; p.x = pk(n0.x, n0.y); p.y = pk(n0.z, n0.w); p.z = pk(n1.x, n1.y); p.w = pk(n1.z, n1.w); *(v4u*)(zrow) = p;
            p.x = pk(n2.x, n2.y); p.y = pk(n2.z, n2.w); p.z = pk(n3.x, n3.y); p.w = pk(n3.z, n3.w); *(v4u*)(zrow + 8) = p;
        }
    }
}
#undef DPPI
DI void p_peer(const Args& a, int l, LAS unsigned char* lds, int tid) {
    const int lane = tid & 63, w = tid >> 6;
    int* ELb = (int*)(a.ws + WS_SLIST) + (size_t)blockIdx.x * 8192; float* GLb = (float*)(a.ws + WS_SLIST + 8 * MiB) + (size_t)blockIdx.x * 8192;
    int ng = 0, ph = -1; int* pel = ELb; float* pgl = GLb;
    for (int g = blockIdx.x; g < M / 32; g += gridDim.x, ++ng)
        for (int hh = 0; hh < 2; ++hh) {
            if (ph >= 0) peer_sel_c(ph, lds, tid, pel, pgl);
            peer_sel_a(a, l, g, hh, lds, tid);
            __syncthreads();
            peer_sel_b(lds, tid);
            __syncthreads();
            ph = hh; pel = ELb + ng * 4096; pgl = GLb + ng * 4096; }
    if (ph >= 0) peer_sel_c(ph, lds, tid, pel, pgl);
    __syncthreads();
    LAS float* ACTb = (LAS float*)lds;
    for (int k = 0; k < ng; ++k)
        for (int ti = 0; ti < 4; ++ti) { const int tt = 4 * w + ti; peer_upass(a, (blockIdx.x + k * gridDim.x) * 32 + tt, ELb + (k * 32 + tt) * 128, GLb + (k * 32 + tt) * 128, ACTb + (k * 32 + tt) * 128, lane); }
    for (int k = 0; k < ng; ++k)
        for (int ti = 0; ti < 4; ++ti) { const int tt = 4 * w + ti; peer_vpass(a, l, (blockIdx.x + k * gridDim.x) * 32 + tt, ELb + (k * 32 + tt) * 128, ACTb + (k * 32 + tt) * 128, lane); }
    __syncthreads();
}
#ifndef MK_PER_PHASE
#define MK_PER_PHASE 0
#endif
#ifndef PH_MASK
#define PH_MASK 0x7FF
#endif
#define PHASE_ON(j) ((((PH_MASK) >> (j)) & 1) != 0)
constexpr int NPH = 1 + 10 * LAYERS;
__global__ void __launch_bounds__(NT, 2) fwd(Args a_unused) {
    typedef const __attribute__((address_space(4))) Args* KArgP;
    KArgP kap = (KArgP)__builtin_amdgcn_kernarg_segment_ptr();
    Args a; __builtin_memcpy(&a, kap, sizeof(Args));
    extern __shared__ __attribute__((aligned(16))) unsigned char lds_raw[];
    LAS unsigned char* lds = (LAS unsigned char*)lds_raw;
    const int tid0 = threadIdx.x;
#define tid tid0
    volatile LAS unsigned* MISC = (volatile LAS unsigned*)(lds + MISC_OFF);
    if (tid < 64) MISC[tid] = 0u;
    __syncthreads();
    unsigned* ctl = (unsigned*)(a.ws + WS_CTL);
    XcdBarrier bar = xcd_barrier_post(ctl + CW_BAR, MISC + 8);
    const int lo = a.ph_lo, hi = a.ph_hi;
#define IN(k) (lo <= (k) && (k) < hi)
#define SEAM(k) do { if (IN(k) && IN((k) + 1)) xcd_barrier(bar); } while (0)
    unsigned char* ws = a.ws;
#undef tid
#define LAUNDER_ARGS Args a; { KArgP p_ = kap; asm volatile("" : "+s"(p_)); __builtin_memcpy(&a, p_, sizeof(Args)); } unsigned char* ws = a.ws; const float* xin = (l == 0) ? a.in[I_X] : a.out
#define LAUNDER_TID int tid = tid0; asm volatile("" : "+v"(tid)); Args a; { KArgP p_ = kap; asm volatile("" : "+s"(p_)); __builtin_memcpy(&a, p_, sizeof(Args)); }
    if (PHASE_ON(10) && IN(0)) { LAUNDER_TID; for (int rep = 0; rep < REP_PRO; ++rep) p_prologue(a, lds, tid, 0, 1, true);
        p_rms(a.in[I_X], a.in[I_LN1], (bf16*)(ws + WS_XN), tid);
#if PROBE_CVT
        { unsigned xw = (unsigned)tid * 2654435761u; f32x2 sacc = (f32x2){0.f, 0.f};
#pragma unroll 1
          for (int i = 0; i < 20000; i += 4) {
#if PROBE_CVT == 1
              sacc += __builtin_amdgcn_cvt_scalef32_pk_f32_fp4(xw, 1.0f, 0); sacc += __builtin_amdgcn_cvt_scalef32_pk_f32_fp4(xw, 1.0f, 1);
              sacc += __builtin_amdgcn_cvt_scalef32_pk_f32_fp4(xw, 1.0f, 2); sacc += __builtin_amdgcn_cvt_scalef32_pk_f32_fp4(xw, 1.0f, 3);
#else
              sacc += sacc * (f32x2){1.0001f, 0.9999f}; sacc += sacc * (f32x2){1.0001f, 0.9999f}; sacc += sacc * (f32x2){1.0001f, 0.9999f}; sacc += sacc * (f32x2){1.0001f, 0.9999f};
#endif
              asm volatile("" : "+v"(xw)); xw += 0x01010101u; }
          if (sacc.x == 12345.678f) ((float*)(ws + WS_CTL))[200000 + tid] = sacc.y; }
#endif
        if (IN(0) && IN(2)) xcd_barrier(bar); }
    for (int l = 0; l < LAYERS; ++l) {
        const int pb = 1 + 10 * l;
        const float* xin = (l == 0) ? a.in[I_X] : a.out;
        if (PHASE_ON(1) && IN(pb + 1)) { LAUNDER_ARGS;
            pg8::Gemm g{(const bf16*)(ws + WS_XN), (const bf16*)(ws + WS_WIN) + (size_t)l * NP * 1024, M, NP, 1024}; pg8::StaticOrder S; S.init(M, NP, gridDim.x, blockIdx.x);
            pg8::EpiBf16P E{(bf16*)(ws + WS_PROJ), NP, KV_TILE_MASK, (bf16*)(ws + WS_KV0), (bf16*)(ws + WS_KV1)};
#if GEMM_STAGGER_NS
            spin_ns(((blockIdx.x >> 3) & 7) * GEMM_STAGGER_NS);
#endif
            for (int rep = 0; rep < REP_WIN; ++rep) pg8::gemm_phase<pg8::EpiBf16P, pg8::StaticOrder, true, true>(lds, g, S, E);
            SEAM(pb + 1); }
        if (PHASE_ON(2) && IN(pb + 2)) { LAUNDER_TID; p_prep(a, l, lds, tid); SEAM(pb + 2); }
        if (PHASE_ON(3) && IN(pb + 3)) { LAUNDER_TID; p_mix(a, l, lds, tid); SEAM(pb + 3); }
        if (PHASE_ON(4) && IN(pb + 4)) { LAUNDER_TID; p_post(a, l, tid); SEAM(pb + 4); }
        if (PHASE_ON(5) && IN(pb + 5)) { LAUNDER_ARGS;
            pg8::StaticOrder S; S.init(M, 1024, gridDim.x, blockIdx.x);
            const bf16* Gp = (const bf16*)(ws + WS_PROJ) + C_GA; bf16* MG = (bf16*)(ws + WS_XN); const bf16* WB = (const bf16*)(ws + WS_WBR) + (size_t)l * 3 * 1024 * 512;
#pragma unroll 1
            for (int br3 = 0; br3 < 3 * REP_MERGE; ++br3) { const int br = br3 % 3;
                if (br3 < 3 && (int)(blockIdx.x & 3u) == br3) { int tc_ = tid0; asm volatile("" : "+v"(tc_)); p_cvt_tables(a, l, tc_);
                    if (l == 0) { p_prologue(a, lds, tc_, 1, LAYERS, false); __syncthreads(); } }
                pg8::Gemm g{(const bf16*)(ws + WS_OA + (size_t)br * (WS_OB - WS_OA)), WB + (size_t)br * 1024 * 512, M, 1024, 512}; pg8::EpiMerge E{Gp + br * 1024, NP, MG, br, ((DBG_ZERO >> br) & 1) ? 0.f : 1.f};
                pg8::gemm_phase<pg8::EpiMerge, pg8::StaticOrder, true, true>(lds, g, S, E); }
            if ((blockIdx.x & 3u) == 3u) { int tc_ = tid0; asm volatile("" : "+v"(tc_)); p_cvt_tables(a, l, tc_);
                if (l == 0) { p_prologue(a, lds, tc_, 1, LAYERS, false); __syncthreads(); } }
            SEAM(pb + 5); }
        if (PHASE_ON(6) && IN(pb + 6)) { LAUNDER_ARGS;
            pg8::Gemm g{(const bf16*)(ws + WS_XN), (const bf16*)(ws + WS_WOUT) + (size_t)l * 1024 * 1024, M, 1024, 1024}; pg8::StaticOrder S; S.init(M, 1024, gridDim.x, blockIdx.x);
            pg8::EpiResid E{xin, a.out};
            pg8::gemm_phase<pg8::EpiResid, pg8::StaticOrder, true, true>(lds, g, S, E);
            SEAM(pb + 6); }
        if (PHASE_ON(7) && IN(pb + 7)) { LAUNDER_TID; for (int rep = 0; rep < REP_NORM2; ++rep) p_norm2(a, l, tid); SEAM(pb + 7); }
        if (PHASE_ON(8) && IN(pb + 8)) { LAUNDER_ARGS;
            pg8::Gemm g{(const bf16*)(ws + WS_XN), (const bf16*)(ws + WS_WQ) + (size_t)l * 2048 * 1024, M, 2048, 1024}; pg8::StaticOrder S; S.init(M, 2048, gridDim.x, blockIdx.x);
            pg8::EpiBf16P E{(bf16*)(ws + WS_PQ), 2048, 0u, nullptr, nullptr};
            for (int rep = 0; rep < REP_PQ; ++rep) pg8::gemm_phase<pg8::EpiBf16P, pg8::StaticOrder, true, true>(lds, g, S, E);
            SEAM(pb + 8); }
        if (PHASE_ON(9) && IN(pb + 9)) { LAUNDER_TID; p_peer(a, l, lds, tid); if (l + 1 < LAYERS) { if (IN(pb + 9) && IN(pb + 11)) xcd_barrier(bar); } }
    }
#undef IN
#undef SEAM
}

extern "C" void kernel_launch(void* const* d_in, const int* in_sizes, int n_in, void* d_out, int out_size, void* d_ws, size_t ws_size, hipStream_t stream) {
    static int grid = 0;
    if (grid == 0) {
        if (n_in != 32 || in_sizes[0] != M * D || out_size != M * D || ws_size < WS_END) { fprintf(stderr, "kernel_launch: unexpected problem shape / workspace (%d inputs, ws %zu)\n", n_in, ws_size); grid = -1; return; }
        int dev = 0, cus = 0, per_cu = 0;
        if (hipGetDevice(&dev) != hipSuccess || hipDeviceGetAttribute(&cus, hipDeviceAttributeMultiprocessorCount, dev) != hipSuccess) { grid = -1; return; }
        if (hipFuncSetAttribute((const void*)fwd, hipFuncAttributeMaxDynamicSharedMemorySize, LDS_BYTES) != hipSuccess) { fprintf(stderr, "kernel_launch: hipFuncSetAttribute failed\n"); grid = -1; return; }
        if (hipOccupancyMaxActiveBlocksPerMultiprocessor(&per_cu, (const void*)fwd, NT, LDS_BYTES) != hipSuccess || per_cu < 1) { fprintf(stderr, "kernel_launch: occupancy query says %d\n", per_cu); (void)hipGetLastError(); }
        grid = cus;
    }
    if (grid < 0) return;
    (void)hipMemsetAsync((char*)d_ws + WS_CTL, 0, CTL_ZERO_BYTES, stream);
    Args a{};
    for (int i = 0; i < 32; ++i) a.in[i] = (const float*)d_in[i];
    a.out = (float*)d_out; a.ws = (unsigned char*)d_ws;
#if MK_PER_PHASE
    for (int p = 0; p < NPH; ++p) { if (p == 1 || p == 11) continue; a.ph_lo = p; a.ph_hi = p + 1; hipLaunchKernelGGL(fwd, dim3(grid), dim3(NT), LDS_BYTES, stream, a); }
#else
    a.ph_lo = 0; a.ph_hi = NPH;
    hipLaunchKernelGGL(fwd, dim3(grid), dim3(NT), LDS_BYTES, stream, a);
#endif
}
```
